# Optimizing an MI355X kernel written in HIP

```python
import functools
import jax, jax.numpy as jnp
from jax import lax
import numpy as np

D_MODEL = 2048
BATCH = 4
SEQ = 2048
DEPTH = 4
DEC_BATCH = 8
DEC_SEQ = 1
PAST_LEN = 16384
PAGE_SIZE = 128

HEAD_DIM = 128
WIDTH_A = D_MODEL // 2
N_HEADS_A = WIDTH_A // HEAD_DIM
DILATIONS = ((128, 1), (512, 4), (2048, 16))
MAX_WINDOW = 2048
N_HEADS_B = 8
DV_B = (D_MODEL // 2) // N_HEADS_B
DK_B = DV_B // 2
WIDTH_BQK = N_HEADS_B * DK_B
WIDTH_BV = N_HEADS_B * DV_B
MIX_WIDTH = WIDTH_A + WIDTH_BV
IN_WIDTH = 3 * WIDTH_A + 2 * WIDTH_BQK + 2 * WIDTH_BV
FFN_DIM = 5632
PLE_DIM = 256
RET_CHUNK = 128
LN_EPS = 1e-5
GN_EPS = 1e-5
NEG_INF = -1e30
DEEPNORM_ALPHA = (2 * DEPTH) ** 0.25
DEEPNORM_BETA = (8 * DEPTH) ** -0.25

kernel_name = "hybrid_dilated_attn_retention_decoder_step"


def alibi_slopes():
    h = jnp.arange(1, N_HEADS_A + 1, dtype=jnp.float32)
    return jnp.exp2(-8.0 * h / N_HEADS_A)


def retention_log_gamma():
    h = jnp.arange(N_HEADS_B, dtype=jnp.float32)
    return jnp.log(1.0 - jnp.exp2(-5.0 - h))


def layer_norm(x, g, b):
    xf = x.astype(jnp.float32)
    mu = xf.mean(-1, keepdims=True)
    var = jnp.mean(jnp.square(xf - mu), -1, keepdims=True)
    return ((xf - mu) * lax.rsqrt(var + LN_EPS) * g + b).astype(x.dtype)


def swiglu(x, w1, w3, w2):
    return (jax.nn.silu(x @ w1) * (x @ w3)) @ w2


def split_projection(h, w_in):
    B, T, _ = h.shape
    z = h @ w_in
    bounds = np.cumsum([WIDTH_A, WIDTH_A, WIDTH_A, WIDTH_BQK, WIDTH_BQK, WIDTH_BV]).tolist()
    qa, ka, va, qb, kb, vb, gb = jnp.split(z, bounds, axis=-1)
    heads = lambda a, n: a.reshape(B, T, n, -1)
    return (heads(qa, N_HEADS_A), heads(ka, N_HEADS_A), heads(va, N_HEADS_A),
            heads(qb, N_HEADS_B), heads(kb, N_HEADS_B) * (DK_B ** -0.5), heads(vb, N_HEADS_B), gb)


def strided_band_attention(q, k, v, window, dil):
    B, T, H, Dh = q.shape
    steps = window // dil
    L = T // dil
    C = steps
    nb = -(-L // C)
    Lp = nb * C

    def to_blocks(a):
        a = a.reshape(B, L, dil, H, Dh).transpose(0, 2, 1, 3, 4)
        a = jnp.pad(a, ((0, 0), (0, 0), (0, Lp - L), (0, 0), (0, 0)))
        return a.reshape(B, dil, nb, C, H, Dh)

    def with_prev(a):
        prev = jnp.pad(a[:, :, :-1], ((0, 0), (0, 0), (1, 0), (0, 0), (0, 0), (0, 0)))
        return jnp.concatenate([prev, a], axis=3)

    qs = to_blocks(q)
    kb = with_prev(to_blocks(k))
    vb = with_prev(to_blocks(v))
    s = jnp.einsum('brnqhd,brnkhd->brnhqk', qs, kb,
                   preferred_element_type=jnp.float32) * (HEAD_DIM ** -0.5)
    qi = jnp.arange(C)[:, None]
    ki = jnp.arange(2 * C)[None, :]
    dist = qi + C - ki
    blk = jnp.arange(nb)[:, None, None]
    valid = (dist >= 0) & (dist <= steps) & (blk * C + ki - C >= 0)
    bias = -alibi_slopes()[:, None, None] * (dist * dil).astype(jnp.float32)
    s = jnp.where(valid[:, None], s + bias, NEG_INF)
    lse = jax.nn.logsumexp(s, axis=-1)
    p = jnp.exp(s - lse[..., None])
    o = jnp.einsum('brnhqk,brnkhd->brnqhd', p.astype(v.dtype), vb)
    o = o.reshape(B, dil, Lp, H, Dh)[:, :, :L].transpose(0, 2, 1, 3, 4).reshape(B, T, H, Dh)
    lse = lse.transpose(0, 1, 2, 4, 3).reshape(B, dil, Lp, H)[:, :, :L]
    lse = lse.transpose(0, 2, 1, 3).reshape(B, T, H)
    return o, lse


def combine_dilations(outs, lses, dtype):
    w = jax.nn.softmax(jnp.stack(lses, 0), axis=0)
    o = jnp.einsum('gbth,gbthd->bthd', w, jnp.stack(outs, 0).astype(jnp.float32))
    return o.astype(dtype)


def dilated_attention_prompt(q, k, v):
    outs, lses = [], []
    for window, dil in DILATIONS:
        o, lse = strided_band_attention(q, k, v, window, dil)
        outs.append(o)
        lses.append(lse)
    return combine_dilations(outs, lses, q.dtype)


def dilated_attention_decode(q, k_all, v_all, n_past):
    S = q.shape[1]
    outs, lses = [], []
    for window, dil in DILATIONS:
        steps = window // dil
        j = jnp.arange(steps + 1)
        idx = n_past + jnp.arange(S)[:, None] - j[None, :] * dil
        valid = idx >= 0
        idx = jnp.maximum(idx, 0)
        kg = k_all[:, idx]
        vg = v_all[:, idx]
        s = jnp.einsum('bshd,bsjhd->bhsj', q, kg,
                       preferred_element_type=jnp.float32) * (HEAD_DIM ** -0.5)
        s = s - alibi_slopes()[:, None, None] * (j * dil).astype(jnp.float32)[None, None, :]
        s = jnp.where(valid[None, None], s, NEG_INF)
        lse = jax.nn.logsumexp(s, axis=-1)
        p = jnp.exp(s - lse[..., None])
        outs.append(jnp.einsum('bhsj,bsjhd->bshd', p.astype(vg.dtype), vg))
        lses.append(lse.transpose(0, 2, 1))
    return combine_dilations(outs, lses, q.dtype)


def retention(q, k, v, s0):
    B, T, H, _ = q.shape
    dv = v.shape[-1]
    C = RET_CHUNK if T % RET_CHUNK == 0 else T
    n = T // C
    log_g = retention_log_gamma()

    def chunks(a):
        return a.astype(jnp.float32).reshape(B, n, C, H, a.shape[-1]).transpose(1, 0, 2, 3, 4)

    pos = jnp.arange(C, dtype=jnp.float32)
    rel = pos[:, None] - pos[None, :]
    decay_mask = jnp.where(rel >= 0, jnp.exp(jnp.maximum(rel, 0.0)[None] * log_g[:, None, None]), 0.0)
    q_decay = jnp.exp((pos[:, None] + 1.0) * log_g[None])
    k_decay = jnp.exp((C - 1.0 - pos[:, None]) * log_g[None])
    chunk_decay = jnp.exp(C * log_g)

    def step(state, inp):
        qc, kc, vc = inp
        inner = jnp.einsum('bihd,bjhd->bhij', qc, kc) * decay_mask
        o = (jnp.einsum('bhij,bjhe->bihe', inner, vc)
             + jnp.einsum('bihd,bhde->bihe', qc, state) * q_decay[None, :, :, None])
        state = (state * chunk_decay[None, :, None, None]
                 + jnp.einsum('bjhd,bjhe->bhde', kc * k_decay[None, :, :, None], vc))
        return state, o

    s_final, o = lax.scan(step, s0.astype(jnp.float32), (chunks(q), chunks(k), chunks(v)))
    return o.transpose(1, 0, 2, 3, 4).reshape(B, T, H, dv), s_final


def retention_readout(o, gb, gn_g, gn_b):
    B, T, H, dv = o.shape
    mu = o.mean(-1, keepdims=True)
    var = jnp.mean(jnp.square(o - mu), -1, keepdims=True)
    on = ((o - mu) * lax.rsqrt(var + GN_EPS)).reshape(B, T, H * dv)
    return ((on * gn_g + gn_b) * jax.nn.silu(gb.astype(jnp.float32))).astype(gb.dtype)


def merge_heads(oa, ob, w_out):
    B, T = oa.shape[:2]
    return jnp.concatenate([oa.reshape(B, T, WIDTH_A), ob], axis=-1) @ w_out


def mix_prompt(h, w_in, w_out, gn_g, gn_b):
    B, T, _ = h.shape
    qa, ka, va, qb, kb, vb, gb = split_projection(h, w_in)
    oa = dilated_attention_prompt(qa, ka, va)
    s0 = jnp.zeros((B, N_HEADS_B, DK_B, DV_B), jnp.float32)
    ob, s_final = retention(qb, kb, vb, s0)
    out = merge_heads(oa, retention_readout(ob, gb, gn_g, gn_b), w_out)
    keep = min(MAX_WINDOW, T)
    return out, (ka[:, T - keep:], va[:, T - keep:], s_final.astype(h.dtype))


def mix_sample(h, cache_k, cache_v, state, w_in, w_out, gn_g, gn_b):
    qa, ka, va, qb, kb, vb, gb = split_projection(h, w_in)
    n_past = cache_k.shape[1]
    k_all = jnp.concatenate([cache_k.astype(ka.dtype), ka], axis=1)
    v_all = jnp.concatenate([cache_v.astype(va.dtype), va], axis=1)
    oa = dilated_attention_decode(qa, k_all, v_all, n_past)
    ob, s_final = retention(qb, kb, vb, state)
    out = merge_heads(oa, retention_readout(ob, gb, gn_g, gn_b), w_out)
    return out, (ka, va, s_final.astype(h.dtype))


def decoder_layer(x, p, mix_fn, f1_w1, f1_w3, f1_w2, f2_w1, f2_w3, f2_w2, ln_g, ln_b, w_ple, w_gate):
    x = layer_norm(DEEPNORM_ALPHA * x + 0.5 * swiglu(x, f1_w1, f1_w3, f1_w2), ln_g[0], ln_b[0])
    m, new_state = mix_fn(x)
    x = layer_norm(DEEPNORM_ALPHA * x + m, ln_g[1], ln_b[1])
    x = layer_norm(DEEPNORM_ALPHA * x + 0.5 * swiglu(x, f2_w1, f2_w3, f2_w2), ln_g[2], ln_b[2])
    ple = (p @ w_ple) * jax.nn.sigmoid(x @ w_gate)
    x = layer_norm(DEEPNORM_ALPHA * x + ple, ln_g[3], ln_b[3])
    return x, new_state


def setup_inputs(seed: int = 0) -> dict:
    key = jax.random.key(seed)
    ks = jax.random.split(key, 24)
    f32 = jnp.float32
    nrm = lambda k, shape, s: jax.random.normal(k, shape, f32) * s
    win_buf = min(MAX_WINDOW, PAST_LEN)
    col_scale = np.ones((IN_WIDTH,), np.float32)
    col_scale[2 * WIDTH_A:3 * WIDTH_A] = DEEPNORM_BETA
    vb0 = 3 * WIDTH_A + 2 * WIDTH_BQK
    col_scale[vb0:vb0 + WIDTH_BV] = DEEPNORM_BETA
    return {
        "x_prompt": nrm(ks[0], (BATCH, SEQ, D_MODEL), 1.0),
        "x_sample": nrm(ks[1], (DEC_BATCH, DEC_SEQ, D_MODEL), 1.0),
        "cache_k": nrm(ks[2], (DEPTH, DEC_BATCH, win_buf, N_HEADS_A, HEAD_DIM), 1.0),
        "cache_v": nrm(ks[3], (DEPTH, DEC_BATCH, win_buf, N_HEADS_A, HEAD_DIM), DEEPNORM_BETA),
        "state_ret": nrm(ks[4], (DEPTH, DEC_BATCH, N_HEADS_B, DK_B, DV_B), 0.5),
        "p_prompt": nrm(ks[5], (DEPTH, BATCH, SEQ, PLE_DIM), 1.0),
        "p_sample": nrm(ks[6], (DEPTH, DEC_BATCH, DEC_SEQ, PLE_DIM), 1.0),
        "w_in": nrm(ks[7], (DEPTH, D_MODEL, IN_WIDTH), D_MODEL ** -0.5) * jnp.asarray(col_scale),
        "w_out": nrm(ks[8], (DEPTH, MIX_WIDTH, D_MODEL), MIX_WIDTH ** -0.5 * DEEPNORM_BETA),
        "gn_g": 1.0 + nrm(ks[9], (DEPTH, WIDTH_BV), 0.02),
        "gn_b": nrm(ks[10], (DEPTH, WIDTH_BV), 0.02),
        "ffn1_w1": nrm(ks[11], (DEPTH, D_MODEL, FFN_DIM), D_MODEL ** -0.5 * DEEPNORM_BETA),
        "ffn1_w3": nrm(ks[12], (DEPTH, D_MODEL, FFN_DIM), D_MODEL ** -0.5 * DEEPNORM_BETA),
        "ffn1_w2": nrm(ks[13], (DEPTH, FFN_DIM, D_MODEL), FFN_DIM ** -0.5 * DEEPNORM_BETA),
        "ffn2_w1": nrm(ks[14], (DEPTH, D_MODEL, FFN_DIM), D_MODEL ** -0.5 * DEEPNORM_BETA),
        "ffn2_w3": nrm(ks[15], (DEPTH, D_MODEL, FFN_DIM), D_MODEL ** -0.5 * DEEPNORM_BETA),
        "ffn2_w2": nrm(ks[16], (DEPTH, FFN_DIM, D_MODEL), FFN_DIM ** -0.5 * DEEPNORM_BETA),
        "w_ple": nrm(ks[17], (DEPTH, PLE_DIM, D_MODEL), PLE_DIM ** -0.5 * DEEPNORM_BETA),
        "w_gate": nrm(ks[18], (DEPTH, D_MODEL, D_MODEL), D_MODEL ** -0.5),
        "ln_g": 1.0 + nrm(ks[19], (DEPTH, 4, D_MODEL), 0.02),
        "ln_b": nrm(ks[20], (DEPTH, 4, D_MODEL), 0.02),
    }


def reference(x_prompt, x_sample, cache_k, cache_v, state_ret, p_prompt, p_sample,
              w_in, w_out, gn_g, gn_b, ffn1_w1, ffn1_w3, ffn1_w2, ffn2_w1, ffn2_w3, ffn2_w2,
              w_ple, w_gate, ln_g, ln_b):
    xp, xs = x_prompt, x_sample
    kp, vp, sp, ksm, vsm, ssm = [], [], [], [], [], []
    for i in range(DEPTH):
        layer_w = (ffn1_w1[i], ffn1_w3[i], ffn1_w2[i], ffn2_w1[i], ffn2_w3[i], ffn2_w2[i],
                   ln_g[i], ln_b[i], w_ple[i], w_gate[i])
        mix_p = functools.partial(mix_prompt, w_in=w_in[i], w_out=w_out[i],
                                  gn_g=gn_g[i], gn_b=gn_b[i])
        mix_s = functools.partial(mix_sample, cache_k=cache_k[i], cache_v=cache_v[i],
                                  state=state_ret[i], w_in=w_in[i], w_out=w_out[i],
                                  gn_g=gn_g[i], gn_b=gn_b[i])
        xp, (k_i, v_i, s_i) = decoder_layer(xp, p_prompt[i], mix_p, *layer_w)
        xs, (k_j, v_j, s_j) = decoder_layer(xs, p_sample[i], mix_s, *layer_w)
        kp.append(k_i); vp.append(v_i); sp.append(s_i)
        ksm.append(k_j); vsm.append(v_j); ssm.append(s_j)
    return (xp, xs, jnp.stack(kp), jnp.stack(vp), jnp.stack(sp),
            jnp.stack(ksm), jnp.stack(vsm), jnp.stack(ssm))
```

```cpp
#include <hip/hip_runtime.h>
#include <cstdio>
#include <cstdint>
namespace nv {
constexpr int D = 2048, T = 2048, NB = 4, M = NB * T, DEPTH = 4, SB = 8, FF = 5632, INW = 6144, PLE = 256;
constexpr int HA = 8, HD = 128, HB = 8, DKB = 64, DVB = 128;
constexpr float ALPHA = 1.6817928305074290f;
constexpr float LN_EPS = 1e-5f, GN_EPS = 1e-5f;

__global__ void __launch_bounds__(256) gemm128(const float* __restrict__ A, int lda, const float* __restrict__ W, int ldw, float* __restrict__ C, int ldc, int K) {
    __shared__ float As[16][128 + 4];
    __shared__ float Bs[16][128 + 4];
    const int tid = threadIdx.x, tx = tid & 15, ty = tid >> 4;
    const int m0 = blockIdx.y * 128, n0 = blockIdx.x * 128;
    float acc[8][8];
#pragma unroll
    for (int i = 0; i < 8; ++i)
#pragma unroll
        for (int j = 0; j < 8; ++j) acc[i][j] = 0.f;
    for (int k0 = 0; k0 < K; k0 += 16) {
#pragma unroll
        for (int i = 0; i < 2; ++i) {
            const int idx = tid + i * 256;
            const int r = idx >> 2, c4 = (idx & 3) * 4;
            const float4 v = *(const float4*)(A + (size_t)(m0 + r) * lda + k0 + c4);
            As[c4 + 0][r] = v.x; As[c4 + 1][r] = v.y; As[c4 + 2][r] = v.z; As[c4 + 3][r] = v.w;
        }
#pragma unroll
        for (int i = 0; i < 2; ++i) {
            const int idx = tid + i * 256;
            const int r = idx >> 5, c4 = (idx & 31) * 4;
            const float4 v = *(const float4*)(W + (size_t)(k0 + r) * ldw + n0 + c4);
            *(float4*)&Bs[r][c4] = v;
        }
        __syncthreads();
#pragma unroll
        for (int kk = 0; kk < 16; ++kk) {
            float a[8], b[8];
#pragma unroll
            for (int i = 0; i < 8; ++i) a[i] = As[kk][ty * 8 + i];
#pragma unroll
            for (int j = 0; j < 8; ++j) b[j] = Bs[kk][tx * 8 + j];
#pragma unroll
            for (int i = 0; i < 8; ++i)
#pragma unroll
                for (int j = 0; j < 8; ++j) acc[i][j] = fmaf(a[i], b[j], acc[i][j]);
        }
        __syncthreads();
    }
#pragma unroll
    for (int i = 0; i < 8; ++i) {
        float* cp = C + (size_t)(m0 + ty * 8 + i) * ldc + n0 + tx * 8;
        *(float4*)cp = make_float4(acc[i][0], acc[i][1], acc[i][2], acc[i][3]);
        *(float4*)(cp + 4) = make_float4(acc[i][4], acc[i][5], acc[i][6], acc[i][7]);
    }
}
__global__ void __launch_bounds__(256) gemm8(const float* __restrict__ A, int lda, const float* __restrict__ W, int ldw, float* __restrict__ C, int ldc, int K, int N) {
    const int n = blockIdx.x * 256 + threadIdx.x;
    if (n >= N) return;
    float acc[8];
#pragma unroll
    for (int i = 0; i < 8; ++i) acc[i] = 0.f;
    for (int k = 0; k < K; ++k) {
        const float w = W[(size_t)k * ldw + n];
#pragma unroll
        for (int i = 0; i < 8; ++i) acc[i] = fmaf(A[(size_t)i * lda + k], w, acc[i]);
    }
#pragma unroll
    for (int i = 0; i < 8; ++i) C[(size_t)i * ldc + n] = acc[i];
}
__device__ __forceinline__ float block_sum256(float v, float* red) {
#pragma unroll
    for (int o = 32; o > 0; o >>= 1) v += __shfl_xor(v, o);
    __syncthreads();
    if ((threadIdx.x & 63) == 0) red[threadIdx.x >> 6] = v;
    __syncthreads();
    return red[0] + red[1] + red[2] + red[3];
}
__global__ void __launch_bounds__(256) res_ln(float* __restrict__ x, const float* __restrict__ t, float scale, const float* __restrict__ g, const float* __restrict__ b) {
    __shared__ float red[4];
    const size_t row = blockIdx.x;
    float v[8]; float s = 0.f;
#pragma unroll
    for (int i = 0; i < 8; ++i) { const int c = threadIdx.x + 256 * i; v[i] = ALPHA * x[row * D + c] + scale * t[row * D + c]; s += v[i]; }
    const float mu = block_sum256(s, red) * (1.f / D);
    float q = 0.f;
#pragma unroll
    for (int i = 0; i < 8; ++i) { const float d = v[i] - mu; q += d * d; }
    const float var = block_sum256(q, red) * (1.f / D);
    const float rstd = 1.0f / sqrtf(var + LN_EPS);
#pragma unroll
    for (int i = 0; i < 8; ++i) { const int c = threadIdx.x + 256 * i; x[row * D + c] = (v[i] - mu) * rstd * g[c] + b[c]; }
}
__device__ __forceinline__ float silu_f(float v) { return v / (1.f + expf(-v)); }
__global__ void __launch_bounds__(256) swiglu_k(float* __restrict__ g1, const float* __restrict__ g3, size_t n) {
    size_t i = (size_t)blockIdx.x * 256 + threadIdx.x;
    for (; i < n; i += (size_t)gridDim.x * 256) g1[i] = silu_f(g1[i]) * g3[i];
}
__global__ void __launch_bounds__(256) gate_k(float* __restrict__ gt, const float* __restrict__ pw, size_t n) {
    size_t i = (size_t)blockIdx.x * 256 + threadIdx.x;
    for (; i < n; i += (size_t)gridDim.x * 256) gt[i] = pw[i] / (1.f + expf(-gt[i]));
}
__global__ void __launch_bounds__(256) copy_k(float* __restrict__ dst, const float* __restrict__ src, size_t n) {
    size_t i = (size_t)blockIdx.x * 256 + threadIdx.x;
    for (; i < n; i += (size_t)gridDim.x * 256) dst[i] = src[i];
}
__global__ void __launch_bounds__(256) cols_k(float* __restrict__ dst, const float* __restrict__ z, int c0, int w, size_t rows, float scale) {
    size_t i = (size_t)blockIdx.x * 256 + threadIdx.x;
    const size_t n = rows * (size_t)w;
    for (; i < n; i += (size_t)gridDim.x * 256) { const size_t r = i / w; const int c = (int)(i % w); dst[i] = z[r * INW + c0 + c] * scale; }
}
template <bool DECODE>
__global__ void __launch_bounds__(64) attn_k(const float* __restrict__ z, const float* __restrict__ ck, const float* __restrict__ cv, float* __restrict__ oa) {
    const int lane = threadIdx.x, h = blockIdx.x & 7, row = blockIdx.x >> 3;
    const int b = DECODE ? row : row / T, t = DECODE ? 0 : row % T;
    const float slope = exp2f(-(float)(h + 1));
    const float* q = z + (size_t)row * INW + h * HD;
    float sc[7]; const float* vp[7];
    float mx = -3.0e38f;
#pragma unroll
    for (int c = 0; c < 7; ++c) {
        const int i = lane + 64 * c; sc[c] = -3.0e38f; vp[c] = nullptr;
        if (i < 387) {
            const int gsel = i / 129, j = i % 129, dd = 1 << (2 * gsel);
            bool valid; const float* kr; const float* vr;
            if (DECODE) {
                valid = true;
                if (j == 0) { kr = z + (size_t)row * INW + 1024 + h * HD; vr = z + (size_t)row * INW + 2048 + h * HD; }
                else { const int idx = 2048 - j * dd; kr = ck + (((size_t)b * 2048 + idx) * 8 + h) * HD; vr = cv + (((size_t)b * 2048 + idx) * 8 + h) * HD; }
            } else {
                const int kt = t - j * dd; valid = kt >= 0;
                const size_t kr_row = (size_t)b * T + (valid ? kt : 0);
                kr = z + kr_row * INW + 1024 + h * HD; vr = z + kr_row * INW + 2048 + h * HD;
            }
            if (valid) {
                float dot = 0.f;
                for (int d = 0; d < HD; ++d) dot = fmaf(q[d], kr[d], dot);
                sc[c] = dot * 0.08838834764831845f - slope * (float)(j * dd);
                vp[c] = vr;
                mx = fmaxf(mx, sc[c]);
            }
        }
    }
#pragma unroll
    for (int o = 32; o > 0; o >>= 1) mx = fmaxf(mx, __shfl_xor(mx, o));
    float l = 0.f;
#pragma unroll
    for (int c = 0; c < 7; ++c) { sc[c] = (vp[c] != nullptr) ? expf(sc[c] - mx) : 0.f; l += sc[c]; }
#pragma unroll
    for (int o = 32; o > 0; o >>= 1) l += __shfl_xor(l, o);
    float o0 = 0.f, o1 = 0.f;
#pragma unroll
    for (int c = 0; c < 7; ++c) {
        for (int s = 0; s < 64; ++s) {
            const float p = __shfl(sc[c], s);
            const unsigned long long vpl = (unsigned long long)vp[c];
            const unsigned lo = __shfl((unsigned)vpl, s), hi = __shfl((unsigned)(vpl >> 32), s);
            const float* vr = (const float*)(((unsigned long long)hi << 32) | lo);
            if (vr != nullptr) { o0 = fmaf(p, vr[2 * lane], o0); o1 = fmaf(p, vr[2 * lane + 1], o1); }
        }
    }
    const float inv = 1.f / l;
    oa[(size_t)row * 1024 + h * HD + 2 * lane] = o0 * inv;
    oa[(size_t)row * 1024 + h * HD + 2 * lane + 1] = o1 * inv;
}
__global__ void __launch_bounds__(256) ret_k(const float* __restrict__ z, const float* __restrict__ s0, float* __restrict__ ob, float* __restrict__ sfin, int Tn) {
    __shared__ float qs[64], ks[64], part[256];
    const int tid = threadIdx.x, e = tid & 127, dh = tid >> 7, h = blockIdx.x & 7, b = blockIdx.x >> 3;
    const float gam = 1.f - exp2f(-5.f - (float)h);
    float S[32];
#pragma unroll
    for (int i = 0; i < 32; ++i) S[i] = s0 ? s0[(((size_t)b * 8 + h) * 64 + dh * 32 + i) * 128 + e] : 0.f;
    for (int t = 0; t < Tn; ++t) {
        const size_t row = (size_t)b * Tn + t;
        __syncthreads();
        if (tid < 64) qs[tid] = z[row * INW + 3072 + h * 64 + tid];
        else if (tid < 128) ks[tid - 64] = z[row * INW + 3584 + h * 64 + (tid - 64)] * 0.125f;
        const float v = z[row * INW + 4096 + h * 128 + e];
        __syncthreads();
        float o = 0.f;
#pragma unroll
        for (int i = 0; i < 32; ++i) { S[i] = fmaf(gam, S[i], ks[dh * 32 + i] * v); o = fmaf(qs[dh * 32 + i], S[i], o); }
        part[tid] = o;
        __syncthreads();
        if (tid < 128) ob[row * 1024 + h * 128 + e] = part[tid] + part[tid + 128];
    }
#pragma unroll
    for (int i = 0; i < 32; ++i) sfin[(((size_t)b * 8 + h) * 64 + dh * 32 + i) * 128 + e] = S[i];
}
__global__ void __launch_bounds__(64) readout_k(const float* __restrict__ z, const float* __restrict__ oa, const float* __restrict__ ob, const float* __restrict__ gng, const float* __restrict__ gnb, float* __restrict__ mix) {
    const int lane = threadIdx.x, h = blockIdx.x & 7; const size_t row = blockIdx.x >> 3;
    const float a0 = ob[row * 1024 + h * 128 + 2 * lane], a1 = ob[row * 1024 + h * 128 + 2 * lane + 1];
    float s = a0 + a1;
#pragma unroll
    for (int o = 32; o > 0; o >>= 1) s += __shfl_xor(s, o);
    const float mu = s * (1.f / 128.f);
    float q = (a0 - mu) * (a0 - mu) + (a1 - mu) * (a1 - mu);
#pragma unroll
    for (int o = 32; o > 0; o >>= 1) q += __shfl_xor(q, o);
    const float rstd = 1.0f / sqrtf(q * (1.f / 128.f) + GN_EPS);
    const int c = h * 128 + 2 * lane;
    const float g0 = z[row * INW + 5120 + c], g1 = z[row * INW + 5120 + c + 1];
    mix[row * D + 1024 + c] = ((a0 - mu) * rstd * gng[c] + gnb[c]) * silu_f(g0);
    mix[row * D + 1024 + c + 1] = ((a1 - mu) * rstd * gng[c + 1] + gnb[c + 1]) * silu_f(g1);
    mix[row * D + c] = oa[row * 1024 + c]; mix[row * D + c + 1] = oa[row * 1024 + c + 1];
}

struct Bufs { float *X, *G1, *G3, *Z, *OA, *OB, *MIX, *TT, *PW; };
inline void gemm(hipStream_t st, const float* A, int lda, const float* W, int N, float* C, int ldc, int K, int Mrows) {
    if (Mrows == 8) hipLaunchKernelGGL(gemm8, dim3((N + 255) / 256), dim3(256), 0, st, A, lda, W, N, C, ldc, K, N);
    else hipLaunchKernelGGL(gemm128, dim3(N / 128, Mrows / 128), dim3(256), 0, st, A, lda, W, N, C, ldc, K);
}
inline void forward(hipStream_t st, bool sample, void* const* d_in, float* out, const Bufs& B) {
    const int Mr = sample ? SB : M;
    const float* xin = (const float*)d_in[sample ? 1 : 0];
    const float* cache_k = (const float*)d_in[2]; const float* cache_v = (const float*)d_in[3]; const float* state = (const float*)d_in[4];
    const float* pin = (const float*)d_in[sample ? 6 : 5];
    const float *w_in = (const float*)d_in[7], *w_out = (const float*)d_in[8], *gn_g = (const float*)d_in[9], *gn_b = (const float*)d_in[10];
    const float *f1w1 = (const float*)d_in[11], *f1w3 = (const float*)d_in[12], *f1w2 = (const float*)d_in[13];
    const float *f2w1 = (const float*)d_in[14], *f2w3 = (const float*)d_in[15], *f2w2 = (const float*)d_in[16];
    const float *w_ple = (const float*)d_in[17], *w_gate = (const float*)d_in[18], *ln_g = (const float*)d_in[19], *ln_b = (const float*)d_in[20];
    const size_t O_YP = 0, O_YS = O_YP + (size_t)M * D, O_KP = O_YS + (size_t)SB * D, O_VP = O_KP + (size_t)DEPTH * M * 1024, O_RP = O_VP + (size_t)DEPTH * M * 1024,
                 O_KS = O_RP + (size_t)DEPTH * NB * 8 * 64 * 128, O_VS = O_KS + (size_t)DEPTH * SB * 1024, O_RS = O_VS + (size_t)DEPTH * SB * 1024;
    const size_t nX = (size_t)Mr * D;
    hipLaunchKernelGGL(copy_k, dim3(2048), dim3(256), 0, st, B.X, xin, nX);
    for (int l = 0; l < DEPTH; ++l) {
        const float* lg = ln_g + (size_t)l * 4 * D; const float* lb = ln_b + (size_t)l * 4 * D;
        for (int f = 0; f < 2; ++f) {
            if (f == 1) {
                gemm(st, B.X, D, w_in + (size_t)l * D * INW, INW, B.Z, INW, D, Mr);
                float* ko = out + (sample ? O_KS + (size_t)l * SB * 1024 : O_KP + (size_t)l * M * 1024);
                float* vo = out + (sample ? O_VS + (size_t)l * SB * 1024 : O_VP + (size_t)l * M * 1024);
                hipLaunchKernelGGL(cols_k, dim3(2048), dim3(256), 0, st, ko, B.Z, 1024, 1024, (size_t)Mr, 1.0f);
                hipLaunchKernelGGL(cols_k, dim3(2048), dim3(256), 0, st, vo, B.Z, 2048, 1024, (size_t)Mr, 1.0f);
                if (sample) {
                    hipLaunchKernelGGL(attn_k<true>, dim3(Mr * 8), dim3(64), 0, st, B.Z, cache_k + (size_t)l * SB * 2048 * 1024, cache_v + (size_t)l * SB * 2048 * 1024, B.OA);
                    hipLaunchKernelGGL(ret_k, dim3(SB * 8), dim3(256), 0, st, B.Z, state + (size_t)l * SB * 8 * 64 * 128, B.OB, out + O_RS + (size_t)l * SB * 8 * 64 * 128, 1);
                } else {
                    hipLaunchKernelGGL(attn_k<false>, dim3(Mr * 8), dim3(64), 0, st, B.Z, (const float*)nullptr, (const float*)nullptr, B.OA);
                    hipLaunchKernelGGL(ret_k, dim3(NB * 8), dim3(256), 0, st, B.Z, (const float*)nullptr, B.OB, out + O_RP + (size_t)l * NB * 8 * 64 * 128, T);
                }
                hipLaunchKernelGGL(readout_k, dim3(Mr * 8), dim3(64), 0, st, B.Z, B.OA, B.OB, gn_g + (size_t)l * 1024, gn_b + (size_t)l * 1024, B.MIX);
                gemm(st, B.MIX, D, w_out + (size_t)l * D * D, D, B.TT, D, D, Mr);
                hipLaunchKernelGGL(res_ln, dim3(Mr), dim3(256), 0, st, B.X, B.TT, 1.0f, lg + 1 * D, lb + 1 * D);
            }
            const float* w1 = (f ? f2w1 : f1w1) + (size_t)l * D * FF; const float* w3 = (f ? f2w3 : f1w3) + (size_t)l * D * FF; const float* w2 = (f ? f2w2 : f1w2) + (size_t)l * FF * D;
            gemm(st, B.X, D, w1, FF, B.G1, FF, D, Mr);
            gemm(st, B.X, D, w3, FF, B.G3, FF, D, Mr);
            hipLaunchKernelGGL(swiglu_k, dim3(4096), dim3(256), 0, st, B.G1, B.G3, (size_t)Mr * FF);
            gemm(st, B.G1, FF, w2, D, B.TT, D, FF, Mr);
            hipLaunchKernelGGL(res_ln, dim3(Mr), dim3(256), 0, st, B.X, B.TT, 0.5f, lg + (f ? 2 : 0) * D, lb + (f ? 2 : 0) * D);
        }
        gemm(st, pin + (size_t)l * Mr * PLE, PLE, w_ple + (size_t)l * PLE * D, D, B.PW, D, PLE, Mr);
        gemm(st, B.X, D, w_gate + (size_t)l * D * D, D, B.TT, D, D, Mr);
        hipLaunchKernelGGL(gate_k, dim3(2048), dim3(256), 0, st, B.TT, B.PW, nX);
        hipLaunchKernelGGL(res_ln, dim3(Mr), dim3(256), 0, st, B.X, B.TT, 1.0f, lg + 3 * D, lb + 3 * D);
    }
    hipLaunchKernelGGL(copy_k, dim3(2048), dim3(256), 0, st, out + (sample ? O_YS : O_YP), B.X, nX);
}
}

extern "C" void kernel_launch(void* const* d_in, const int* in_sizes, int n_in, void* d_out, int out_size, void* d_ws, size_t ws_size, hipStream_t stream) {
    using namespace nv;
    float* w = (float*)d_ws; size_t o = 0;
    Bufs B;
    B.X = w + o; o += (size_t)M * D; B.G1 = w + o; o += (size_t)M * FF; B.G3 = w + o; o += (size_t)M * FF; B.Z = w + o; o += (size_t)M * INW;
    B.OA = w + o; o += (size_t)M * 1024; B.OB = w + o; o += (size_t)M * 1024; B.MIX = w + o; o += (size_t)M * D; B.TT = w + o; o += (size_t)M * D; B.PW = w + o; o += (size_t)M * D;
    if (o * 4 > ws_size) { fprintf(stderr, "workspace too small\n"); return; }
    forward(stream, false, d_in, (float*)d_out, B);
    forward(stream, true, d_in, (float*)d_out, B);
}
```

```cpp
#include <hip/hip_runtime.h>
#include <cstdio>
#include <cstdint>

namespace pg8 {
#define PG8_LAS __attribute__((address_space(3)))
typedef unsigned short bf16_t;
typedef short bf16x8 __attribute__((ext_vector_type(8)));
typedef float f32x4 __attribute__((ext_vector_type(4)));
typedef unsigned u32x4 __attribute__((ext_vector_type(4)));
constexpr int BM = 256, BK = 64, HALF = 128, HTB = HALF * BK * 2  , STAGE_BYTES = 8 * HTB, NXCD = 8, WGM = 8;

__host__ __device__ __forceinline__ int lds_byte(int r, int c) { const int st = (r >> 4) * 2 + (c >> 5), rr = r & 15, cc = c & 31, ob = rr * 64 + cc * 2; return st * 1024 + (ob ^ (((ob >> 9) & 1) << 5)); }
__host__ __device__ __forceinline__ void stage_rc(int b, int& R, int& C) { const int st = b / 1024, sb = b % 1024, swz = sb ^ (((sb >> 9) & 1) << 5); R = (st >> 1) * 16 + swz / 64; C = (st & 1) * 32 + (swz % 64) / 2; }
__host__ __device__ __forceinline__ int perm32(int rho) { const int n = rho >> 4, i = rho & 15; return 8 * (i >> 2) + 4 * n + (i & 3); }

struct Unit { int pm, pn, idx, half; };
struct Gemm { const bf16_t* A; const bf16_t* Bt; int M, N, K; };

struct StaticOrder {
    int nM, nN, nwg, G, c, lim;
    __host__ __device__ void init(int M, int N, int G_, int c_) { nM = M / BM; nN = N / BM; nwg = nM * nN; G = G_; c = c_; lim = nwg; }
    __host__ __device__ bool next(int i, Unit& u) const {
        const long L = (long)i * G + c; if (L >= lim) return false;
        int wgid = (int)L; { const int q = nwg / NXCD, r = nwg % NXCD, xcd = wgid % NXCD, off = wgid / NXCD; wgid = (xcd < r ? xcd * (q + 1) : r * (q + 1) + (xcd - r) * q) + off; }
        const int nig = WGM * nN, gid = wgid / nig, fm = gid * WGM, gsz = (nM - fm) < WGM ? (nM - fm) : WGM;
        u.pm = fm + ((wgid % nig) % gsz); u.pn = (wgid % nig) / gsz; u.idx = i; u.half = 0; return true;
    }
    __device__ __forceinline__ void a_ready(const Unit&) const {}
    __device__ __forceinline__ void done(const Unit&) const {}
};

__device__ __forceinline__ unsigned cvt_pk_bf16(float lo, float hi) { unsigned r; asm volatile("v_cvt_pk_bf16_f32 %0, %1, %2" : "=v"(r) : "v"(lo), "v"(hi)); return r; }
typedef float f32x2 __attribute__((ext_vector_type(2)));
struct NoPre { __device__ __forceinline__ void operator()() const {} };
template <class S_> struct has_chain { template <class T> static auto f(int) -> decltype(T::HAS_CHAIN, char()); template <class T> static long f(...); static constexpr bool value = sizeof(f<S_>(0)) == 1; };
template <class Epi, class Sched, bool ALIGN_EPI = false, bool SP2 = false, bool HALF_M = false, bool FP8 = false, class Pre = NoPre, bool PRELOADED = false, class Mid = NoPre>
__device__ __forceinline__ void gemm_phase(PG8_LAS unsigned char* lds, const Gemm g, const Sched& S, const Epi& E, int wave_in, const Pre& pre = Pre(), const Mid& mid = Mid()) {
    unsigned z_op = 0u; asm volatile("" : "+s"(z_op));
    int tid_op = (int)__builtin_amdgcn_mbcnt_hi(~0u, __builtin_amdgcn_mbcnt_lo(~0u, z_op)) + 64 * wave_in; asm volatile("" : "+v"(tid_op));
    const int tid = tid_op, wid = __builtin_amdgcn_readfirstlane(tid >> 6), lane = tid & 63, wr = wid >> 2, wc = wid & 3, fr = lane & 15, fq = lane >> 4;
    const int K = g.K, nt = K / BK;
    unsigned voffA[2], voffB[2];
#pragma unroll
    for (int i = 0; i < 2; ++i) { int R, C; stage_rc(tid * 16 + i * 8192, R, C); const int Rb = Epi::PERM ? ((R & ~31) + perm32(R & 31)) : R;
        voffA[i] = (unsigned)(R * K + C) * 2u; voffB[i] = (unsigned)(Rb * K + C) * 2u; }
    const int p1step = 64 * K * 2;
    const size_t kstep = (size_t)(BK * 2);
    const size_t hstep = (size_t)HALF * K * 2;
    const size_t tstep = 2 * hstep;
    const size_t hstepA = HALF_M ? (size_t)0 : hstep;
    static_assert(!HALF_M || SP2, "HALF_M is written for the SP2 loop");
    const unsigned ldsw = (unsigned)wid * 1024u;
    const int aoff = lds_byte(wr * 64 + fr, fq * 8), boff = lds_byte(wc * 32 + fr, fq * 8);
#define PG8_SA(b, h) (((b) * 2 + (h)) * HTB)
#define PG8_SB(b, h) ((4 + (b) * 2 + (h)) * HTB)
    const char* base_voffA = (const char*)g.A; const char* base_voffB = (const char*)g.Bt;
    const __amdgpu_buffer_rsrc_t rsrc_voffA = __builtin_amdgcn_make_buffer_rsrc((void*)g.A, (short)0, 0x7fffffff, 0x00020000), rsrc_voffB = __builtin_amdgcn_make_buffer_rsrc((void*)g.Bt, (short)0, 0x7fffffff, 0x00020000);
#define PG8_STAGE(bufoff, gbase, voff) do { const int so_ = (int)((gbase) - base_##voff); _Pragma("unroll") for (int _i = 0; _i < 2; ++_i) \
        __builtin_amdgcn_raw_ptr_buffer_load_lds(rsrc_##voff, (PG8_LAS void*)(lds + (bufoff) + ldsw + _i * 8192), 16, (int)(voff)[0], so_ + _i * p1step, 0, 0); } while (0)
#define PG8_LDA(dst, b, h) do { _Pragma("unroll") for (int m = 0; m < 4; ++m) _Pragma("unroll") for (int k = 0; k < 2; ++k) dst[m][k] = *(const PG8_LAS bf16x8*)(lds + PG8_SA(b, h) + aoff + m * 2048 + k * 1024); } while (0)
#define PG8_LDB(dst, b, h) do { _Pragma("unroll") for (int n = 0; n < 2; ++n) _Pragma("unroll") for (int k = 0; k < 2; ++k) dst[n][k] = *(const PG8_LAS bf16x8*)(lds + PG8_SB(b, h) + boff + n * 2048 + k * 1024); } while (0)
#define PG8_MMA(ai, bj, At, Bt) do { __builtin_amdgcn_s_setprio(1); _Pragma("unroll") for (int m = 0; m < 4; ++m) _Pragma("unroll") for (int n = 0; n < 2; ++n) { \
        if constexpr (FP8) {   \
            typedef int pg8_v8i __attribute__((ext_vector_type(8))); typedef int pg8_v4i __attribute__((ext_vector_type(4))); \
            const pg8_v4i b0_ = __builtin_bit_cast(pg8_v4i, Bt[n][0]), b1_ = __builtin_bit_cast(pg8_v4i, Bt[n][1]), a0_ = __builtin_bit_cast(pg8_v4i, At[m][0]), a1_ = __builtin_bit_cast(pg8_v4i, At[m][1]); \
            const pg8_v8i bb_ = (pg8_v8i){b0_[0], b0_[1], b0_[2], b0_[3], b1_[0], b1_[1], b1_[2], b1_[3]}, aa_ = (pg8_v8i){a0_[0], a0_[1], a0_[2], a0_[3], a1_[0], a1_[1], a1_[2], a1_[3]}; \
            acc[ai][bj][m][n] = __builtin_amdgcn_mfma_scale_f32_16x16x128_f8f6f4(bb_, aa_, acc[ai][bj][m][n], 0, 0, 0, 0x7F7F7F7F, 0, 0x7F7F7F7F); \
        } else { _Pragma("unroll") for (int k = 0; k < 2; ++k) \
        acc[ai][bj][m][n] = __builtin_amdgcn_mfma_f32_16x16x32_bf16(Bt[n][k], At[m][k], acc[ai][bj][m][n], 0, 0, 0); } } __builtin_amdgcn_s_setprio(0); } while (0)
#define PG8_WAIT_V(n) asm volatile("s_waitcnt vmcnt(" #n ")" ::: "memory")
#define PG8_WAIT_L(n) asm volatile("s_waitcnt lgkmcnt(" #n ")" ::: "memory")
#define PG8_BAR __builtin_amdgcn_s_barrier()
#define PG8_SCHED __builtin_amdgcn_sched_barrier(0)
    Unit cur, nxt; int ui = 0;
    if (!S.next(0, cur)) return;
    f32x4 acc[2][2][4][2];
#pragma unroll
    for (int a = 0; a < 2; ++a)
#pragma unroll
        for (int b = 0; b < 2; ++b)
#pragma unroll
            for (int m = 0; m < 4; ++m)
#pragma unroll
                for (int n = 0; n < 2; ++n) acc[a][b][m][n] = (f32x4){0.f, 0.f, 0.f, 0.f};
    bf16x8 At[4][2], B0[2][2], B1[2][2];
    const char* cA = (const char*)g.A + (size_t)cur.pm * tstep + (HALF_M ? (size_t)cur.half * hstep : (size_t)0); const char* cB = (const char*)g.Bt + (size_t)cur.pn * tstep;
    S.a_ready(cur);
    if constexpr (SP2 && PRELOADED) {
        pre();
        if (wr == 1) PG8_BAR;
        PG8_BAR;
        PG8_BAR;
    } else if constexpr (SP2) {
        PG8_STAGE(PG8_SB(0, 0), cB, voffB); PG8_STAGE(PG8_SB(0, 1), cB + hstep, voffB); PG8_STAGE(PG8_SA(0, 0), cA, voffA); if constexpr (!HALF_M) PG8_STAGE(PG8_SA(0, 1), cA + hstepA, voffA);
        pre();
        if (wr == 1) PG8_BAR;
        if constexpr (HALF_M) PG8_WAIT_V(0); else PG8_WAIT_V(2); PG8_BAR;
        PG8_STAGE(PG8_SB(1, 0), cB + kstep, voffB); PG8_STAGE(PG8_SA(1, 0), cA + kstep, voffA); PG8_STAGE(PG8_SB(1, 1), cB + hstep + kstep, voffB);
        PG8_WAIT_V(6); PG8_BAR;
    } else {
        PG8_STAGE(PG8_SB(0, 0), cB, voffB); PG8_STAGE(PG8_SA(0, 0), cA, voffA); PG8_STAGE(PG8_SB(0, 1), cB + hstep, voffB); PG8_STAGE(PG8_SA(0, 1), cA + hstepA, voffA);
        pre();
        if (wr == 1) PG8_BAR;
        PG8_WAIT_V(4); PG8_BAR;
        PG8_STAGE(PG8_SB(1, 0), cB + kstep, voffB); PG8_STAGE(PG8_SA(1, 0), cA + kstep, voffA); PG8_STAGE(PG8_SB(1, 1), cB + hstep + kstep, voffB);
        PG8_WAIT_V(6); PG8_BAR;
    }
    for (;;) {
        const bool has_next = S.next(ui + 1, nxt);
        bool pf = has_next;
        if constexpr (has_chain<Sched>::value) { if (!has_next) pf = S.chain(nxt); }
        const char* nA = pf ? (const char*)g.A + (size_t)nxt.pm * tstep + ((HALF_M || has_chain<Sched>::value) ? (size_t)nxt.half * hstep : (size_t)0) : cA; const char* nB = pf ? (const char*)g.Bt + (size_t)nxt.pn * tstep : cB;
        for (int t = 0; t < nt; t += 2) {
            const bool last = (t == nt - 2);
            const char* a1 = cA + (size_t)(t + 1) * kstep;
            const char* a2 = last ? nA : cA + (size_t)(t + 2) * kstep; const char* b2 = last ? nB : cB + (size_t)(t + 2) * kstep;
            const char* a3 = a2 + kstep; const char* b3 = b2 + kstep;
            if (last && has_next) S.a_ready(nxt);
            if constexpr (SP2) {
            PG8_LDB(B0, 0, 0); PG8_LDB(B1, 0, 1); PG8_SCHED; PG8_LDA(At, 0, 0); if constexpr (!HALF_M) PG8_STAGE(PG8_SA(1, 1), a1 + hstepA, voffA);
            PG8_WAIT_V(8); PG8_WAIT_L(0); PG8_BAR; PG8_MMA(0, 0, At, B0); PG8_MMA(0, 1, At, B1); PG8_BAR; PG8_SCHED;
            if constexpr (!HALF_M) PG8_LDA(At, 0, 1); PG8_STAGE(PG8_SB(0, 0), b2, voffB); PG8_STAGE(PG8_SB(0, 1), b2 + hstep, voffB); PG8_STAGE(PG8_SA(0, 0), a2, voffA);
            if constexpr (HALF_M) PG8_WAIT_V(6); else PG8_WAIT_V(8); PG8_WAIT_L(0); PG8_BAR; if constexpr (!HALF_M) { PG8_MMA(1, 0, At, B0); PG8_MMA(1, 1, At, B1); } PG8_BAR; PG8_SCHED;
            PG8_LDB(B0, 1, 0); PG8_LDB(B1, 1, 1); PG8_SCHED; PG8_LDA(At, 1, 0); if constexpr (!HALF_M) PG8_STAGE(PG8_SA(0, 1), a2 + hstepA, voffA);
            PG8_WAIT_V(8); PG8_WAIT_L(0); PG8_BAR; PG8_MMA(0, 0, At, B0); PG8_MMA(0, 1, At, B1); PG8_BAR; PG8_SCHED;
            if constexpr (!HALF_M) PG8_LDA(At, 1, 1); PG8_STAGE(PG8_SB(1, 0), b3, voffB); PG8_STAGE(PG8_SB(1, 1), b3 + hstep, voffB); PG8_STAGE(PG8_SA(1, 0), a3, voffA);
            if constexpr (HALF_M) PG8_WAIT_V(6); else PG8_WAIT_V(8); PG8_WAIT_L(0); PG8_BAR; if constexpr (!HALF_M) { PG8_MMA(1, 0, At, B0); PG8_MMA(1, 1, At, B1); } PG8_BAR; PG8_SCHED;
            } else {
            PG8_LDB(B0, 0, 0); PG8_SCHED; PG8_LDA(At, 0, 0); PG8_STAGE(PG8_SA(1, 1), a1 + hstepA, voffA);
            PG8_WAIT_L(8); PG8_BAR; PG8_WAIT_L(0); PG8_MMA(0, 0, At, B0); PG8_BAR; PG8_SCHED;
            PG8_LDB(B1, 0, 1); PG8_STAGE(PG8_SB(0, 0), b2, voffB);
            PG8_BAR; PG8_WAIT_L(0); PG8_MMA(0, 1, At, B1); PG8_BAR;
            PG8_LDA(At, 0, 1); PG8_STAGE(PG8_SA(0, 0), a2, voffA);
            PG8_BAR; PG8_WAIT_L(0); PG8_MMA(1, 0, At, B0); PG8_BAR; PG8_SCHED;
            PG8_STAGE(PG8_SB(0, 1), b2 + hstep, voffB);
            PG8_WAIT_V(6); PG8_BAR; PG8_MMA(1, 1, At, B1); PG8_BAR;
            PG8_LDB(B0, 1, 0); PG8_SCHED; PG8_LDA(At, 1, 0); PG8_STAGE(PG8_SA(0, 1), a2 + hstepA, voffA);
            PG8_WAIT_L(8); PG8_BAR; PG8_WAIT_L(0); PG8_MMA(0, 0, At, B0); PG8_BAR; PG8_SCHED;
            PG8_LDB(B1, 1, 1); PG8_STAGE(PG8_SB(1, 0), b3, voffB);
            PG8_BAR; PG8_WAIT_L(0); PG8_MMA(0, 1, At, B1); PG8_BAR;
            PG8_LDA(At, 1, 1); PG8_STAGE(PG8_SA(1, 0), a3, voffA);
            PG8_BAR; PG8_WAIT_L(0); PG8_MMA(1, 0, At, B0); PG8_BAR; PG8_SCHED;
            PG8_STAGE(PG8_SB(1, 1), b3 + hstep, voffB);
            PG8_WAIT_V(6); PG8_BAR; PG8_MMA(1, 1, At, B1); PG8_BAR;
            }
        }
        if constexpr (ALIGN_EPI) { if (wr == 0) PG8_BAR; }
        if constexpr (!Epi::AFTER_DRAIN) { E(acc, cur, wr, wc, fr, fq); S.done(cur); }
        if (!has_next) break;
#pragma unroll
        for (int a = 0; a < 2; ++a)
#pragma unroll
            for (int b = 0; b < 2; ++b)
#pragma unroll
                for (int m = 0; m < 4; ++m)
#pragma unroll
                    for (int n = 0; n < 2; ++n) acc[a][b][m][n] = (f32x4){0.f, 0.f, 0.f, 0.f};
        cur = nxt; cA = nA; cB = nB; ++ui;
        if constexpr (ALIGN_EPI) { if (wr == 1) PG8_BAR; }
    }
    PG8_WAIT_V(0);
    if constexpr (!ALIGN_EPI) { if (wr == 0) PG8_BAR; }
    PG8_BAR;
    if constexpr (Epi::AFTER_DRAIN) { mid(); E.fused(acc, cur, wr, wc, fr, fq, lds, wid, lane); S.done(cur); }
#undef PG8_SA
#undef PG8_SB
#undef PG8_STAGE
#undef PG8_LDA
#undef PG8_LDB
#undef PG8_MMA
#undef PG8_WAIT_V
#undef PG8_WAIT_L
#undef PG8_BAR
#undef PG8_SCHED
}
}

#define GAS __attribute__((address_space(1)))
#define LAS __attribute__((address_space(3)))
typedef unsigned short bf16;
typedef unsigned v4u __attribute__((ext_vector_type(4)));
typedef float f32x4 __attribute__((ext_vector_type(4)));
typedef short bf16x8 __attribute__((ext_vector_type(8)));
typedef GAS unsigned gu32;
typedef GAS unsigned long long gu64;
#define RLX_AGENT __ATOMIC_RELAXED, __HIP_MEMORY_SCOPE_AGENT
#define LDS_WAIT() asm volatile("s_waitcnt lgkmcnt(0)" ::: "memory")
#define VM_WAIT() asm volatile("s_waitcnt vmcnt(0)" ::: "memory")
__device__ __forceinline__ unsigned long long rt() { return __builtin_amdgcn_s_memrealtime(); }
__device__ __forceinline__ unsigned f2bf(float f) { unsigned u = __builtin_bit_cast(unsigned, f); return (u + 0x7fffu + ((u >> 16) & 1u)) >> 16; }
__device__ __forceinline__ unsigned pk2(float lo, float hi) { return f2bf(lo) | (f2bf(hi) << 16); }
#define XB_TMO      128
#define XB_XCNT(j)  (256  + 64 * (j))
#define XB_XSUB(j)  (1280 + 64 * (j))
#define XB_XGEN(j)  (2304 + 64 * (j))
#define XB_TOP      3328
#define XB_TOPGEN   3392
#define XCD_BAR_WORDS 3456
#define XB_SPIN_CAP (1u << 18)

__device__ __forceinline__ unsigned xb_ld(unsigned* p)              { return __hip_atomic_load(p, __ATOMIC_RELAXED, __HIP_MEMORY_SCOPE_AGENT); }
__device__ __forceinline__ unsigned xb_add(unsigned* p, unsigned v) { return __hip_atomic_fetch_add(p, v, __ATOMIC_RELAXED, __HIP_MEMORY_SCOPE_AGENT); }
__device__ __forceinline__ unsigned xb_xcc_id() { return (unsigned)__builtin_amdgcn_s_getreg((3 << 11) | 20) & 0xFu; }
#define XB_SPIN(cond, bar) do { unsigned _sp = 0; while (cond) { __builtin_amdgcn_s_sleep(1); \
    if ((++_sp & 255u) == 0u) { if (xb_ld(&(bar)[XB_TMO])) break; if (_sp > XB_SPIN_CAP) { atomicAdd(&(bar)[XB_TMO], 1u); break; } } } } while (0)

struct XcdBarrier {
    unsigned* bar; unsigned x;
    volatile LAS unsigned* st;
};

__device__ __forceinline__ XcdBarrier xcd_barrier_post(unsigned* bar, volatile LAS unsigned* st) {
    XcdBarrier b; b.bar = bar; b.x = xb_xcc_id(); b.st = st;
    if (threadIdx.x == 0) (void)xb_add(&bar[XB_XCNT(b.x)], 1u);
    return b;
}
__device__ __forceinline__ void xcd_barrier_complete(unsigned* bar, unsigned x, unsigned& nloc, unsigned& nx) {
    const unsigned G = gridDim.x * gridDim.y * gridDim.z;
    unsigned sum, cnt, mine, sp = 0u;
    for (;;) {
        sum = 0u; cnt = 0u; mine = 0u;
#pragma unroll
        for (unsigned j = 0; j < 16; ++j) { const unsigned c = xb_ld(&bar[XB_XCNT(j)]); sum += c; cnt += (c > 0u) ? 1u : 0u; mine = (j == x) ? c : mine; }
        if (sum == G) break;
        __builtin_amdgcn_s_sleep(1);
        if ((++sp & 255u) == 0u) { if (xb_ld(&bar[XB_TMO])) break; if (sp > XB_SPIN_CAP) { atomicAdd(&bar[XB_TMO], 1u); break; } }
    }
    nloc = mine > 0u ? mine : 1u; nx = cnt > 0u ? cnt : 1u;
}

__device__ __forceinline__ void xcd_barrier(const XcdBarrier& b) {
    asm volatile("s_waitcnt vmcnt(0)" ::: "memory");
    __syncthreads();
    if (threadIdx.x == 0) {
        unsigned* bar = b.bar;
        __builtin_amdgcn_s_waitcnt(0);
        unsigned nloc = b.st[0], nx = b.st[1];
        if (nloc == 0u) { xcd_barrier_complete(bar, b.x, nloc, nx); b.st[0] = nloc; b.st[1] = nx; }
        const unsigned old = xb_add(&bar[XB_XSUB(b.x)], 1u);
        const unsigned gen = old / nloc;
        if (old + 1u == (gen + 1u) * nloc) {
            __builtin_amdgcn_fence(__ATOMIC_RELEASE, "agent");
            asm volatile("s_waitcnt vmcnt(0)" ::: "memory");
            const unsigned og = xb_add(&bar[XB_TOP], 1u);
            const unsigned tg = og / nx;
            if (og + 1u == (tg + 1u) * nx) xb_add(&bar[XB_TOPGEN], 1u);
            else XB_SPIN(xb_ld(&bar[XB_TOPGEN]) == tg, bar);
            __builtin_amdgcn_fence(__ATOMIC_ACQUIRE, "agent");
            xb_add(&bar[XB_XGEN(b.x)], 1u);
            asm volatile("s_waitcnt vmcnt(0)" ::: "memory");
        } else {
            XB_SPIN(xb_ld(&bar[XB_XGEN(b.x)]) == gen, bar);
            __builtin_amdgcn_fence(__ATOMIC_ACQUIRE, "agent");
            asm volatile("s_waitcnt vmcnt(0)" ::: "memory");
        }
    }
    __syncthreads();
}

namespace mk {
using pg8::bf16_t; using pg8::Unit;
typedef unsigned u32x2 __attribute__((ext_vector_type(2)));
typedef unsigned u32x4 __attribute__((ext_vector_type(4)));
typedef short s16x4 __attribute__((ext_vector_type(4)));
typedef float f32x2 __attribute__((ext_vector_type(2)));

constexpr int D = 2048, T = 2048, NB = 4, M = NB * T, DEPTH = 4, SB = 8, FF = 5632, INW = 6144, PLE = 256, NUP = 2 * FF;
constexpr float ALPHA = 1.6817928305074290f, LN_EPS = 1e-5f, GN_EPS = 1e-5f, LOG2E = 1.4426950408889634f;
constexpr int NWAVES = 8, NTHR = 512;

constexpr size_t O_YP = 0, O_YS = O_YP + (size_t)M * D, O_KP = O_YS + (size_t)SB * D, O_VP = O_KP + (size_t)DEPTH * M * 1024, O_RP = O_VP + (size_t)DEPTH * M * 1024,
                 O_KS = O_RP + (size_t)DEPTH * NB * 8 * 64 * 128, O_VS = O_KS + (size_t)DEPTH * SB * 1024, O_RS = O_VS + (size_t)DEPTH * SB * 1024, O_END = O_RS + (size_t)DEPTH * SB * 8 * 64 * 128;

constexpr int CV_UP1 = 0, CV_IN = NUP, CV_UP2 = NUP + INW, CV_GATE = 2 * NUP + INW, NCV = 2 * NUP + INW + D;

constexpr size_t E_UP = (size_t)NUP * D, E_DN = (size_t)D * FF, E_IN = (size_t)INW * D, E_OUT = (size_t)D * D, E_GATE = (size_t)D * D, E_PLE = (size_t)D * PLE;
constexpr size_t W_UP1 = 0, W_DN1 = W_UP1 + E_UP, W_IN = W_DN1 + E_DN, W_OUT = W_IN + E_IN, W_UP2 = W_OUT + E_OUT, W_DN2 = W_UP2 + E_UP, W_GATE = W_DN2 + E_DN, W_PLE = W_GATE + E_GATE, LW = W_PLE + E_PLE;

constexpr size_t al256(size_t x) { return (x + 255) & ~(size_t)255; }
constexpr size_t WS_CTL = 0, CTL_BYTES = 1u << 20;
constexpr size_t WS_STATS = CTL_BYTES;
constexpr size_t WS_CV = WS_STATS + 2 * (size_t)M * 16 * 4;
constexpr size_t WS_SMP = al256(WS_CV + (size_t)DEPTH * 2 * NCV * 4);
constexpr size_t WS_PART = WS_SMP + (2u << 20);
constexpr size_t WS_W = al256(WS_PART + (size_t)DEPTH * 2 * 32 * NCV * 4);
constexpr size_t WS_YB = al256(WS_W + (size_t)DEPTH * LW * 2);
constexpr size_t WS_Y = WS_YB + 2 * (size_t)M * D * 2;
constexpr size_t WS_H = WS_Y + (size_t)M * D * 4;
constexpr size_t WS_Z = WS_H + (size_t)M * FF * 2;
constexpr size_t WS_MIX = WS_Z + (size_t)M * INW * 2;
constexpr size_t WS_OG = WS_MIX + (size_t)M * D * 2;
constexpr size_t WS_LSE = WS_OG + 3 * (size_t)M * 1024 * 2;
constexpr size_t WS_U = WS_LSE + 3 * (size_t)M * 8 * 4;
constexpr size_t WS_PB = WS_U + (size_t)NB * 8 * 16 * 8192 * 4;
constexpr size_t WS_PW = WS_PB + (size_t)DEPTH * M * PLE * 2;
constexpr size_t WS_END = WS_PW + (size_t)DEPTH * M * D * 2;
constexpr int SM_YS = 0;
constexpr int SM_ST = SM_YS + 2 * 8 * 2048;
constexpr int SM_RUP = SM_ST + 64;
constexpr int SM_RD = SM_RUP + 8 * NUP;
constexpr int SM_RIN = SM_RD + 8 * D;
constexpr int SM_MIX = SM_RIN + 8 * INW;
constexpr int SM_AP = SM_MIX + 8 * D;
constexpr int SM_PWS = SM_AP + 192 * 136;
constexpr int SM_RDB = SM_PWS + DEPTH * 8 * D;
constexpr int SM_HS = SM_RDB + 8 * D;
constexpr int SM_END = SM_HS + 8 * FF / 4;
static_assert(SM_END * 4 <= (2 << 20), "sample scratch");

constexpr int RING_BYTES = 131072, MISC_OFF = RING_BYTES + 320, LDS_BYTES = 147456;

__device__ __forceinline__ float bf2f(unsigned short u) { return __uint_as_float((unsigned)u << 16); }
__device__ __forceinline__ float bflo(unsigned u) { return __uint_as_float(u << 16); }
__device__ __forceinline__ float bfhi(unsigned u) { return __uint_as_float(u & 0xffff0000u); }
__device__ __forceinline__ unsigned pk(float lo, float hi) { return pg8::cvt_pk_bf16(lo, hi); }
__device__ __forceinline__ float shx(float v, int m, int lane) { return __int_as_float(__builtin_amdgcn_ds_bpermute((lane ^ m) << 2, __float_as_int(v))); }
__device__ __forceinline__ float sigmoid_f(float v) { return __builtin_amdgcn_rcpf(1.f + __builtin_amdgcn_exp2f(-v * LOG2E)); }

__device__ __forceinline__ float clamp448(float v) { return __builtin_amdgcn_fmed3f(v, -448.f, 448.f); }
__device__ __forceinline__ unsigned pk8(float a, float b, float c, float d) { int w = 0; w = __builtin_amdgcn_cvt_pk_fp8_f32(clamp448(a), clamp448(b), w, false); w = __builtin_amdgcn_cvt_pk_fp8_f32(clamp448(c), clamp448(d), w, true); return (unsigned)w; }
__device__ __forceinline__ unsigned pk8u(float a, float b, float c, float d) { int w = 0; w = __builtin_amdgcn_cvt_pk_fp8_f32(a, b, w, false); w = __builtin_amdgcn_cvt_pk_fp8_f32(c, d, w, true); return (unsigned)w; }
__device__ __forceinline__ float up8(unsigned w, int sel) { return sel == 0 ? __builtin_amdgcn_cvt_f32_fp8((int)w, 0) : sel == 1 ? __builtin_amdgcn_cvt_f32_fp8((int)w, 1) : sel == 2 ? __builtin_amdgcn_cvt_f32_fp8((int)w, 2) : __builtin_amdgcn_cvt_f32_fp8((int)w, 3); }
constexpr float W8S = 256.f, H8S = 64.f;

__device__ __forceinline__ void row_stats(const float* st, int row, float& mu, float& rs) {
    const f32x4* p = (const f32x4*)(st + (size_t)row * 16);
    const f32x4 a = p[0], b = p[1], c = p[2], d = p[3];
    const float s = ((a.x + a.z) + (b.x + b.z)) + ((c.x + c.z) + (d.x + d.z));
    const float q = ((a.y + a.w) + (b.y + b.w)) + ((c.y + c.w) + (d.y + d.w));
    mu = s * (1.f / 2048.f);
    const float var = fmaxf(q * (1.f / 2048.f) - mu * mu, 0.f);
    rs = 1.0f / sqrtf(var + LN_EPS);
}

constexpr int TAB_OFF = RING_BYTES + 1024;
template <class Sched> __device__ __forceinline__ void stats_table_fill(PG8_LAS unsigned char* lds, const Sched& S, const float* st, int tid) {
    PG8_LAS f32x2* tab = (PG8_LAS f32x2*)(lds + TAB_OFF);
#pragma unroll
    for (int k = 0; k < 3; ++k) {
        const int e = tid + 512 * k, slot = e >> 8, r = e & 255;
        Unit u;
        if (S.next(slot, u)) { float mu, rs; row_stats(st, u.pm * 256 + r, mu, rs); tab[e] = (f32x2){mu, rs}; }
    }
    __syncthreads();
}
__device__ __forceinline__ f32x2 tab_get(const Unit& u, int rowlocal) { extern __shared__ __attribute__((aligned(16))) unsigned char lds_tab_[]; return ((const PG8_LAS f32x2*)((PG8_LAS unsigned char*)lds_tab_ + TAB_OFF))[u.idx * 256 + rowlocal]; }

struct TailOrder {
    pg8::StaticOrder base; int first, nfull, c, total;
    __device__ bool next(int i, Unit& u) const {
        const int F = first + i * nfull + (c % nfull);
        if (c >= 2 * nfull || F >= total) return false;
        pg8::StaticOrder b = base; b.lim = b.nwg; b.G = 1; b.c = 0;
        if (!b.next(F, u)) return false;
        u.idx = i; u.half = c / nfull; return true;
    }
    __device__ __forceinline__ void a_ready(const Unit&) const {}
    __device__ __forceinline__ void done(const Unit&) const {}
};
struct ChainOrder {
    static constexpr bool HAS_CHAIN = true;
    pg8::StaticOrder base; int first, nfull;
    __device__ bool next(int i, Unit& u) const { return base.next(i, u); }
    __device__ bool chain(Unit& u) const { const TailOrder t{base, first, nfull, base.c, base.nwg}; return t.next(0, u); }
    __device__ __forceinline__ void a_ready(const Unit&) const {}
    __device__ __forceinline__ void done(const Unit&) const {}
};
__device__ __forceinline__ void stats_table_fill_half(PG8_LAS unsigned char* lds, const TailOrder& S, const float* st, int tid) {
    PG8_LAS f32x2* tab = (PG8_LAS f32x2*)(lds + TAB_OFF);
#pragma unroll
    for (int k = 0; k < 3; ++k) {
        const int e = tid + 512 * k, slot = e >> 7, r = e & 127;
        Unit u;
        if (S.next(slot, u)) { float mu, rs; row_stats(st, u.pm * 256 + u.half * 128 + r, mu, rs); tab[e] = (f32x2){mu, rs}; }
    }
    __syncthreads();
}
__device__ __forceinline__ f32x2 tab_get_half(const Unit& u, int rowlocal128) { extern __shared__ __attribute__((aligned(16))) unsigned char lds_tab_[]; return ((const PG8_LAS f32x2*)((PG8_LAS unsigned char*)lds_tab_ + TAB_OFF))[u.idx * 128 + rowlocal128]; }

template <class Sched> struct PreTab { PG8_LAS unsigned char* lds; const Sched& S; const float* st; int tid; int on;
    __device__ __forceinline__ void operator()() const { if (on) stats_table_fill(lds, S, st, tid); } };
struct PreTabHalf { PG8_LAS unsigned char* lds; const TailOrder& S; const float* st; int tid; int on;
    __device__ __forceinline__ void operator()() const { if (on) stats_table_fill_half(lds, S, st, tid); } };

template <bool HALF_M> struct EpiSwiGLU {
    static constexpr bool PERM = true, AFTER_DRAIN = false; static constexpr int NSTORE = HALF_M ? 4 : 8;
    unsigned char* H; const float* st; const float* c1; const float* c2; int ident;
#if defined(MK_PROBE)
    int nost;
#endif
    __device__ __forceinline__ void operator()(const f32x4 (&acc)[2][2][4][2], const Unit& u, int wr, int wc, int fr, int fq) const {
#if defined(MK_PROBE)
        if (nost & 2) return;
#endif
        const int hoff = HALF_M ? u.half * 128 : 0, row0 = u.pm * 256 + hoff + wr * 64 + fr;
        const int nc = u.pn * 256 + wc * 32 + 8 * fq, hc = u.pn * 128 + wc * 32 + 8 * fq;
        f32x4 c1g[2], c2g[2], c1u[2], c2u[2];
#pragma unroll
        for (int n = 0; n < 2; ++n) {
            if (ident) { c1g[n] = (f32x4){0.f, 0.f, 0.f, 0.f}; c2g[n] = c1g[n]; c1u[n] = c1g[n]; c2u[n] = c1g[n]; }
            else { c1g[n] = *(const f32x4*)(c1 + nc + 4 * n); c2g[n] = *(const f32x4*)(c2 + nc + 4 * n); c1u[n] = *(const f32x4*)(c1 + nc + 128 + 4 * n) * H8S; c2u[n] = *(const f32x4*)(c2 + nc + 128 + 4 * n) * H8S; }
        }
#pragma unroll
        for (int ai = 0; ai < (HALF_M ? 1 : 2); ++ai)
#pragma unroll
            for (int m = 0; m < 4; ++m) {
                const int r = row0 + ai * 128 + m * 16;
                float mu = 0.f, rs = 1.f;
                if (!ident) { const f32x2 ms = HALF_M ? tab_get_half(u, wr * 64 + m * 16 + fr) : tab_get(u, ai * 128 + wr * 64 + m * 16 + fr); mu = ms.x; rs = ms.y; }
                u32x2 w;
                const float rsg = rs * (1.f / W8S), rsu = rs * (H8S / W8S), nm = -mu * rs;
#pragma unroll
                for (int n = 0; n < 2; ++n) {
                    const f32x4 g4 = acc[ai][0][m][n] * rsg + (c1g[n] * nm + c2g[n]);
                    const f32x4 u4 = acc[ai][1][m][n] * rsu + (c1u[n] * nm + c2u[n]);
                    float h4[4];
#pragma unroll
                    for (int e = 0; e < 4; ++e) h4[e] = g4[e] * u4[e] * sigmoid_f(g4[e]);
                    w[n] = pk8(h4[0], h4[1], h4[2], h4[3]);
                }
#if defined(MK_PROBE)
                if (nost & 1) { asm volatile("" :: "v"(w)); continue; }
#endif
                *(u32x2*)(H + (size_t)r * FF + hc) = w;
            }
    }
};
struct EpiIn {
    static constexpr bool PERM = true, AFTER_DRAIN = false; static constexpr int NSTORE = 16;
    bf16_t* Z; float* kout; float* vout; const float* st; const float* c1; const float* c2;
    __device__ __forceinline__ void operator()(const f32x4 (&acc)[2][2][4][2], const Unit& u, int wr, int wc, int fr, int fq) const {
        const int row0 = u.pm * 256 + wr * 64 + fr, colb = u.pn * 256 + wc * 32 + 8 * fq;
        const float sc = (u.pn == 14 || u.pn == 15) ? 0.125f : 1.f;
        f32x4 c1v[2][2], c2v[2][2];
#pragma unroll
        for (int bj = 0; bj < 2; ++bj)
#pragma unroll
            for (int n = 0; n < 2; ++n) { c1v[bj][n] = *(const f32x4*)(c1 + colb + bj * 128 + 4 * n); c2v[bj][n] = *(const f32x4*)(c2 + colb + bj * 128 + 4 * n); }
#pragma unroll
        for (int ai = 0; ai < 2; ++ai)
#pragma unroll
            for (int m = 0; m < 4; ++m) {
                const int r = row0 + ai * 128 + m * 16;
                const f32x2 ms = tab_get(u, ai * 128 + wr * 64 + m * 16 + fr); const float mu = ms.x, rs = ms.y;
#pragma unroll
                for (int bj = 0; bj < 2; ++bj) {
                    const int col = colb + bj * 128;
                    const f32x4 z0 = (acc[ai][bj][m][0] - mu * c1v[bj][0]) * rs + c2v[bj][0];
                    const f32x4 z1 = (acc[ai][bj][m][1] - mu * c1v[bj][1]) * rs + c2v[bj][1];
                    if (u.pn >= 4 && u.pn < 12) {
                        float* dst = (u.pn < 8) ? (kout + (size_t)r * 1024 + (col - 1024)) : (vout + (size_t)r * 1024 + (col - 2048));
                        __builtin_nontemporal_store(z0, (f32x4*)dst); __builtin_nontemporal_store(z1, (f32x4*)(dst + 4));
                    }
                    u32x4 w; w.x = pk(z0[0] * sc, z0[1] * sc); w.y = pk(z0[2] * sc, z0[3] * sc); w.z = pk(z1[0] * sc, z1[1] * sc); w.w = pk(z1[2] * sc, z1[3] * sc);
                    *(u32x4*)(Z + (size_t)r * INW + col) = w;
                }
            }
    }
};
struct EpiPlain {
    static constexpr bool PERM = true, AFTER_DRAIN = false; static constexpr int NSTORE = 16;
    bf16_t* O; int ldc;
    __device__ __forceinline__ void operator()(const f32x4 (&acc)[2][2][4][2], const Unit& u, int wr, int wc, int fr, int fq) const {
        const int row0 = u.pm * 256 + wr * 64 + fr;
#pragma unroll
        for (int ai = 0; ai < 2; ++ai)
#pragma unroll
            for (int m = 0; m < 4; ++m)
#pragma unroll
                for (int bj = 0; bj < 2; ++bj) {
                    const int r = row0 + ai * 128 + m * 16, col = u.pn * 256 + bj * 128 + wc * 32 + 8 * fq;
                    const f32x4 z0 = acc[ai][bj][m][0], z1 = acc[ai][bj][m][1];
                    u32x4 w; w.x = pk(z0[0], z0[1]); w.y = pk(z0[2], z0[3]); w.z = pk(z1[0], z1[1]); w.w = pk(z1[2], z1[3]);
                    *(u32x4*)(O + (size_t)r * ldc + col) = w;
                }
    }
};
constexpr int PLE_TSTEP = (int)(LW * 2 / (256 * PLE * 2));
static_assert((LW * 2) % (256 * PLE * 2) == 0, "layer stride is a whole number of w_ple tile steps");
struct PleOrder {
    pg8::StaticOrder base;
    __device__ bool next(int i, Unit& u) const { if (i >= DEPTH || !base.next(0, u)) return false; u.pm += 32 * i; u.pn += PLE_TSTEP * i; u.idx = i; return true; }
    __device__ __forceinline__ void a_ready(const Unit&) const {}
    __device__ __forceinline__ void done(const Unit&) const {}
};
struct EpiPle {
    static constexpr bool PERM = true, AFTER_DRAIN = false; static constexpr int NSTORE = 16;
    bf16_t* O;
    __device__ __forceinline__ void operator()(const f32x4 (&acc)[2][2][4][2], const Unit& u, int wr, int wc, int fr, int fq) const {
        const int l = u.idx, pm0 = u.pm - 32 * l, pn0 = u.pn - PLE_TSTEP * l, row0 = pm0 * 256 + wr * 64 + fr;
        bf16_t* Ol = O + (size_t)l * M * D;
#pragma unroll
        for (int ai = 0; ai < 2; ++ai)
#pragma unroll
            for (int m = 0; m < 4; ++m)
#pragma unroll
                for (int bj = 0; bj < 2; ++bj) {
                    const int r = row0 + ai * 128 + m * 16, col = pn0 * 256 + bj * 128 + wc * 32 + 8 * fq;
                    const f32x4 z0 = acc[ai][bj][m][0], z1 = acc[ai][bj][m][1];
                    u32x4 w; w.x = pk(z0[0], z0[1]); w.y = pk(z0[2], z0[3]); w.z = pk(z1[0], z1[1]); w.w = pk(z1[2], z1[3]);
                    *(u32x4*)(Ol + (size_t)r * D + col) = w;
                }
    }
};
template <int MODE, bool HALF_M = false> struct EpiRes {
    static constexpr bool PERM = true, AFTER_DRAIN = true; static constexpr int NSTORE = 0;
    const float* prev32; const bf16_t* prevb; bf16_t* ybout; const float* st_prev; float* st_next; const float* g; const float* b; int ident; float scale;
    const bf16_t* pw; const float* c1; const float* c2; unsigned char* y8;
    __device__ __forceinline__ void fused(f32x4 (&acc)[2][2][4][2], const Unit& u, int wr, int wc, int fr, int fq, PG8_LAS unsigned char* lds, int wid, int lane) const {
        asm volatile("" : "+v"(lane));
        fr = lane & 15; fq = lane >> 4;
        const int hoff = HALF_M ? u.half * 128 : 0, col0 = u.pn * 256 + wc * 32 + 8 * fq, rowb = u.pm * 256 + hoff + wr * 64 + fr, cl0 = wc * 32 + 8 * fq;
        PG8_LAS f32x2* P = (PG8_LAS f32x2*)lds;
        PG8_LAS float* CVL = (PG8_LAS float*)(lds + 8192);
        {   const int t = wid * 64 + lane, cc = u.pn * 256 + (t & 255);
            if (t < 256) { CVL[t] = ident ? 1.f : g[cc]; CVL[256 + t] = ident ? 0.f : b[cc]; }
            else if (MODE == 1) { CVL[512 + (t & 255)] = c1[cc]; CVL[768 + (t & 255)] = c2[cc]; } }
#pragma unroll
        for (int ai = 0; ai < (HALF_M ? 1 : 2); ++ai) {
            u32x4 pv[4][2], pq[4][2];
#pragma unroll
            for (int m = 0; m < 4; ++m)
#pragma unroll
                for (int bj = 0; bj < 2; ++bj) {
                    const size_t off = (size_t)(rowb + ai * 128 + m * 16) * D + col0 + bj * 128;
                    pv[m][bj] = ident ? (u32x4){0u, 0u, 0u, 0u} : *(const u32x4*)(prevb + off);
                    pq[m][bj] = (MODE == 1) ? *(const u32x4*)(pw + off) : (u32x4){0u, 0u, 0u, 0u};
                }
            if (ai == 0) __syncthreads();
#pragma unroll
            for (int m = 0; m < 4; ++m) {
                const int r = rowb + ai * 128 + m * 16;
                float mu = 0.f, rs = 1.f, ssum = 0.f, ssq = 0.f;
                if (!ident) { const f32x2 ms = HALF_M ? tab_get_half(u, wr * 64 + m * 16 + fr) : tab_get(u, ai * 128 + wr * 64 + m * 16 + fr); mu = ms.x; rs = ms.y; }
#pragma unroll
                for (int bj = 0; bj < 2; ++bj) {
                    const size_t offb = (size_t)r * D + col0 + bj * 128;
                    u32x4 wo; u32x2 w8;
#pragma unroll
                    for (int n = 0; n < 2; ++n) {
                        const int cl = cl0 + bj * 128 + 4 * n;
                        const unsigned pa = pv[m][bj][2 * n], pb = pv[m][bj][2 * n + 1], qa = pq[m][bj][2 * n], qb = pq[m][bj][2 * n + 1];
                        f32x4 x;
                        if (ident) x = *(const f32x4*)(prev32 + offb + 4 * n);
                        else { const f32x4 pvv = (f32x4){bflo(pa), bfhi(pa), bflo(pb), bfhi(pb)}; x = (pvv - mu) * rs * (*(const PG8_LAS f32x4*)(CVL + cl)) + *(const PG8_LAS f32x4*)(CVL + 256 + cl); }
                        const f32x4 a = acc[ai][bj][m][n];
                        f32x4 t;
                        if (MODE == 0) t = a * scale;
                        else {
                            const f32x4 zf = (a - mu * (*(const PG8_LAS f32x4*)(CVL + 512 + cl))) * rs + *(const PG8_LAS f32x4*)(CVL + 768 + cl);
                            t[0] = bflo(qa) * sigmoid_f(zf[0]); t[1] = bfhi(qa) * sigmoid_f(zf[1]); t[2] = bflo(qb) * sigmoid_f(zf[2]); t[3] = bfhi(qb) * sigmoid_f(zf[3]);
                        }
                        const f32x4 y = x * ALPHA + t;
                        const unsigned w0 = pk(y[0], y[1]), w1 = pk(y[2], y[3]);
                        wo[2 * n] = w0; wo[2 * n + 1] = w1;
                        w8[n] = pk8(y[0], y[1], y[2], y[3]);
                        const float y0 = bflo(w0), y1 = bfhi(w0), y2 = bflo(w1), y3 = bfhi(w1);
                        ssum += (y0 + y1) + (y2 + y3);
                        ssq += (y0 * y0 + y1 * y1) + (y2 * y2 + y3 * y3);
                    }
                    *(u32x4*)(ybout + offb) = wo;
                    if (y8) *(u32x2*)(y8 + offb) = w8;
                }
                ssum += shx(ssum, 16, lane); ssum += shx(ssum, 32, lane); ssq += shx(ssq, 16, lane); ssq += shx(ssq, 32, lane);
                if (fq == 0) P[(ai * 128 + wr * 64 + m * 16 + fr) * 4 + wc] = (f32x2){ssum, ssq};
            }
        }
        __syncthreads();
        const int tid = wid * 64 + lane;
        if (tid < (HALF_M ? 128 : 256)) {
            const f32x2 a0 = P[tid * 4 + 0], a1 = P[tid * 4 + 1], a2 = P[tid * 4 + 2], a3 = P[tid * 4 + 3];
            f32x2 o; o.x = (a0.x + a1.x) + (a2.x + a3.x); o.y = (a0.y + a1.y) + (a2.y + a3.y);
            *(f32x2*)(st_next + (size_t)(u.pm * 256 + hoff + tid) * 16 + u.pn * 2) = o;
        }
        __syncthreads();
    }
};

struct TrCtx { const float* W; bf16_t* WT; const float* gk; const float* bk; float* p1; float* p2; int K, N, drow0, n0, k0, f8; };
__device__ __forceinline__ void tr_load(const TrCtx& c, int lane, float (&wv)[32], float (&gv)[8], float (&bv)[8]) {
    const int cc = lane & 7;
#pragma unroll
    for (int e = 0; e < 8; ++e) { gv[e] = 1.f; bv[e] = 0.f; }
    if (c.gk) {
        const f32x4 g0 = *(const f32x4*)(c.gk + c.k0 + 8 * cc), g1 = *(const f32x4*)(c.gk + c.k0 + 8 * cc + 4), b0 = *(const f32x4*)(c.bk + c.k0 + 8 * cc), b1 = *(const f32x4*)(c.bk + c.k0 + 8 * cc + 4);
#pragma unroll
        for (int e = 0; e < 4; ++e) { gv[e] = g0[e]; gv[4 + e] = g1[e]; bv[e] = b0[e]; bv[4 + e] = b1[e]; }
    }
    const float* wp = c.W + (size_t)(c.k0 + (lane >> 5)) * c.N + c.n0 + (lane & 31);
#pragma unroll
    for (int i = 0; i < 32; ++i) wv[i] = __builtin_nontemporal_load(wp + (size_t)(2 * i) * c.N);
}
__device__ __forceinline__ void tr_proc(const TrCtx& c, PG8_LAS float* scr, int lane, const float (&wv)[32], const float (&gv)[8], const float (&bv)[8]) {
    const int cc = lane & 7;
#pragma unroll
    for (int i = 0; i < 32; ++i) scr[(2 * i + (lane >> 5)) * 33 + (lane & 31)] = wv[i];
    asm volatile("s_waitcnt lgkmcnt(0)" ::: "memory");
#pragma unroll
    for (int j = 0; j < 4; ++j) {
        const int n = (lane >> 3) + 8 * j; const PG8_LAS float* s = scr + (8 * cc) * 33 + n;
        float w[8];
#pragma unroll
        for (int e = 0; e < 8; ++e) w[e] = s[e * 33];
        float r1 = 0.f;
        if (c.f8) {
            float ws8[8];
#pragma unroll
            for (int e = 0; e < 8; ++e) ws8[e] = __builtin_amdgcn_fmed3f(w[e] * gv[e] * W8S, -448.f, 448.f);
            u32x2 o; o.x = pk8u(ws8[0], ws8[1], ws8[2], ws8[3]); o.y = pk8u(ws8[4], ws8[5], ws8[6], ws8[7]);
            __builtin_nontemporal_store(o, (u32x2*)((unsigned char*)c.WT + (size_t)(c.drow0 + n) * c.K + c.k0 + 8 * cc));
            if (c.gk) r1 = (((up8(o.x, 0) + up8(o.x, 1)) + (up8(o.x, 2) + up8(o.x, 3))) + ((up8(o.y, 0) + up8(o.y, 1)) + (up8(o.y, 2) + up8(o.y, 3)))) * (1.f / W8S);
        } else {
            u32x4 o; o.x = pk(w[0] * gv[0], w[1] * gv[1]); o.y = pk(w[2] * gv[2], w[3] * gv[3]); o.z = pk(w[4] * gv[4], w[5] * gv[5]); o.w = pk(w[6] * gv[6], w[7] * gv[7]);
            __builtin_nontemporal_store(o, (u32x4*)(c.WT + (size_t)(c.drow0 + n) * c.K + c.k0 + 8 * cc));
            if (c.gk) r1 = ((bflo(o.x) + bfhi(o.x)) + (bflo(o.y) + bfhi(o.y))) + ((bflo(o.z) + bfhi(o.z)) + (bflo(o.w) + bfhi(o.w)));
        }
        if (c.gk) {
            float r2 = 0.f;
#pragma unroll
            for (int e = 0; e < 8; ++e) r2 = fmaf(bv[e], w[e], r2);
            r1 += shx(r1, 1, lane); r1 += shx(r1, 2, lane); r1 += shx(r1, 4, lane);
            r2 += shx(r2, 1, lane); r2 += shx(r2, 2, lane); r2 += shx(r2, 4, lane);
            if (cc == 0) { c.p1[c.drow0 + n] = r1; c.p2[c.drow0 + n] = r2; }
        }
    }
    asm volatile("s_waitcnt lgkmcnt(0)" ::: "memory");
}
}

namespace mk {
typedef short bf16x8 __attribute__((ext_vector_type(8)));
#define MK_LAS __attribute__((address_space(3)))
#define MK_OPQF(name, val) float name = (val); asm volatile("" : "+v"(name))
__device__ __forceinline__ f32x4 mfma16(bf16x8 a, bf16x8 b, f32x4 c) { return __builtin_amdgcn_mfma_f32_16x16x32_bf16(a, b, c, 0, 0, 0); }
__device__ __forceinline__ s16x4 tr_rd(MK_LAS unsigned char* p) { return __builtin_bit_cast(s16x4, __builtin_amdgcn_ds_read_tr16_b64_v4i16((MK_LAS s16x4*)p)); }
__device__ __forceinline__ bf16x8 cat8(s16x4 a, s16x4 b) { return (bf16x8){a[0], a[1], a[2], a[3], b[0], b[1], b[2], b[3]}; }
__device__ __forceinline__ unsigned offb(unsigned row, unsigned ch) { return 256u * row + 16u * (ch ^ (((row & 3u) << 2) | ((row >> 2) & 3u))); }
__device__ __forceinline__ void glds16(const void* g, MK_LAS unsigned char* l) { __builtin_amdgcn_global_load_lds((const unsigned*)g, (MK_LAS unsigned*)l, 16, 0, 0); }
__device__ __forceinline__ void st_bf16(bf16_t* p, float v) { *p = (bf16_t)(pk(v, 0.f) & 0xffffu); }

struct AttnP { int b, h, gsel, r, nbk, kbeg, dsh; };
__device__ __forceinline__ AttnP attn_decode(int unit) {
    AttnP p; const int bh = unit / 48, rest = unit % 48, x = rest & 15; p.gsel = rest >> 4; p.b = bh >> 3; p.h = bh & 7; p.dsh = 2 * p.gsel;
    p.r = (p.gsel == 0) ? 0 : (p.gsel == 1 ? (x & 3) : x); p.nbk = (p.gsel == 0) ? x : (p.gsel == 1 ? (x >> 2) : 0); p.kbeg = (p.nbk == 0) ? 128 : 0; return p;
}
__device__ __forceinline__ void attn_stage(MK_LAS unsigned char* img, const bf16_t* Z, const AttnP& p, int coff, int wave, int lane) {
    const __amdgpu_buffer_rsrc_t rz = __builtin_amdgcn_make_buffer_rsrc((void*)Z, (short)0, 0x7fffffff, 0x00020000);
#pragma unroll
    for (int it = 0; it < 8; ++it) {
        const int inst = wave * 8 + it;
        if (inst * 4 >= p.kbeg) {
            const int row = 4 * inst + (lane >> 4), pc = lane & 15, ch = pc ^ (((row & 3) << 2) | ((row >> 2) & 3));
            const int t = ((128 * (p.nbk - 1) + row) << p.dsh) + p.r;
            const unsigned off = (unsigned)(((p.b * T + t) * INW + coff + p.h * 128 + ch * 8) * 2);
            __builtin_amdgcn_raw_ptr_buffer_load_lds(rz, (MK_LAS void*)(img + inst * 1024), 16, (int)off, 0, 0, 0);
        }
    }
}
__device__ __forceinline__ void attn_loadq(bf16x8 (&qf)[4], const bf16_t* Z, const AttnP& p, int wave, int lane) {
    const int qi = 16 * wave + (lane & 15);
    const bf16_t* qp = Z + ((size_t)p.b * T + (((128 * p.nbk + qi) << p.dsh) + p.r)) * INW + p.h * 128 + 8 * (lane >> 4);
#pragma unroll
    for (int ks = 0; ks < 4; ++ks) qf[ks] = *(const bf16x8*)(qp + 32 * ks);
}
#define MK_WAITBAR() do { asm volatile("s_waitcnt vmcnt(0) lgkmcnt(0)" ::: "memory"); __builtin_amdgcn_s_barrier(); asm volatile("" ::: "memory"); } while (0)
__device__ __forceinline__ void attn_phase(MK_LAS unsigned char* lds, const bf16_t* Z, bf16_t* OG, float* LSE, int first, int stride, int nunits, int wave, int lane) {
    asm volatile("" : "+v"(lane));
    MK_LAS unsigned char* KI = lds; MK_LAS unsigned char* VI = lds + 65536;
    const int fr = lane & 15, fq = lane >> 4, q4 = (lane & 15) >> 2, p4 = lane & 3;
    if (first >= nunits) return;
    AttnP p = attn_decode(first);
    bf16x8 qf[4];
    attn_stage(KI, Z, p, 1024, wave, lane);
    attn_loadq(qf, Z, p, wave, lane);
    const int s_lo = wave >> 1, s_hi = (wave >> 1) + 4;
    u32x4 dw[4]; float dl = 0.f; unsigned dofs = 0u, dlofs = 0u; bool dhave = false;
#define MK_ATTN_FLUSH() do { if (dhave) { _Pragma("unroll") for (int cp = 0; cp < 4; ++cp) *(u32x4*)(OG + dofs + 32 * cp) = dw[cp]; if (fq == 0) LSE[dlofs] = dl; } } while (0)
    for (int unit = first; unit < nunits; unit += stride) {
        const int qi = 16 * wave + fr;
        const size_t rowb = (size_t)p.b * T;
        MK_WAITBAR();
        asm volatile("" : "+v"(qf[0]), "+v"(qf[1]), "+v"(qf[2]), "+v"(qf[3]));
        attn_stage(VI, Z, p, 2048, wave, lane);
        MK_ATTN_FLUSH();
        f32x4 S[8][2];
        {
            unsigned kb[2][4];
#pragma unroll
            for (int u = 0; u < 2; ++u)
#pragma unroll
                for (int ks = 0; ks < 4; ++ks) kb[u][ks] = offb(8 * (fr >> 2) + 4 * u + (fr & 3), 4 * ks + fq);
#pragma unroll
            for (int s = 0; s < 8; ++s)
#pragma unroll
                for (int u = 0; u < 2; ++u) {
                    S[s][u] = (f32x4){0.f, 0.f, 0.f, 0.f};
                    if (32 * s >= p.kbeg && s >= s_lo && s <= s_hi) {
#pragma unroll
                        for (int ks = 0; ks < 4; ++ks) { const bf16x8 kf = *(const MK_LAS bf16x8*)(KI + kb[u][ks] + 8192 * s); S[s][u] = mfma16(kf, qf[ks], S[s][u]); }
                    }
                    asm volatile("" ::: "memory");
                }
        }
        MK_OPQF(sc2, 0.08838834764831845f * LOG2E); MK_OPQF(kneg, -1e30f); MK_OPQF(k128, 128.f);
        const float slope2 = __builtin_amdgcn_exp2f(-(float)(p.h + 1)) * LOG2E * (float)(1 << p.dsh);
        float mx = kneg;
        int qo = qi + 128 - 8 * fq; asm volatile("" : "+v"(qo));
        const float qof = (float)qo;
#pragma unroll
        for (int s = 0; s < 8; ++s) {
            const bool son = (32 * s >= p.kbeg) && s >= s_lo && s <= s_hi;
            if (!son) continue;
#pragma unroll
            for (int u = 0; u < 2; ++u)
#pragma unroll
                for (int i = 0; i < 4; ++i) {
                    const float dist = qof - (float)(32 * s + 4 * u + i);
                    const bool valid = son && (dist >= 0.f) && (dist <= k128);
                    const float v = valid ? (S[s][u][i] * sc2 - slope2 * dist) : kneg;
                    S[s][u][i] = v; mx = fmaxf(mx, v);
                }
        }
        mx = fmaxf(mx, shx(mx, 16, lane)); mx = fmaxf(mx, shx(mx, 32, lane));
        float l = 0.f;
        bf16x8 pf[8];
#pragma unroll
        for (int s = 0; s < 8; ++s) {
            if (!(32 * s >= p.kbeg && s >= s_lo && s <= s_hi)) { pf[s] = (bf16x8){0, 0, 0, 0, 0, 0, 0, 0}; continue; }
            float pp[8];
#pragma unroll
            for (int j = 0; j < 8; ++j) { pp[j] = __builtin_amdgcn_exp2f(S[s][j >> 2][j & 3] - mx); l += pp[j]; }
            u32x4 w; w.x = pk(pp[0], pp[1]); w.y = pk(pp[2], pp[3]); w.z = pk(pp[4], pp[5]); w.w = pk(pp[6], pp[7]);
            pf[s] = __builtin_bit_cast(bf16x8, w);
        }
        l += shx(l, 16, lane); l += shx(l, 32, lane);
        MK_WAITBAR();
        const AttnP pc = p;
        const int nu = unit + stride;
        if (nu < nunits) { p = attn_decode(nu); attn_stage(KI, Z, p, 1024, wave, lane); attn_loadq(qf, Z, p, wave, lane); }
        f32x4 O[8];
#pragma unroll
        for (int c = 0; c < 8; ++c) O[c] = (f32x4){0.f, 0.f, 0.f, 0.f};
        {
            unsigned vb[8][2];
            const unsigned vbase = (unsigned)(unsigned long long)VI;
#pragma unroll
            for (int c = 0; c < 8; ++c)
#pragma unroll
                for (int t2 = 0; t2 < 2; ++t2) vb[c][t2] = vbase + offb(8 * fq + q4 + 4 * t2, 4 * (c >> 1) + p4) + 8 * (c & 1);
#pragma unroll
            for (int s = 0; s < 8; ++s) {
                if (32 * s >= pc.kbeg && s >= s_lo && s <= s_hi) {
#pragma unroll
                    for (int ch = 0; ch < 2; ++ch) {
                        s16x4 va[4][2];
#pragma unroll
                        for (int c = 0; c < 4; ++c)
#pragma unroll
                            for (int t2 = 0; t2 < 2; ++t2) asm volatile("ds_read_b64_tr_b16 %0, %1 offset:%2" : "=v"(va[c][t2]) : "v"(vb[4 * ch + c][t2]), "n"(8192 * s));
                        asm volatile("s_waitcnt lgkmcnt(0)" : "+v"(va[0][0]), "+v"(va[0][1]), "+v"(va[1][0]), "+v"(va[1][1]), "+v"(va[2][0]), "+v"(va[2][1]), "+v"(va[3][0]), "+v"(va[3][1]));
#pragma unroll
                        for (int c = 0; c < 4; ++c) O[4 * ch + c] = mfma16(cat8(va[c][0], va[c][1]), pf[s], O[4 * ch + c]);
                    }
                }
                asm volatile("" ::: "memory");
            }
        }
        const float linv = 1.0f / l;
        {
            const int tq = ((128 * pc.nbk + qi) << pc.dsh) + pc.r;
            dofs = (unsigned)((size_t)pc.gsel * M * 1024 + (rowb + tq) * 1024 + pc.h * 128 + 8 * fq);
#pragma unroll
            for (int cp = 0; cp < 4; ++cp) { u32x4 w; w.x = pk(O[2 * cp][0] * linv, O[2 * cp][1] * linv); w.y = pk(O[2 * cp][2] * linv, O[2 * cp][3] * linv); w.z = pk(O[2 * cp + 1][0] * linv, O[2 * cp + 1][1] * linv); w.w = pk(O[2 * cp + 1][2] * linv, O[2 * cp + 1][3] * linv); dw[cp] = w; }
        }
        dlofs = (unsigned)((size_t)pc.gsel * M * 8 + (rowb + (((128 * pc.nbk + qi) << pc.dsh) + pc.r)) * 8 + pc.h);
        dl = (mx + __builtin_amdgcn_logf(l)) * (1.0f / LOG2E);
        dhave = true;
    }
    MK_ATTN_FLUSH();
#undef MK_ATTN_FLUSH
    MK_WAITBAR();
}

constexpr int KP = 144, VP = 272;
__device__ __forceinline__ void stage_rows64(MK_LAS unsigned char* img, const bf16_t* src0  , int tid, bool decay, float l2g) {
#pragma unroll
    for (int i = 0; i < 2; ++i) {
        const int idx = tid + 512 * i, row = idx >> 3, ch = idx & 7;
        u32x4 v = *(const u32x4*)(src0 + (size_t)row * INW + ch * 8);
        if (decay) {
            const float dc = __builtin_amdgcn_exp2f((float)(127 - row) * l2g);
            v.x = pk(bflo(v.x) * dc, bfhi(v.x) * dc); v.y = pk(bflo(v.y) * dc, bfhi(v.y) * dc); v.z = pk(bflo(v.z) * dc, bfhi(v.z) * dc); v.w = pk(bflo(v.w) * dc, bfhi(v.w) * dc);
        }
        *(MK_LAS u32x4*)(img + row * KP + ch * 16) = v;
    }
}
__device__ __forceinline__ void stage_rows128(MK_LAS unsigned char* img, const bf16_t* src0, int tid) {
#pragma unroll
    for (int i = 0; i < 4; ++i) {
        const int idx = tid + 512 * i, row = idx >> 4, ch = idx & 15;
        *(MK_LAS u32x4*)(img + row * VP + ch * 16) = *(const u32x4*)(src0 + (size_t)row * INW + ch * 8);
    }
}
__device__ __forceinline__ void retu_pair(MK_LAS unsigned char* lds, const bf16_t* Z, float* U, int u0, int u1, int tid, int wave, int lane) {
    asm volatile("" : "+v"(lane), "+v"(tid));
    const int half = wave >> 2, unit = half ? u1 : u0, ht = tid & 255, hw = wave & 3;
    MK_LAS unsigned char* KI = lds + half * 65536; MK_LAS unsigned char* VI = KI + 20480;
    const int bh = unit >> 4, c = unit & 15, b = bh >> 3, h = bh & 7;
    const float l2g = log2f(1.f - exp2f(-5.f - (float)h));
    const bf16_t* zr = Z + ((size_t)b * T + 128 * c) * INW;
    if (unit >= 0) {
        u32x4 kv[4], vv[8];
#pragma unroll
        for (int i = 0; i < 4; ++i) { const int idx = ht + 256 * i, row = idx >> 3, ch = idx & 7; kv[i] = *(const u32x4*)(zr + 3584 + h * 64 + (size_t)row * INW + ch * 8); }
#pragma unroll
        for (int i = 0; i < 8; ++i) { const int idx = ht + 256 * i, row = idx >> 4, ch = idx & 15; vv[i] = *(const u32x4*)(zr + 4096 + h * 128 + (size_t)row * INW + ch * 8); }
#pragma unroll
        for (int i = 0; i < 4; ++i) {
            const int idx = ht + 256 * i, row = idx >> 3, ch = idx & 7;
            const float dc = __builtin_amdgcn_exp2f((float)(127 - row) * l2g);
            u32x4 v = kv[i];
            v.x = pk(bflo(v.x) * dc, bfhi(v.x) * dc); v.y = pk(bflo(v.y) * dc, bfhi(v.y) * dc); v.z = pk(bflo(v.z) * dc, bfhi(v.z) * dc); v.w = pk(bflo(v.w) * dc, bfhi(v.w) * dc);
            *(MK_LAS u32x4*)(KI + row * KP + ch * 16) = v;
        }
#pragma unroll
        for (int i = 0; i < 8; ++i) { const int idx = ht + 256 * i, row = idx >> 4, ch = idx & 15; *(MK_LAS u32x4*)(VI + row * VP + ch * 16) = vv[i]; }
    }
    __syncthreads();
    if (unit >= 0) {
        const int fr = lane & 15, fq = lane >> 4, q4 = fr >> 2, p4 = lane & 3, rb = hw;
        f32x4 acc[8];
#pragma unroll
        for (int j = 0; j < 8; ++j) acc[j] = (f32x4){0.f, 0.f, 0.f, 0.f};
#pragma unroll
        for (int ks = 0; ks < 4; ++ks) {
            const int row0 = 32 * ks + 8 * fq + q4;
            const bf16x8 af = cat8(tr_rd(KI + row0 * KP + (16 * rb + 4 * p4) * 2), tr_rd(KI + (row0 + 4) * KP + (16 * rb + 4 * p4) * 2));
#pragma unroll
            for (int j = 0; j < 8; ++j) {
                const bf16x8 bf = cat8(tr_rd(VI + row0 * VP + (16 * j + 4 * p4) * 2), tr_rd(VI + (row0 + 4) * VP + (16 * j + 4 * p4) * 2));
                acc[j] = mfma16(af, bf, acc[j]);
            }
        }
        float* up = U + (size_t)unit * 8192;
#pragma unroll
        for (int j = 0; j < 8; ++j)
#pragma unroll
            for (int i = 0; i < 4; ++i) up[(16 * rb + 4 * fq + i) * 128 + 16 * j + fr] = acc[j][i];
    }
    __syncthreads();
}
__device__ __forceinline__ void retu_units(MK_LAS unsigned char* lds, const bf16_t* Z, float* U, int first, int stride, int nunits, int tid, int wave, int lane) {
    asm volatile("" : "+v"(lane), "+v"(tid));
    if (first >= nunits) return;
    MK_LAS unsigned char* KI = lds; MK_LAS unsigned char* VI = lds + 32768;
    u32x4 kv[2], vv[4];
#define MK_RETU_LOAD(unit_) do { const int bh_ = (unit_) >> 4, c_ = (unit_) & 15, b_ = bh_ >> 3, h_ = bh_ & 7; const bf16_t* zr_ = Z + ((size_t)b_ * T + 128 * c_) * INW; \
        _Pragma("unroll") for (int i = 0; i < 2; ++i) { const int idx = tid + 512 * i, row = idx >> 3, ch = idx & 7; kv[i] = *(const u32x4*)(zr_ + 3584 + h_ * 64 + (size_t)row * INW + ch * 8); } \
        _Pragma("unroll") for (int i = 0; i < 4; ++i) { const int idx = tid + 512 * i, row = idx >> 4, ch = idx & 15; vv[i] = *(const u32x4*)(zr_ + 4096 + h_ * 128 + (size_t)row * INW + ch * 8); } } while (0)
    MK_RETU_LOAD(first);
    for (int unit = first; unit < nunits; unit += stride) {
        const int h = (unit >> 4) & 7;
        const float l2g = log2f(1.f - exp2f(-5.f - (float)h));
#pragma unroll
        for (int i = 0; i < 2; ++i) {
            const int idx = tid + 512 * i, row = idx >> 3, ch = idx & 7;
            const float dc = __builtin_amdgcn_exp2f((float)(127 - row) * l2g);
            u32x4 v = kv[i];
            v.x = pk(bflo(v.x) * dc, bfhi(v.x) * dc); v.y = pk(bflo(v.y) * dc, bfhi(v.y) * dc); v.z = pk(bflo(v.z) * dc, bfhi(v.z) * dc); v.w = pk(bflo(v.w) * dc, bfhi(v.w) * dc);
            *(MK_LAS u32x4*)(KI + row * KP + ch * 16) = v;
        }
#pragma unroll
        for (int i = 0; i < 4; ++i) { const int idx = tid + 512 * i, row = idx >> 4, ch = idx & 15; *(MK_LAS u32x4*)(VI + row * VP + ch * 16) = vv[i]; }
        asm volatile("" ::: "memory");
        if (unit + stride < nunits) MK_RETU_LOAD(unit + stride);
        __syncthreads();
        const int fr = lane & 15, fq = lane >> 4, q4 = fr >> 2, p4 = lane & 3, rb = wave & 3, cb0 = 4 * (wave >> 2);
        f32x4 acc[4];
#pragma unroll
        for (int j = 0; j < 4; ++j) acc[j] = (f32x4){0.f, 0.f, 0.f, 0.f};
#pragma unroll
        for (int ks = 0; ks < 4; ++ks) {
            const int row0 = 32 * ks + 8 * fq + q4;
            const bf16x8 af = cat8(tr_rd(KI + row0 * KP + (16 * rb + 4 * p4) * 2), tr_rd(KI + (row0 + 4) * KP + (16 * rb + 4 * p4) * 2));
#pragma unroll
            for (int j = 0; j < 4; ++j) {
                const bf16x8 bf = cat8(tr_rd(VI + row0 * VP + (16 * (cb0 + j) + 4 * p4) * 2), tr_rd(VI + (row0 + 4) * VP + (16 * (cb0 + j) + 4 * p4) * 2));
                acc[j] = mfma16(af, bf, acc[j]);
            }
        }
        float* up = U + (size_t)unit * 8192;
#pragma unroll
        for (int j = 0; j < 4; ++j)
#pragma unroll
            for (int i = 0; i < 4; ++i) up[(16 * rb + 4 * fq + i) * 128 + 16 * (cb0 + j) + fr] = acc[j][i];
        __syncthreads();
    }
#undef MK_RETU_LOAD
}
struct NoJob { __device__ __forceinline__ void operator()() const {} };
template <class JPre = NoJob, class JPost = NoJob> __device__ __forceinline__ void reto_unit(MK_LAS unsigned char* lds, const bf16_t* Z, const float* U, bf16_t* MIX, const float* gng, const float* gnb, float* sfin  ,
                                          int unit, int tid, int wave, int lane, const JPre& jpre = JPre(), const JPost& jpost = JPost()) {
    asm volatile("" : "+v"(lane), "+v"(tid));
    const int pass = unit >> 8, idx = unit & 255, bh = (idx >> 3) , c = pass ? (idx & 7) : 15 - (idx & 7), b = bh >> 3, h = bh & 7;
    const float l2g = log2f(1.f - exp2f(-5.f - (float)h));
    const float G = __builtin_amdgcn_exp2f(128.f * l2g);
    const size_t row0g = (size_t)b * T + 128 * c;
    const bf16_t* zr = Z + row0g * INW;
    MK_LAS unsigned char* QI = lds; MK_LAS unsigned char* KI = lds + 18432; MK_LAS unsigned char* VI = lds + 36864; MK_LAS unsigned char* SI = lds + 71680;
    const float* ub = U + (size_t)bh * 16 * 8192;
    u32x4 qv[2], kv[2], vv[4];
#pragma unroll
    for (int i = 0; i < 2; ++i) { const int idx = tid + 512 * i, row = idx >> 3, ch = idx & 7; qv[i] = *(const u32x4*)(zr + 3072 + h * 64 + (size_t)row * INW + ch * 8); kv[i] = *(const u32x4*)(zr + 3584 + h * 64 + (size_t)row * INW + ch * 8); }
#pragma unroll
    for (int i = 0; i < 4; ++i) { const int idx = tid + 512 * i, row = idx >> 4, ch = idx & 15; vv[i] = *(const u32x4*)(zr + 4096 + h * 128 + (size_t)row * INW + ch * 8); }
    jpre();
    asm volatile("" ::: "memory");
    {
        f32x4 S[4];
#pragma unroll
        for (int k = 0; k < 4; ++k) S[k] = (f32x4){0.f, 0.f, 0.f, 0.f};
#pragma unroll 4
        for (int cc = 0; cc < c; ++cc) {
            f32x4 v[4];
#pragma unroll
            for (int k = 0; k < 4; ++k) v[k] = *(const f32x4*)(ub + (size_t)cc * 8192 + tid * 4 + 2048 * k);
#pragma unroll
            for (int k = 0; k < 4; ++k) S[k] = S[k] * G + v[k];
        }
#pragma unroll
        for (int k = 0; k < 4; ++k) {
            const int e = tid * 4 + 2048 * k;
            u32x2 w; w.x = pk(S[k][0], S[k][1]); w.y = pk(S[k][2], S[k][3]);
            *(MK_LAS u32x2*)(SI + (e >> 7) * VP + (e & 127) * 2) = w;
            if (c == 15) *(f32x4*)(sfin + (size_t)bh * 8192 + e) = S[k] * G + *(const f32x4*)(ub + (size_t)15 * 8192 + e);
        }
    }
    jpost();
#pragma unroll
    for (int i = 0; i < 2; ++i) { const int idx = tid + 512 * i, row = idx >> 3, ch = idx & 7; *(MK_LAS u32x4*)(QI + row * KP + ch * 16) = qv[i]; *(MK_LAS u32x4*)(KI + row * KP + ch * 16) = kv[i]; }
#pragma unroll
    for (int i = 0; i < 4; ++i) { const int idx = tid + 512 * i, row = idx >> 4, ch = idx & 15; *(MK_LAS u32x4*)(VI + row * VP + ch * 16) = vv[i]; }
    __syncthreads();
    const int fr = lane & 15, fq = lane >> 4, q4 = fr >> 2, p4 = lane & 3, i0 = 16 * wave, smax = wave >> 1;
    bf16x8 qf[2];
#pragma unroll
    for (int ks = 0; ks < 2; ++ks) qf[ks] = *(const MK_LAS bf16x8*)(QI + (i0 + fr) * KP + (32 * ks + 8 * fq) * 2);
    f32x4 O1[8], O2[8];
#pragma unroll
    for (int cb = 0; cb < 8; ++cb) { O1[cb] = (f32x4){0.f, 0.f, 0.f, 0.f}; O2[cb] = O1[cb]; }
    const int iq = i0 + fr;
#pragma unroll
    for (int s = 0; s < 4; ++s) {
        if (s <= smax) {
            float p[8];
#pragma unroll
            for (int u = 0; u < 2; ++u) {
                const int krow = 32 * s + 8 * (fr >> 2) + 4 * u + (fr & 3);
                f32x4 P = (f32x4){0.f, 0.f, 0.f, 0.f};
#pragma unroll
                for (int ks = 0; ks < 2; ++ks) { const bf16x8 kf = *(const MK_LAS bf16x8*)(KI + krow * KP + (32 * ks + 8 * fq) * 2); P = mfma16(kf, qf[ks], P); }
#pragma unroll
                for (int i = 0; i < 4; ++i) { const int kap = 32 * s + 8 * fq + 4 * u + i; p[4 * u + i] = (iq >= kap) ? P[i] * __builtin_amdgcn_exp2f((float)(iq - kap) * l2g) : 0.f; }
            }
            u32x4 w; w.x = pk(p[0], p[1]); w.y = pk(p[2], p[3]); w.z = pk(p[4], p[5]); w.w = pk(p[6], p[7]);
            const bf16x8 pfr = __builtin_bit_cast(bf16x8, w);
            const int row0 = 32 * s + 8 * fq + q4;
#pragma unroll
            for (int cb = 0; cb < 8; ++cb) {
                const int dch = (32 * (cb >> 1) + 8 * p4 + 4 * (cb & 1)) * 2;
                const bf16x8 vf = cat8(tr_rd(VI + row0 * VP + dch), tr_rd(VI + (row0 + 4) * VP + dch));
                O1[cb] = mfma16(vf, pfr, O1[cb]);
            }
        }
    }
#pragma unroll
    for (int ks = 0; ks < 2; ++ks) {
        const int row0 = 32 * ks + 8 * fq + q4;
#pragma unroll
        for (int cb = 0; cb < 8; ++cb) {
            const int dch = (32 * (cb >> 1) + 8 * p4 + 4 * (cb & 1)) * 2;
            const bf16x8 sf = cat8(tr_rd(SI + row0 * VP + dch), tr_rd(SI + (row0 + 4) * VP + dch));
            O2[cb] = mfma16(sf, qf[ks], O2[cb]);
        }
    }
    {
        const int il = i0 + fr;
        const float qd = __builtin_amdgcn_exp2f((float)(il + 1) * l2g);
        float s = 0.f;
#pragma unroll
        for (int cb = 0; cb < 8; ++cb) { O1[cb] = O1[cb] + qd * O2[cb]; s += (O1[cb][0] + O1[cb][1]) + (O1[cb][2] + O1[cb][3]); }
        s += shx(s, 16, lane); s += shx(s, 32, lane);
        const float mu = s * (1.f / 128.f);
        float q = 0.f;
#pragma unroll
        for (int cb = 0; cb < 8; ++cb)
#pragma unroll
            for (int i = 0; i < 4; ++i) { const float dd = O1[cb][i] - mu; q += dd * dd; }
        q += shx(q, 16, lane); q += shx(q, 32, lane);
        const float rstd = 1.0f / sqrtf(q * (1.f / 128.f) + GN_EPS);
        const size_t trow = row0g + il;
        u32x4 gzv[4]; f32x4 g0v[4], g1v[4], b0v[4], b1v[4];
#pragma unroll
        for (int cp = 0; cp < 4; ++cp) {
            const int dv = h * 128 + 32 * cp + 8 * fq;
            gzv[cp] = *(const u32x4*)(Z + trow * INW + 5120 + dv);
            g0v[cp] = *(const f32x4*)(gng + dv); g1v[cp] = *(const f32x4*)(gng + dv + 4); b0v[cp] = *(const f32x4*)(gnb + dv); b1v[cp] = *(const f32x4*)(gnb + dv + 4);
        }
        asm volatile("" ::: "memory");
#pragma unroll
        for (int cp = 0; cp < 4; ++cp) {
            const int dv = h * 128 + 32 * cp + 8 * fq;
            const u32x4 gz = gzv[cp];
            const f32x4 g0 = g0v[cp], g1 = g1v[cp], b0 = b0v[cp], b1 = b1v[cp];
            float r[8];
#pragma unroll
            for (int j = 0; j < 8; ++j) {
                const unsigned gw_ = gz[j >> 1];
                const float gbv = (j & 1) ? bfhi(gw_) : bflo(gw_);
                const float ov = O1[2 * cp + (j >> 2)][j & 3], gg = (j < 4) ? g0[j & 3] : g1[j & 3], bb = (j < 4) ? b0[j & 3] : b1[j & 3];
                r[j] = ((ov - mu) * rstd * gg + bb) * gbv * sigmoid_f(gbv);
            }
            u32x4 w; w.x = pk(r[0], r[1]); w.y = pk(r[2], r[3]); w.z = pk(r[4], r[5]); w.w = pk(r[6], r[7]);
            *(u32x4*)(MIX + trow * D + 1024 + dv) = w;
        }
    }
    __syncthreads();
}
struct CombRegs2 { u32x4 a[2][2], b[2][2], c[2][2]; float l0[2][2], l1[2][2], l2[2][2]; };
__device__ __forceinline__ void combine_load2(const bf16_t* __restrict__ OG, const float* __restrict__ LSE, int t0, int tstride, int lane, CombRegs2& R) {
#pragma unroll
    for (int r = 0; r < 2; ++r)
#pragma unroll
        for (int j = 0; j < 2; ++j) {
            const int t = t0 + r * tstride, c8 = lane + 64 * j, h = c8 >> 4;
            R.l0[r][j] = LSE[(size_t)t * 8 + h]; R.l1[r][j] = LSE[(size_t)M * 8 + (size_t)t * 8 + h]; R.l2[r][j] = LSE[(size_t)2 * M * 8 + (size_t)t * 8 + h];
            R.a[r][j] = *(const u32x4*)(OG + (size_t)t * 1024 + 8 * c8); R.b[r][j] = *(const u32x4*)(OG + (size_t)M * 1024 + (size_t)t * 1024 + 8 * c8); R.c[r][j] = *(const u32x4*)(OG + (size_t)2 * M * 1024 + (size_t)t * 1024 + 8 * c8);
        }
}
__device__ __forceinline__ void combine_finish2(bf16_t* __restrict__ MIX, int t0, int tstride, int lane, const CombRegs2& R) {
#pragma unroll
    for (int r = 0; r < 2; ++r)
#pragma unroll
        for (int j = 0; j < 2; ++j) {
            const int t = t0 + r * tstride, c8 = lane + 64 * j;
            const float mx = fmaxf(R.l0[r][j], fmaxf(R.l1[r][j], R.l2[r][j]));
            float w0 = __builtin_amdgcn_exp2f((R.l0[r][j] - mx) * LOG2E), w1 = __builtin_amdgcn_exp2f((R.l1[r][j] - mx) * LOG2E), w2 = __builtin_amdgcn_exp2f((R.l2[r][j] - mx) * LOG2E);
            const float inv = 1.0f / (w0 + w1 + w2); w0 *= inv; w1 *= inv; w2 *= inv;
            u32x4 o;
#pragma unroll
            for (int e = 0; e < 4; ++e) o[e] = pk(w0 * bflo(R.a[r][j][e]) + w1 * bflo(R.b[r][j][e]) + w2 * bflo(R.c[r][j][e]), w0 * bfhi(R.a[r][j][e]) + w1 * bfhi(R.b[r][j][e]) + w2 * bfhi(R.c[r][j][e]));
            *(u32x4*)(MIX + (size_t)t * D + 8 * c8) = o;
        }
}
template <int NR> __device__ __forceinline__ void combine_rows(const bf16_t* __restrict__ OG, const float* __restrict__ LSE, bf16_t* __restrict__ MIX, int t0, int tstride, int lane) {
    asm volatile("" : "+v"(lane));
    u32x4 a[NR][2], b[NR][2], c[NR][2]; float l0[NR][2], l1[NR][2], l2[NR][2];
#pragma unroll
    for (int r = 0; r < NR; ++r)
#pragma unroll
        for (int j = 0; j < 2; ++j) {
            const int t = t0 + r * tstride, c8 = lane + 64 * j, h = c8 >> 4;
            l0[r][j] = LSE[(size_t)t * 8 + h]; l1[r][j] = LSE[(size_t)M * 8 + (size_t)t * 8 + h]; l2[r][j] = LSE[(size_t)2 * M * 8 + (size_t)t * 8 + h];
            a[r][j] = *(const u32x4*)(OG + (size_t)t * 1024 + 8 * c8); b[r][j] = *(const u32x4*)(OG + (size_t)M * 1024 + (size_t)t * 1024 + 8 * c8); c[r][j] = *(const u32x4*)(OG + (size_t)2 * M * 1024 + (size_t)t * 1024 + 8 * c8);
        }
#pragma unroll
    for (int r = 0; r < NR; ++r)
#pragma unroll
        for (int j = 0; j < 2; ++j) {
            const int t = t0 + r * tstride, c8 = lane + 64 * j;
            const float mx = fmaxf(l0[r][j], fmaxf(l1[r][j], l2[r][j]));
            float w0 = __builtin_amdgcn_exp2f((l0[r][j] - mx) * LOG2E), w1 = __builtin_amdgcn_exp2f((l1[r][j] - mx) * LOG2E), w2 = __builtin_amdgcn_exp2f((l2[r][j] - mx) * LOG2E);
            const float inv = 1.0f / (w0 + w1 + w2); w0 *= inv; w1 *= inv; w2 *= inv;
            u32x4 o;
#pragma unroll
            for (int e = 0; e < 4; ++e) o[e] = pk(w0 * bflo(a[r][j][e]) + w1 * bflo(b[r][j][e]) + w2 * bflo(c[r][j][e]), w0 * bfhi(a[r][j][e]) + w1 * bfhi(b[r][j][e]) + w2 * bfhi(c[r][j][e]));
            *(u32x4*)(MIX + (size_t)t * D + 8 * c8) = o;
        }
}

__device__ __forceinline__ void ld8(const float* p, float (&v)[8]) { const f32x4 a = *(const f32x4*)p, b = *(const f32x4*)(p + 4); v[0] = a[0]; v[1] = a[1]; v[2] = a[2]; v[3] = a[3]; v[4] = b[0]; v[5] = b[1]; v[6] = b[2]; v[7] = b[3]; }
struct ABDirect { const float* src; int ld; __device__ __forceinline__ void val8(int row, int k0, float (&v)[8]) const { ld8(src + row * ld + k0, v); } };
struct ABResid {
    const float* ys; const float* sst; int ident; const float* g; const float* b; const float* rawp; float scale; int mode; const float* pws; const float* c1; const float* c2;
    __device__ __forceinline__ void val8(int row, int k0, float (&v)[8]) const {
        float y[8], rp[8]; ld8(ys + row * D + k0, y); ld8(rawp + row * D + k0, rp);
        float mu = 0.f, rs = 1.f;
        if (!ident) { mu = sst[2 * row]; rs = sst[2 * row + 1]; float gg[8], bb[8]; ld8(g + k0, gg); ld8(b + k0, bb);
#pragma unroll
            for (int e = 0; e < 8; ++e) y[e] = (y[e] - mu) * rs * gg[e] + bb[e]; }
        if (mode == 0) {
#pragma unroll
            for (int e = 0; e < 8; ++e) v[e] = __builtin_fmaf(ALPHA, y[e], scale * rp[e]);
        } else {
            float pp[8], a1[8], a2[8]; ld8(pws + row * D + k0, pp); ld8(c1 + k0, a1); ld8(c2 + k0, a2);
#pragma unroll
            for (int e = 0; e < 8; ++e) v[e] = __builtin_fmaf(ALPHA, y[e], pp[e] * sigmoid_f(__builtin_fmaf(rp[e] - mu * a1[e], rs, a2[e])));
        }
    }
};
struct ABSwi {
    const float* raw; const float* sst; int ident; const float* c1; const float* c2;
    __device__ __forceinline__ void val8(int row, int k0, float (&v)[8]) const {
        const int gi = 256 * (k0 >> 7) + (k0 & 127);
        float gg[8], uu[8]; ld8(raw + row * NUP + gi, gg); ld8(raw + row * NUP + gi + 128, uu);
        if (!ident) { const float mu = sst[2 * row], rs = sst[2 * row + 1]; float a1[8], a2[8], b1[8], b2[8]; ld8(c1 + gi, a1); ld8(c2 + gi, a2); ld8(c1 + gi + 128, b1); ld8(c2 + gi + 128, b2);
#pragma unroll
            for (int e = 0; e < 8; ++e) { gg[e] = (gg[e] - mu * a1[e]) * rs + a2[e]; uu[e] = (uu[e] - mu * b1[e]) * rs + b2[e]; } }
#pragma unroll
        for (int e = 0; e < 8; ++e) v[e] = gg[e] * uu[e] * sigmoid_f(gg[e]);
    }
};
template <int KS32, class AB, int NG = 1> __device__ __forceinline__ void skinny(const bf16_t* Wt, int N, float* raw, const AB& ab, MK_LAS float* red, int tid, int wave, int lane, int gfirst, int gstride) {
    asm volatile("" : "+v"(lane), "+v"(tid));
    constexpr int K = KS32 * 32 * 8;
    const int fr = lane & 15, fq = lane >> 4, k0 = wave * (KS32 * 32), ng = N >> 4;
    if (gfirst < 0 || gfirst >= ng) return;
    bf16x8 bfr[NG][KS32];
#pragma unroll
    for (int gi = 0; gi < NG; ++gi) {
        const int g = gfirst + gi * gstride;
        if (g < ng) {
            const bf16_t* wp0 = Wt + (size_t)(16 * g + fr) * K + k0 + 8 * fq;
#pragma unroll
            for (int s = 0; s < KS32; ++s) bfr[gi][s] = *(const bf16x8*)(wp0 + 32 * s);
        }
    }
    bf16x8 afr[KS32];
#pragma unroll
    for (int s = 0; s < KS32; ++s) {
        u32x4 w = (u32x4){0u, 0u, 0u, 0u};
        if (fr < 8) { float v[8]; ab.val8(fr, k0 + 32 * s + 8 * fq, v); w.x = pk(v[0], v[1]); w.y = pk(v[2], v[3]); w.z = pk(v[4], v[5]); w.w = pk(v[6], v[7]); }
        afr[s] = __builtin_bit_cast(bf16x8, w);
    }
    for (int g0 = gfirst; g0 < ng; g0 += NG * gstride) {
        if (g0 != gfirst) {
#pragma unroll
            for (int gi = 0; gi < NG; ++gi) {
                const int g = g0 + gi * gstride;
                if (g < ng) {
                    const bf16_t* wp = Wt + (size_t)(16 * g + fr) * K + k0 + 8 * fq;
#pragma unroll
                    for (int s = 0; s < KS32; ++s) bfr[gi][s] = *(const bf16x8*)(wp + 32 * s);
                }
            }
        }
#pragma unroll
        for (int gi = 0; gi < NG; ++gi) {
            if (g0 + gi * gstride < ng) {
                f32x4 acc = (f32x4){0.f, 0.f, 0.f, 0.f};
#pragma unroll
                for (int s = 0; s < KS32; ++s) acc = mfma16(afr[s], bfr[gi][s], acc);
                if (fq < 2) {
#pragma unroll
                    for (int i = 0; i < 4; ++i) red[(gi * 8 + wave) * 128 + (4 * fq + i) * 16 + fr] = acc[i];
                }
            }
        }
        __syncthreads();
        if (tid < NG * 128) {
            const int gi = tid >> 7, idx = tid & 127, g = g0 + gi * gstride;
            if (g < ng) {
                float s = 0.f;
#pragma unroll
                for (int w8 = 0; w8 < 8; ++w8) s += red[(gi * 8 + w8) * 128 + idx];
                raw[(size_t)(idx >> 4) * N + 16 * g + (idx & 15)] = s;
            }
        }
        __syncthreads();
    }
}
struct ABRaw8 { const unsigned char* src; };
template <int NS, class AB, int NG = 1, int UNR = 2, bool RAW8 = false> __device__ __forceinline__ void skinny8(const unsigned char* W8, int N, int K, float* raw, const AB& ab, float ascale, float oscale, MK_LAS unsigned char* lds, int tid, int wave, int lane, int gfirst, int gstride) {
    asm volatile("" : "+v"(lane), "+v"(tid));
    typedef int v8i __attribute__((ext_vector_type(8)));
    MK_LAS unsigned char* ai = lds;
    MK_LAS float* red = (MK_LAS float*)(lds + 49152);
    const int fr = lane & 15, fq = lane >> 4, ng = N >> 4, nst = K >> 7, base = nst >> 3, rem = nst & 7, k8n = K >> 3;
    const int cnt = base + (wave < rem ? 1 : 0), s0 = wave * base + (wave < rem ? wave : rem);
    if (gfirst < 0 || gfirst >= ng) return;
    v8i bfr[NG][NS];
#pragma unroll
    for (int gi = 0; gi < NG; ++gi) {
        const int g = gfirst + gi * gstride;
        const unsigned char* wp = W8 + (size_t)(16 * g + fr) * K + 128 * s0 + 32 * fq;
#pragma unroll
        for (int s = 0; s < NS; ++s) {
            if (g < ng && s < cnt) { const u32x4 b0 = *(const u32x4*)(wp + 128 * s), b1 = *(const u32x4*)(wp + 128 * s + 16); bfr[gi][s] = (v8i){(int)b0.x, (int)b0.y, (int)b0.z, (int)b0.w, (int)b1.x, (int)b1.y, (int)b1.z, (int)b1.w}; }
            else bfr[gi][s] = (v8i){0, 0, 0, 0, 0, 0, 0, 0};
        }
    }
    if constexpr (RAW8) {
        u32x4 cp[6];
#pragma unroll
        for (int j = 0; j < 6; ++j) { const int it = tid + j * NTHR; if (16 * it < 8 * K) cp[j] = *(const u32x4*)(ab.src + 16 * it); }
#pragma unroll
        for (int j = 0; j < 6; ++j) { const int it = tid + j * NTHR; if (16 * it < 8 * K) *(MK_LAS u32x4*)(ai + 16 * it) = cp[j]; }
    } else
    for (int it0 = tid; it0 < K; it0 += UNR * NTHR) {
        float v[UNR][8];
#pragma unroll
        for (int j = 0; j < UNR; ++j) { const int it = it0 + j * NTHR; if (it < K) { const int row = it / k8n, k8 = it - row * k8n; if constexpr (!RAW8) ab.val8(row, 8 * k8, v[j]); } }
#pragma unroll
        for (int j = 0; j < UNR; ++j) {
            const int it = it0 + j * NTHR;
            if (it < K) { const int row = it / k8n, k8 = it - row * k8n;
                u32x2 w; w.x = pk8(v[j][0] * ascale, v[j][1] * ascale, v[j][2] * ascale, v[j][3] * ascale); w.y = pk8(v[j][4] * ascale, v[j][5] * ascale, v[j][6] * ascale, v[j][7] * ascale);
                *(MK_LAS u32x2*)(ai + row * K + 8 * k8) = w; }
        }
    }
    __syncthreads();
    v8i afr[NS];
#pragma unroll
    for (int s = 0; s < NS; ++s) {
        afr[s] = (v8i){0, 0, 0, 0, 0, 0, 0, 0};
        if (fr < 8 && s < cnt) { const MK_LAS unsigned char* ap = ai + fr * K + 128 * (s0 + s) + 32 * fq; const u32x4 a0 = *(const MK_LAS u32x4*)ap, a1 = *(const MK_LAS u32x4*)(ap + 16);
            afr[s] = (v8i){(int)a0.x, (int)a0.y, (int)a0.z, (int)a0.w, (int)a1.x, (int)a1.y, (int)a1.z, (int)a1.w}; }
    }
    for (int g0 = gfirst; g0 < ng; g0 += NG * gstride) {
        if (g0 != gfirst) {
#pragma unroll
            for (int gi = 0; gi < NG; ++gi) {
                const int g = g0 + gi * gstride;
                const unsigned char* wp = W8 + (size_t)(16 * g + fr) * K + 128 * s0 + 32 * fq;
#pragma unroll
                for (int s = 0; s < NS; ++s) {
                    if (g < ng && s < cnt) { const u32x4 b0 = *(const u32x4*)(wp + 128 * s), b1 = *(const u32x4*)(wp + 128 * s + 16); bfr[gi][s] = (v8i){(int)b0.x, (int)b0.y, (int)b0.z, (int)b0.w, (int)b1.x, (int)b1.y, (int)b1.z, (int)b1.w}; }
                    else bfr[gi][s] = (v8i){0, 0, 0, 0, 0, 0, 0, 0};
                }
            }
        }
#pragma unroll
        for (int gi = 0; gi < NG; ++gi) {
            if (g0 + gi * gstride < ng) {
                f32x4 acc = (f32x4){0.f, 0.f, 0.f, 0.f};
#pragma unroll
                for (int s = 0; s < NS; ++s) acc = __builtin_amdgcn_mfma_scale_f32_16x16x128_f8f6f4(afr[s], bfr[gi][s], acc, 0, 0, 0, 0x7F7F7F7F, 0, 0x7F7F7F7F);
                if (fq < 2) {
#pragma unroll
                    for (int i = 0; i < 4; ++i) red[(gi * 8 + wave) * 128 + (4 * fq + i) * 16 + fr] = acc[i];
                }
            }
        }
        __syncthreads();
        if (tid < NG * 128) {
            const int gi = tid >> 7, idx = tid & 127, g = g0 + gi * gstride;
            if (g < ng) {
                float s = 0.f;
#pragma unroll
                for (int w8 = 0; w8 < 8; ++w8) s += red[(gi * 8 + w8) * 128 + idx];
                raw[(size_t)(idx >> 4) * N + 16 * g + (idx & 15)] = s * oscale;
            }
        }
        __syncthreads();
    }
}
template <class AB> __device__ __forceinline__ void skinny8_swi(const unsigned char* W8, const AB& ab, int ident, const float* c1, const float* c2, unsigned char* HS, MK_LAS unsigned char* lds, int tid, int wave, int lane, int bx) {
    asm volatile("" : "+v"(lane), "+v"(tid));
    typedef int v8i __attribute__((ext_vector_type(8)));
    constexpr int K = D, NS = 2, NG = 4, NP = NUP / 32;
    MK_LAS unsigned char* ai = lds;
    MK_LAS float* stp = (MK_LAS float*)(lds + 16384);
    MK_LAS float* stt = (MK_LAS float*)(lds + 16384 + 512);
    MK_LAS float* zt = (MK_LAS float*)(lds + 20480);
    MK_LAS float* red = (MK_LAS float*)(lds + 49152);
    const int fr = lane & 15, fq = lane >> 4, s0 = wave * 2;
    v8i bfr[NG][NS];
#pragma unroll
    for (int gi = 0; gi < NG; ++gi) {
        const int p = bx + 256 * (gi >> 1), g = 16 * (p >> 3) + (p & 7) + 8 * (gi & 1);
        const unsigned char* wp = W8 + (size_t)(16 * g + fr) * K + 128 * s0 + 32 * fq;
#pragma unroll
        for (int s = 0; s < NS; ++s) {
            if (p < NP) { const u32x4 b0 = *(const u32x4*)(wp + 128 * s), b1 = *(const u32x4*)(wp + 128 * s + 16); bfr[gi][s] = (v8i){(int)b0.x, (int)b0.y, (int)b0.z, (int)b0.w, (int)b1.x, (int)b1.y, (int)b1.z, (int)b1.w}; }
            else bfr[gi][s] = (v8i){0, 0, 0, 0, 0, 0, 0, 0};
        }
    }
    {
        float v[4][8];
#pragma unroll
        for (int j = 0; j < 4; ++j) ab.val8((tid >> 8) + 2 * j, 8 * (tid & 255), v[j]);
#pragma unroll
        for (int j = 0; j < 4; ++j) {
            float sm = 0.f, sq = 0.f;
#pragma unroll
            for (int e = 0; e < 8; ++e) { sm += v[j][e]; sq += v[j][e] * v[j][e]; }
#pragma unroll
            for (int o = 32; o > 0; o >>= 1) { sm += shx(sm, o, lane); sq += shx(sq, o, lane); }
            if (lane == 0) { stp[(wave * 4 + j) * 2] = sm; stp[(wave * 4 + j) * 2 + 1] = sq; }
            u32x2 w; w.x = pk8(v[j][0], v[j][1], v[j][2], v[j][3]); w.y = pk8(v[j][4], v[j][5], v[j][6], v[j][7]);
            *(MK_LAS u32x2*)(ai + ((tid >> 8) + 2 * j) * K + 8 * (tid & 255)) = w;
        }
    }
    __syncthreads();
    if (tid < 8) {
        float sm = 0.f, sq = 0.f;
#pragma unroll
        for (int w4 = 0; w4 < 4; ++w4) { sm += stp[((4 * (tid & 1) + w4) * 4 + (tid >> 1)) * 2]; sq += stp[((4 * (tid & 1) + w4) * 4 + (tid >> 1)) * 2 + 1]; }
        const float mu = sm * (1.f / 2048.f), var = fmaxf(sq * (1.f / 2048.f) - mu * mu, 0.f);
        stt[2 * tid] = mu; stt[2 * tid + 1] = 1.0f / sqrtf(var + LN_EPS);
    }
    v8i afr[NS];
#pragma unroll
    for (int s = 0; s < NS; ++s) {
        afr[s] = (v8i){0, 0, 0, 0, 0, 0, 0, 0};
        if (fr < 8) { const MK_LAS unsigned char* ap = ai + fr * K + 128 * (s0 + s) + 32 * fq; const u32x4 a0 = *(const MK_LAS u32x4*)ap, a1 = *(const MK_LAS u32x4*)(ap + 16);
            afr[s] = (v8i){(int)a0.x, (int)a0.y, (int)a0.z, (int)a0.w, (int)a1.x, (int)a1.y, (int)a1.z, (int)a1.w}; }
    }
#pragma unroll
    for (int gi = 0; gi < NG; ++gi) {
        if (bx + 256 * (gi >> 1) < NP) {
            f32x4 acc = (f32x4){0.f, 0.f, 0.f, 0.f};
#pragma unroll
            for (int s = 0; s < NS; ++s) acc = __builtin_amdgcn_mfma_scale_f32_16x16x128_f8f6f4(afr[s], bfr[gi][s], acc, 0, 0, 0, 0x7F7F7F7F, 0, 0x7F7F7F7F);
            if (fq < 2) {
#pragma unroll
                for (int i = 0; i < 4; ++i) red[(gi * 8 + wave) * 128 + (4 * fq + i) * 16 + fr] = acc[i];
            }
        }
    }
    __syncthreads();
    const int gi = tid >> 7, idx = tid & 127, p = bx + 256 * (gi >> 1), r = idx >> 4;
    if (p < NP) {
        float sm = 0.f;
#pragma unroll
        for (int w8 = 0; w8 < 8; ++w8) sm += red[(gi * 8 + w8) * 128 + idx];
        MK_OPQF(kinv, 1.f / W8S);
        const float val = sm * kinv;
        const int col = 16 * (16 * (p >> 3) + (p & 7) + 8 * (gi & 1)) + (idx & 15);
        zt[gi * 128 + idx] = ident ? val : (val - stt[2 * r] * c1[col]) * stt[2 * r + 1] + c2[col];
    }
    __syncthreads();
    if (p < NP && (gi & 1) == 0) {
        const float gg = zt[gi * 128 + idx], uu = zt[(gi + 1) * 128 + idx];
        const float h = gg * uu * sigmoid_f(gg) * H8S;
        HS[(size_t)r * FF + (p >> 3) * 128 + 16 * (p & 7) + (idx & 15)] = (unsigned char)(pk8(h, 0.f, 0.f, 0.f) & 0xffu);
    }
}
template <class AB> __device__ __forceinline__ void smp_update(const AB& ab, float* ysn, float* sstn, int wave, int lane) {
    float s = 0.f, q = 0.f;
    float vall[4][8];
#pragma unroll
    for (int j = 0; j < 4; ++j) ab.val8(wave, lane * 8 + 512 * j, vall[j]);
    asm volatile("" ::: "memory");
#pragma unroll
    for (int j = 0; j < 4; ++j) {
        const int kb = lane * 8 + 512 * j;
        float (&v)[8] = vall[j];
        *(f32x4*)(ysn + wave * D + kb) = (f32x4){v[0], v[1], v[2], v[3]}; *(f32x4*)(ysn + wave * D + kb + 4) = (f32x4){v[4], v[5], v[6], v[7]};
#pragma unroll
        for (int e = 0; e < 8; ++e) { s += v[e]; q += v[e] * v[e]; }
    }
#pragma unroll
    for (int o = 32; o > 0; o >>= 1) { s += shx(s, o, lane); q += shx(q, o, lane); }
    if (lane == 0) { const float mu = s * (1.f / 2048.f); const float var = fmaxf(q * (1.f / 2048.f) - mu * mu, 0.f); sstn[2 * wave] = mu; sstn[2 * wave + 1] = 1.0f / sqrtf(var + LN_EPS); }
}
struct ZsFold { const float* raw; const float* sst; const float* c1; const float* c2;
    __device__ __forceinline__ float operator()(int b, int col) const { return (raw[b * INW + col] - sst[2 * b] * c1[col]) * sst[2 * b + 1] + c2[col]; } };
__device__ __forceinline__ void smp_attn(MK_LAS float* ls, const ZsFold& zf, const float* ck, const float* cv, float* ap, float* kout, float* vout, int task, int tid, int wave, int lane) {
    asm volatile("" : "+v"(lane), "+v"(tid));
    const int b = task / 24, h = (task % 24) / 3, g = task % 3, dd = 1 << (2 * g);
    MK_LAS float* qs = ls; MK_LAS float* sc = ls + 128; MK_LAS float* kn = ls + 384; MK_LAS float* vn = ls + 512; MK_LAS float* po = ls + 640;
    const int d = tid & 127, part = tid >> 7;
    f32x2 kk[17]; float vv[33];
#pragma unroll
    for (int i = 0; i < 17; ++i) { const int j = wave + 8 * i; kk[i] = (j >= 1 && j < 129) ? *(const f32x2*)(ck + (((size_t)b * 2048 + (2048 - j * dd)) * 8 + h) * 128 + 2 * lane) : (f32x2){0.f, 0.f}; }
#pragma unroll
    for (int i = 0; i < 33; ++i) { const int j = part + 4 * i; vv[i] = (j >= 1 && j < 129) ? cv[(((size_t)b * 2048 + (2048 - j * dd)) * 8 + h) * 128 + d] : 0.f; }
    if (tid < 128) { qs[tid] = zf(b, h * 128 + tid); const float kv = zf(b, 1024 + h * 128 + tid), vv = zf(b, 2048 + h * 128 + tid); kn[tid] = kv; vn[tid] = vv;
        if (g == 0) { kout[b * 1024 + h * 128 + tid] = kv; vout[b * 1024 + h * 128 + tid] = vv; } }
    __syncthreads();
    const float slope = __builtin_amdgcn_exp2f(-(float)(h + 1));
    {
        if (wave == 0) kk[0] = (f32x2){kn[2 * lane], kn[2 * lane + 1]};
        const float q0 = qs[2 * lane], q1 = qs[2 * lane + 1];
        MK_OPQF(kscale, 0.08838834764831845f);
#pragma unroll
        for (int i = 0; i < 17; ++i) {
            const int j = wave + 8 * i;
            float dot = q0 * kk[i].x + q1 * kk[i].y;
#pragma unroll
            for (int o = 32; o > 0; o >>= 1) dot += shx(dot, o, lane);
            if (lane == 0 && j < 129) sc[j] = __builtin_fmaf(dot, kscale, -slope * (float)(j * dd));
        }
    }
    __syncthreads();
    float mx = -1e30f;
    for (int j = 0; j < 129; ++j) mx = fmaxf(mx, sc[j]);
    float l = 0.f;
    for (int j = 0; j < 129; ++j) l += __expf(sc[j] - mx);
    float o = 0.f;
    {
        if (part == 0) vv[0] = vn[d];
#pragma unroll
        for (int i = 0; i < 33; ++i) { const int j = part + 4 * i; if (j < 129) o = fmaf(__expf(sc[j] - mx), vv[i], o); }
    }
    po[part * 128 + d] = o;
    __syncthreads();
    if (tid < 128) { ap[task * 136 + 8 + tid] = (po[tid] + po[128 + tid]) + (po[256 + tid] + po[384 + tid]); if (tid == 0) { ap[task * 136] = mx; ap[task * 136 + 1] = l; } }
    __syncthreads();
}
__device__ __forceinline__ void smp_ret(MK_LAS float* ls, const ZsFold& zf, const float* s0, float* sout, const float* gng, const float* gnb, float* mixs, int task, int tid) {
    asm volatile("" : "+v"(tid));
    const int b = task >> 3, h = task & 7;
    MK_LAS float* qs = ls; MK_LAS float* ks = ls + 64; MK_LAS float* po = ls + 128; MK_LAS float* os = ls + 640;
    const int e = tid & 127, part = tid >> 7;
    float s0v[16];
#pragma unroll
    for (int i = 0; i < 16; ++i) s0v[i] = s0[(((size_t)b * 8 + h) * 64 + 16 * part + i) * 128 + e];
    if (tid < 64) qs[tid] = zf(b, 3072 + h * 64 + tid);
    else if (tid < 128) ks[tid - 64] = zf(b, 3584 + h * 64 + (tid - 64)) * 0.125f;
    __syncthreads();
    const float gam = 1.f - __builtin_amdgcn_exp2f(-5.f - (float)h);
    const float v = zf(b, 4096 + h * 128 + e);
    float o = 0.f;
#pragma unroll
    for (int i = 0; i < 16; ++i) {
        const int dk = 16 * part + i; const size_t idx = (((size_t)b * 8 + h) * 64 + dk) * 128 + e;
        const float sn = fmaf(gam, s0v[i], ks[dk] * v);
        sout[idx] = sn; o = fmaf(qs[dk], sn, o);
    }
    po[part * 128 + e] = o;
    __syncthreads();
    if (tid < 128) os[tid] = (po[tid] + po[128 + tid]) + (po[256 + tid] + po[384 + tid]);
    __syncthreads();
    if (tid < 128) {
        float s = 0.f;
        for (int i = 0; i < 128; ++i) s += os[i];
        const float mu = s * (1.f / 128.f); float q = 0.f;
        for (int i = 0; i < 128; ++i) { const float dd = os[i] - mu; q += dd * dd; }
        const float rstd = 1.0f / sqrtf(q * (1.f / 128.f) + GN_EPS);
        const int c = h * 128 + tid; const float gbv = zf(b, 5120 + c);
        mixs[b * D + 1024 + c] = ((os[tid] - mu) * rstd * gng[c] + gnb[c]) * gbv * sigmoid_f(gbv);
    }
    __syncthreads();
}
struct MidSkinny8 { const bf16_t* W; float* raw; const float* mixs; MK_LAS float* red; int bx, G, wv;
    __device__ __forceinline__ void operator()() const {
        unsigned z_ = 0u; asm volatile("" : "+s"(z_));
        const int lane = (int)__builtin_amdgcn_mbcnt_hi(~0u, __builtin_amdgcn_mbcnt_lo(~0u, z_)), wave = __builtin_amdgcn_readfirstlane(wv), tid = wave * 64 + lane;
        skinny<8>(W, D, raw, ABDirect{mixs, D}, red, tid, wave, lane, bx, G);
    } };
}

namespace mk {
struct Args { const float* in[21]; float* out; unsigned char* ws; int nl; int stop; int rep; int pad; };
static_assert(sizeof(Args) == 21 * 8 + 8 + 8 + 16, "Args has no padding");

__global__ void __launch_bounds__(NTHR, 2) mega(Args a) {
    extern __shared__ __attribute__((aligned(16))) unsigned char lds_raw[];
    MK_LAS unsigned char* lds = (MK_LAS unsigned char*)lds_raw;
    int wave = __builtin_amdgcn_readfirstlane((int)threadIdx.x >> 6);
    int lane = (int)__builtin_amdgcn_mbcnt_hi(~0u, __builtin_amdgcn_mbcnt_lo(~0u, 0u)), tid = wave * 64 + lane;
    int G = gridDim.x, bx = blockIdx.x;
#define OPAQUE_IDS() do { unsigned z_ = 0u; asm volatile("" : "+s"(z_)); lane = (int)__builtin_amdgcn_mbcnt_hi(~0u, __builtin_amdgcn_mbcnt_lo(~0u, z_)); tid = wave * 64 + lane; asm volatile("" : "+v"(tid), "+v"(lane), "+s"(wave), "+s"(G), "+s"(bx), "+s"(KP)); } while (0)
    for (int u = tid; u < (LDS_BYTES - RING_BYTES) / 4; u += NTHR) ((MK_LAS unsigned*)(lds + RING_BYTES))[u] = 0u;
    __syncthreads();
    typedef const __attribute__((address_space(4))) Args* KArgs;
    KArgs KP = (KArgs)__builtin_amdgcn_kernarg_segment_ptr();
#define ws (KP->ws)
#define out (KP->out)
#define x_prompt (KP->in[0])
#define x_sample (KP->in[1])
#define cache_k (KP->in[2])
#define cache_v (KP->in[3])
#define state_ret (KP->in[4])
#define p_prompt (KP->in[5])
#define p_sample (KP->in[6])
#define w_in (KP->in[7])
#define w_out (KP->in[8])
#define gn_g (KP->in[9])
#define gn_b (KP->in[10])
#define f1w1 (KP->in[11])
#define f1w3 (KP->in[12])
#define f1w2 (KP->in[13])
#define f2w1 (KP->in[14])
#define f2w3 (KP->in[15])
#define f2w2 (KP->in[16])
#define w_ple (KP->in[17])
#define w_gate (KP->in[18])
#define ln_g (KP->in[19])
#define ln_b (KP->in[20])
#define STATS ((float*)(ws + WS_STATS))
#define CV ((float*)(ws + WS_CV))
#define SMP ((float*)(ws + WS_SMP))
#define PART ((float*)(ws + WS_PART))
#define WB ((bf16_t*)(ws + WS_W))
#define YB ((bf16_t*)(ws + WS_YB))
#define Y8 ((unsigned char*)(ws + WS_Y))
#define H ((unsigned char*)(ws + WS_H))
#define Z ((bf16_t*)(ws + WS_Z))
#define MIX ((bf16_t*)(ws + WS_MIX))
#define OG ((bf16_t*)(ws + WS_OG))
#define LSE ((float*)(ws + WS_LSE))
#define U ((float*)(ws + WS_U))
#define PB ((bf16_t*)(ws + WS_PB))
#define PW ((bf16_t*)(ws + WS_PW))
#define YS (SMP + SM_YS)
#define SST (SMP + SM_ST)
#define RUP (SMP + SM_RUP)
#define RDA (SMP + SM_RD)
#define RIN (SMP + SM_RIN)
#define MIXS (SMP + SM_MIX)
#define AP (SMP + SM_AP)
#define PWS (SMP + SM_PWS)
#define RDB (SMP + SM_RDB)
#define HSS ((unsigned char*)(SMP + SM_HS))
#define YBDUM ((bf16_t*)(ws + WS_END + (size_t)M * D * 4))
#define STDUM ((float*)(ws + WS_END + (size_t)M * D * 6))
    XcdBarrier bar = xcd_barrier_post((unsigned*)(ws + WS_CTL) + 4096, (volatile LAS unsigned*)(lds + MISC_OFF) + 8);
    MK_LAS float* red = (MK_LAS float*)lds;
#if defined(MK_STAMP)
    int nstamp = 1; if (bx == 0 && tid == 0) ((unsigned long long*)(ws + WS_CTL + 524288))[0] = __builtin_amdgcn_s_memrealtime();
#endif
#define gw (bx * NWAVES + wave)
#define NGW (G * NWAVES)
#define gt (bx * NTHR + tid)
#define GT (G * NTHR)
#define LNG(l, i) (ln_g + ((size_t)(l) * 4 + (i)) * D)
#define LNB(l, i) (ln_b + ((size_t)(l) * 4 + (i)) * D)
#define CV1(l, off) (CV + ((size_t)(l) * 2 + 0) * NCV + (off))
#define CV2(l, off) (CV + ((size_t)(l) * 2 + 1) * NCV + (off))
#define WL(l, off) (WB + (size_t)(l) * LW + (off))
#if defined(MK_STAMP)
#define GRID_BAR() do { xcd_barrier(bar); if (bx == 0 && tid == 0) { ((unsigned long long*)(ws + WS_CTL + 524288))[nstamp] = __builtin_amdgcn_s_memrealtime(); } ++nstamp; } while (0)
#else
#if defined(MK_PROBE)
#define GRID_BAR() do { xcd_barrier(bar); if ((KP->rep >> 15) & 1) xcd_barrier(bar); } while (0)
#else
#define GRID_BAR() xcd_barrier(bar)
#endif
#endif
#define RUNP(id) (KP->stop == 0 || (id) < KP->stop)
#if defined(MK_PROBE)
#if defined(MK_PROBE_KIND)
#define REPS(kind) for (int rep_ = 0, nrep_ = ((kind) == MK_PROBE_KIND && ((KP->rep >> (kind)) & 1)) ? 2 : 1; rep_ < nrep_; ++rep_)
#else
#define REPS(kind) for (int rep_ = 0, nrep_ = ((KP->rep >> (kind)) & 1) ? 2 : 1; rep_ < nrep_; ++rep_)
#endif
#define REPBAR() do { OPAQUE_IDS(); if (rep_) GRID_BAR(); } while (0)
#define DUMSEL (nrep_ == 2 && rep_ == 0)
#else
#define REPS(kind)
#define REPBAR() do { } while (0)
#define DUMSEL false
#endif

    REPS(10) {
        REPBAR();
        MK_LAS float* scr = (MK_LAS float*)(lds + wave * 16384);
        constexpr int IPL = 44288, NIT = DEPTH * IPL;
#define TR_DECODE(it_, c_) do { \
            const int l = (it_) / IPL; int r = (it_) % IPL; \
            const float* W; int K = D, N; size_t woff; int kind = 0, lnl = -1, lni = 0, cvoff = 0, f8 = 0;     \
            if (r < 5632) { W = f1w1 + (size_t)l * D * FF; N = FF; woff = W_UP1; kind = 1; lnl = l - 1; lni = 3; cvoff = CV_UP1; f8 = 1; } \
            else if ((r -= 5632) < 5632) { W = f1w3 + (size_t)l * D * FF; N = FF; woff = W_UP1; kind = 2; lnl = l - 1; lni = 3; cvoff = CV_UP1; f8 = 1; } \
            else if ((r -= 5632) < 5632) { W = f1w2 + (size_t)l * FF * D; K = FF; N = D; woff = W_DN1; f8 = 1; } \
            else if ((r -= 5632) < 6144) { W = w_in + (size_t)l * D * INW; N = INW; woff = W_IN; lnl = l; lni = 0; cvoff = CV_IN; } \
            else if ((r -= 6144) < 2048) { W = w_out + (size_t)l * D * D; N = D; woff = W_OUT; } \
            else if ((r -= 2048) < 5632) { W = f2w1 + (size_t)l * D * FF; N = FF; woff = W_UP2; kind = 1; lnl = l; lni = 1; cvoff = CV_UP2; f8 = 1; } \
            else if ((r -= 5632) < 5632) { W = f2w3 + (size_t)l * D * FF; N = FF; woff = W_UP2; kind = 2; lnl = l; lni = 1; cvoff = CV_UP2; f8 = 1; } \
            else if ((r -= 5632) < 5632) { W = f2w2 + (size_t)l * FF * D; K = FF; N = D; woff = W_DN2; f8 = 1; } \
            else if ((r -= 5632) < 2048) { W = w_gate + (size_t)l * D * D; N = D; woff = W_GATE; lnl = l; lni = 2; cvoff = CV_GATE; } \
            else { r -= 2048; W = w_ple + (size_t)l * PLE * D; K = PLE; N = D; woff = W_PLE; } \
            const int nblk = N >> 5, kb = r / nblk, nb = r % nblk, n0 = nb * 32; \
            (c_).W = W; (c_).WT = WL(l, woff); (c_).K = K; (c_).N = N; (c_).n0 = n0; (c_).k0 = kb * 64; (c_).f8 = f8; \
            (c_).drow0 = (kind == 0) ? n0 : (256 * (n0 >> 7) + (n0 & 127) + (kind == 2 ? 128 : 0)); \
            (c_).gk = nullptr; (c_).bk = nullptr; if (lnl >= 0) { (c_).gk = LNG(lnl, lni); (c_).bk = LNB(lnl, lni); } \
            (c_).p1 = PART + (((size_t)l * 2 + 0) * 32 + kb) * NCV + cvoff; (c_).p2 = PART + (((size_t)l * 2 + 1) * 32 + kb) * NCV + cvoff; } while (0)
        {
            TrCtx cA, cB; float wA[32], gA[8], bA[8], wB[32], gB[8], bB[8];
            int it = gw; bool vA = it < NIT;
            if (vA) { TR_DECODE(it, cA); tr_load(cA, lane, wA, gA, bA); }
            while (vA) {
                const int itB = it + NGW; const bool vB = itB < NIT;
                if (vB) { TR_DECODE(itB, cB); tr_load(cB, lane, wB, gB, bB); }
                tr_proc(cA, scr, lane, wA, gA, bA);
                if (!vB) break;
                it = itB + NGW; vA = it < NIT;
                if (vA) { TR_DECODE(it, cA); tr_load(cA, lane, wA, gA, bA); }
                tr_proc(cB, scr, lane, wB, gB, bB);
            }
        }
#undef TR_DECODE
        for (int i0 = gt; i0 < M * D / 4; i0 += 8 * GT) {
            f32x4 v[8];
#pragma unroll
            for (int j = 0; j < 8; ++j) { const int i = i0 + j * GT; v[j] = (i < M * D / 4) ? __builtin_nontemporal_load((const f32x4*)x_prompt + i) : (f32x4){0.f, 0.f, 0.f, 0.f}; }
#pragma unroll
            for (int j = 0; j < 8; ++j) { const int i = i0 + j * GT; if (i < M * D / 4) ((unsigned*)Y8)[i] = pk8(v[j][0], v[j][1], v[j][2], v[j][3]); }
        }
        for (int i0 = gt; i0 < DEPTH * M * PLE / 4; i0 += 8 * GT) {
            f32x4 v[8];
#pragma unroll
            for (int j = 0; j < 8; ++j) { const int i = i0 + j * GT; v[j] = (i < DEPTH * M * PLE / 4) ? __builtin_nontemporal_load((const f32x4*)p_prompt + i) : (f32x4){0.f, 0.f, 0.f, 0.f}; }
#pragma unroll
            for (int j = 0; j < 8; ++j) { const int i = i0 + j * GT; if (i < DEPTH * M * PLE / 4) { u32x2 w; w.x = pk(v[j][0], v[j][1]); w.y = pk(v[j][2], v[j][3]); ((u32x2*)PB)[i] = w; } }
        }
    }
    GRID_BAR();
    REPS(11) {
        REPBAR();
        for (int i = gt; i < DEPTH * NCV; i += GT) {
            const int l = i / NCV, col = i % NCV;
            if (l == 0 && col < CV_IN) continue;
            float s1 = 0.f, s2 = 0.f;
            for (int kb = 0; kb < 32; ++kb) { s1 += PART[(((size_t)l * 2 + 0) * 32 + kb) * NCV + col]; s2 += PART[(((size_t)l * 2 + 1) * 32 + kb) * NCV + col]; }
            CV[((size_t)l * 2 + 0) * NCV + col] = s1; CV[((size_t)l * 2 + 1) * NCV + col] = s2;
        }
        {
            OPAQUE_IDS();
            pg8::Gemm g{PB, WL(0, W_PLE), DEPTH * M, D, PLE}; PleOrder S; S.base.init(M, D, G, bx);
            EpiPle E{PW};
            pg8::gemm_phase<EpiPle, PleOrder, false, true>(lds, g, S, E, wave);
        }
        {
            OPAQUE_IDS();
            const int l = bx >> 6, gf = bx & 63;
            if (G == 256 && l < DEPTH) skinny<1, ABDirect, 2>(WL(l, W_PLE), D, PWS + (size_t)l * 8 * D, ABDirect{p_sample + (size_t)l * 8 * PLE, PLE}, red, tid, wave, lane, gf, 64);
            else if (G != 256) for (int l2 = 0; l2 < DEPTH; ++l2) skinny<1>(WL(l2, W_PLE), D, PWS + (size_t)l2 * 8 * D, ABDirect{p_sample + (size_t)l2 * 8 * PLE, PLE}, red, tid, wave, lane, bx, G);
        }
    }
    GRID_BAR();

#if defined(MK_DUP)
#define MK_DUPLOOP(k) for (int rr_ = 0, nr_ = (MK_DUP == (k)) ? 1 + KP->pad : 1; rr_ < nr_; ++rr_)
#else
#define MK_DUPLOOP(k)
#endif
    int cur = 0;
    const float* ysp = x_sample; const float* sstp = SST; int sid = 1; const float* sg = ln_g; const float* sb = ln_b; int ss = 0;
    for (int l = 0; l < KP->nl; ++l) {
        OPAQUE_IDS();
        float* k_out = out + O_KP + (size_t)l * M * 1024; float* v_out = out + O_VP + (size_t)l * M * 1024;
        for (int sub = 0; sub < 2; ++sub) {
            OPAQUE_IDS();
            if (sub == 1) {
                if (RUNP(l * 16 + 3)) REPS(3) {
                    REPBAR();
                    pg8::Gemm g{YB + (size_t)cur * M * D, WL(l, W_IN), M, INW, D}; pg8::StaticOrder S; S.init(M, INW, G, bx);
                    EpiIn E{Z, k_out, v_out, STATS + (size_t)cur * M * 16, CV1(l, CV_IN), CV2(l, CV_IN)};
                    const PreTab<pg8::StaticOrder> PT{lds, S, STATS + (size_t)cur * M * 16, tid, 1};
                    pg8::gemm_phase<EpiIn, pg8::StaticOrder, true, true, false, false, PreTab<pg8::StaticOrder>>(lds, g, S, E, wave, PT);
                    ABResid ab{ysp, sstp, sid, sg, sb, RDB, 0.5f, 0, nullptr, nullptr, nullptr};
                    if (bx == 0) smp_update(ab, YS + ss * 8 * D, SST + ss * 16, wave, lane);
                    MK_DUPLOOP(6) skinny<8, ABResid, 2>(WL(l, W_IN), INW, RIN, ab, red, tid, wave, lane, bx, G);
                }
                ysp = YS + ss * 8 * D; sstp = SST + ss * 16; sid = 0; sg = LNG(l, 0); sb = LNB(l, 0); ss ^= 1;
                GRID_BAR();
                if (RUNP(l * 16 + 4)) REPS(4) {
                    REPBAR();
                    const int xa_ = (G == 256) ? ((4 * (bx & 7) + (bx >> 6)) * 48 + ((bx >> 3) & 7)) : bx, xs_ = (G == 256) ? 8 : G, xn_ = (G == 256) ? ((4 * (bx & 7) + (bx >> 6)) * 48 + 48) : 1536;
                    const int ra_ = (G == 256) ? ((4 * (bx & 7) + (bx >> 6)) * 16 + ((bx >> 3) & 7)) : bx, rn_ = (G == 256) ? ((4 * (bx & 7) + (bx >> 6)) * 16 + 16) : 512;
                    MK_DUPLOOP(1) { OPAQUE_IDS(); attn_phase(lds, Z, OG, LSE, xa_, xs_, xn_, wave, lane); }
                    MK_DUPLOOP(2) { OPAQUE_IDS(); if (G == 256) retu_pair(lds, Z, U, ra_, ra_ + 8, tid, wave, lane); else retu_units(lds, Z, U, ra_, xs_, rn_, tid, wave, lane); }
                    const ZsFold zf{RIN, sstp, CV1(l, CV_IN), CV2(l, CV_IN)};
                    MK_DUPLOOP(3) for (int t = bx; t < 256; t += G) {
                        if (t < 192) smp_attn((MK_LAS float*)lds, zf, cache_k + (size_t)l * SB * 2048 * 1024, cache_v + (size_t)l * SB * 2048 * 1024, AP, out + O_KS + (size_t)l * SB * 1024, out + O_VS + (size_t)l * SB * 1024, t, tid, wave, lane);
                        else smp_ret((MK_LAS float*)lds, zf, state_ret + (size_t)l * SB * 8 * 8192, out + O_RS + (size_t)l * SB * 8 * 8192, gn_g + (size_t)l * 1024, gn_b + (size_t)l * 1024, MIXS, t - 192, tid);
                    }
                }
                GRID_BAR();
                if (RUNP(l * 16 + 5)) REPS(5) {
                    REPBAR();
                    {
                        const int ub_ = (G == 256) ? ((4 * (bx & 7) + (bx >> 6)) * 8 + ((bx >> 3) & 7)) : bx;
                        if (G == 256 && NGW * 4 == M) {
                            int ui_ = 0;
                            for (int u = ub_; u < 512; u += 256) {
                                CombRegs2 cr; const int t0_ = gw + 2 * ui_ * NGW;
                                const auto jpre = [&]() { combine_load2(OG, LSE, t0_, NGW, lane, cr); };
                                const auto jpost = [&]() { combine_finish2(MIX, t0_, NGW, lane, cr); };
                                reto_unit(lds, Z, U, MIX, gn_g + (size_t)l * 1024, gn_b + (size_t)l * 1024, out + O_RP + (size_t)l * NB * 8 * 8192, u, tid, wave, lane, jpre, jpost);
                                ++ui_;
                            }
                        } else {
                            for (int u = ub_; u < 512; u += G) reto_unit(lds, Z, U, MIX, gn_g + (size_t)l * 1024, gn_b + (size_t)l * 1024, out + O_RP + (size_t)l * NB * 8 * 8192, u, tid, wave, lane);
                            for (int t = gw; t < M; t += NGW) combine_rows<1>(OG, LSE, MIX, t, 0, lane);
                        }
                    }
                    for (int t = bx; t < 64; t += G) {
                        if (tid < 128) {
                            const float* p0 = AP + (t * 3 + 0) * 136; const float* p1 = AP + (t * 3 + 1) * 136; const float* p2 = AP + (t * 3 + 2) * 136;
                            const float mx = fmaxf(p0[0], fmaxf(p1[0], p2[0]));
                            const float e0 = __expf(p0[0] - mx), e1 = __expf(p1[0] - mx), e2 = __expf(p2[0] - mx);
                            const float L = p0[1] * e0 + p1[1] * e1 + p2[1] * e2;
                            MIXS[(t >> 3) * D + (t & 7) * 128 + tid] = (p0[8 + tid] * e0 + p1[8 + tid] * e1 + p2[8 + tid] * e2) / L;
                        }
                    }
                }
                GRID_BAR();
                if (RUNP(l * 16 + 6)) REPS(6) {
                    REPBAR(); const bool dum = DUMSEL;
                    pg8::Gemm g{MIX, WL(l, W_OUT), M, D, D}; pg8::StaticOrder S; S.init(M, D, G, bx);
                    EpiRes<0> E{nullptr, YB + (size_t)cur * M * D, dum ? YBDUM : YB + (size_t)(cur ^ 1) * M * D, STATS + (size_t)cur * M * 16, dum ? STDUM : STATS + (size_t)(cur ^ 1) * M * 16, LNG(l, 0), LNB(l, 0), 0, 1.0f, nullptr, nullptr, nullptr, dum ? nullptr : Y8};
                    const PreTab<pg8::StaticOrder> PT{lds, S, STATS + (size_t)cur * M * 16, tid, 1};
                    const MidSkinny8 mid{WL(l, W_OUT), RDA, MIXS, red, bx, G, wave};
                    pg8::gemm_phase<EpiRes<0>, pg8::StaticOrder, false, true, false, false, PreTab<pg8::StaticOrder>, false, MidSkinny8>(lds, g, S, E, wave, PT, mid);
                }
                cur ^= 1;
                GRID_BAR();
            }
            const size_t wup = sub ? W_UP2 : W_UP1, wdn = sub ? W_DN2 : W_DN1; const int cvu = sub ? CV_UP2 : CV_UP1;
            const int idn = (l == 0 && sub == 0) ? 1 : 0;
            if (RUNP(l * 16 + (sub ? 7 : 1))) REPS(1) {
                REPBAR();
                pg8::Gemm g{(const bf16_t*)Y8, WL(l, wup), M, NUP, D / 2}; pg8::StaticOrder S; S.init(M, NUP, G, bx);
                const bool tail = (G == 256);
                if (tail) S.lim = 1280;
#if defined(MK_PROBE)
                const int nost_ = DUMSEL ? (int)((KP->rep >> 16) & 3) : 0;
                EpiSwiGLU<false> E{H, STATS + (size_t)cur * M * 16, CV1(l, cvu), CV2(l, cvu), idn, nost_};
#else
                EpiSwiGLU<false> E{H, STATS + (size_t)cur * M * 16, CV1(l, cvu), CV2(l, cvu), idn};
#endif
                TailOrder ST{S, 1280, G / 2, bx, S.nwg};
                const PreTab<pg8::StaticOrder> PT{lds, S, STATS + (size_t)cur * M * 16, tid, !idn};
                {
                    const ChainOrder SC{S, 1280, G / 2};
                    pg8::gemm_phase<EpiSwiGLU<false>, ChainOrder, true, true, false, true, PreTab<pg8::StaticOrder>>(lds, g, SC, E, wave, PT);
                }
                OPAQUE_IDS();
                if (tail) {
#if defined(MK_PROBE)
                    EpiSwiGLU<true> ET{H, STATS + (size_t)cur * M * 16, CV1(l, cvu), CV2(l, cvu), idn, nost_};
#else
                    EpiSwiGLU<true> ET{H, STATS + (size_t)cur * M * 16, CV1(l, cvu), CV2(l, cvu), idn};
#endif
                    const PreTabHalf PTH{lds, ST, STATS + (size_t)cur * M * 16, tid, !idn}; pg8::gemm_phase<EpiSwiGLU<true>, TailOrder, false, true, true, true, PreTabHalf, true>(lds, g, ST, ET, wave, PTH); }
                OPAQUE_IDS();
                const int sgf = bx, sgs = G;
                if (idn) skinny8_swi((const unsigned char*)WL(l, wup), ABDirect{x_sample, D}, 1, nullptr, nullptr, HSS, lds, tid, wave, lane, bx);
                else {
                    const int gm = (sub == 0) ? 1 : 0;
                    ABResid ab{ysp, sstp, 0, sg, sb, RDA, 1.0f, gm, gm ? PWS + (size_t)(l - 1) * 8 * D : nullptr, gm ? CV1(l - 1, CV_GATE) : nullptr, gm ? CV2(l - 1, CV_GATE) : nullptr};
                    if (sgf == 0) smp_update(ab, YS + ss * 8 * D, SST + ss * 16, wave, lane);
                    OPAQUE_IDS();
                    skinny8_swi((const unsigned char*)WL(l, wup), ab, 0, CV1(l, cvu), CV2(l, cvu), HSS, lds, tid, wave, lane, bx);
                }
            }
            if (!idn) { ysp = YS + ss * 8 * D; sstp = SST + ss * 16; sid = 0; if (sub == 0) { sg = LNG(l - 1, 3); sb = LNB(l - 1, 3); } else { sg = LNG(l, 1); sb = LNB(l, 1); } ss ^= 1; }
            GRID_BAR();
            if (RUNP(l * 16 + (sub ? 8 : 2))) REPS(2) {
                REPBAR(); const bool dum = DUMSEL;
                pg8::Gemm g{(const bf16_t*)H, WL(l, wdn), M, D, FF / 2}; pg8::StaticOrder S; S.init(M, D, G, bx);
                const float* pg = idn ? ln_g : (sub ? LNG(l, 1) : LNG(l - 1, 3)); const float* pb = idn ? ln_b : (sub ? LNB(l, 1) : LNB(l - 1, 3));
                EpiRes<0> E{x_prompt, YB + (size_t)cur * M * D, dum ? YBDUM : YB + (size_t)(cur ^ 1) * M * D, STATS + (size_t)cur * M * 16, dum ? STDUM : STATS + (size_t)(cur ^ 1) * M * 16, pg, pb, idn, 0.5f / (W8S * H8S), nullptr, nullptr, nullptr, nullptr};
                const PreTab<pg8::StaticOrder> PT{lds, S, STATS + (size_t)cur * M * 16, tid, !idn};
                pg8::gemm_phase<EpiRes<0>, pg8::StaticOrder, false, true, false, true, PreTab<pg8::StaticOrder>>(lds, g, S, E, wave, PT);
                OPAQUE_IDS();
                skinny8<6, ABRaw8, 1, 3, true>((const unsigned char*)WL(l, wdn), D, FF, RDB, ABRaw8{HSS}, 1.f, 1.f / (W8S * H8S), lds, tid, wave, lane, bx, G);
            }
            cur ^= 1;
            GRID_BAR();
        }
        OPAQUE_IDS();
        if (RUNP(l * 16 + 9)) REPS(9) {
            REPBAR(); const bool dum = DUMSEL;
            pg8::Gemm g{YB + (size_t)cur * M * D, WL(l, W_GATE), M, D, D}; pg8::StaticOrder S; S.init(M, D, G, bx);
            EpiRes<1> E{nullptr, YB + (size_t)cur * M * D, dum ? YBDUM : YB + (size_t)(cur ^ 1) * M * D, STATS + (size_t)cur * M * 16, dum ? STDUM : STATS + (size_t)(cur ^ 1) * M * 16, LNG(l, 2), LNB(l, 2), 0, 1.0f, PW + (size_t)l * M * D, CV1(l, CV_GATE), CV2(l, CV_GATE), dum ? nullptr : Y8};
            const PreTab<pg8::StaticOrder> PT{lds, S, STATS + (size_t)cur * M * 16, tid, 1};
            pg8::gemm_phase<EpiRes<1>, pg8::StaticOrder, false, true, false, false, PreTab<pg8::StaticOrder>>(lds, g, S, E, wave, PT);
            ABResid ab{ysp, sstp, 0, sg, sb, RDB, 0.5f, 0, nullptr, nullptr, nullptr};
            if (bx == 0) smp_update(ab, YS + ss * 8 * D, SST + ss * 16, wave, lane);
            MK_DUPLOOP(6) skinny<8>(WL(l, W_GATE), D, RDA, ab, red, tid, wave, lane, bx, G);
        }
        ysp = YS + ss * 8 * D; sstp = SST + ss * 16; sid = 0; sg = LNG(l, 2); sb = LNB(l, 2); ss ^= 1;
        cur ^= 1;
        GRID_BAR();
    }
    {
        OPAQUE_IDS();
        const int l = KP->nl - 1;
        const float* st = STATS + (size_t)cur * M * 16; const float* g = LNG(l, 3); const float* b = LNB(l, 3);
        for (int t0 = gw; t0 < M; t0 += 4 * NGW) {
            u32x2 pq[4][8]; float mu[4], rs[4];
#pragma unroll
            for (int r = 0; r < 4; ++r) {
                const int t = t0 + r * NGW;
                if (t < M) { row_stats(st, t, mu[r], rs[r]);
#pragma unroll
                    for (int j = 0; j < 8; ++j) pq[r][j] = *(const u32x2*)(YB + (size_t)cur * M * D + (size_t)t * D + 4 * lane + 256 * j); }
            }
#pragma unroll
            for (int j = 0; j < 8; ++j) {
                const int c = 4 * lane + 256 * j; const f32x4 gv = *(const f32x4*)(g + c), bv = *(const f32x4*)(b + c);
#pragma unroll
                for (int r = 0; r < 4; ++r) {
                    const int t = t0 + r * NGW;
                    if (t < M) { const f32x4 v = (f32x4){bflo(pq[r][j].x), bfhi(pq[r][j].x), bflo(pq[r][j].y), bfhi(pq[r][j].y)}; __builtin_nontemporal_store((v - mu[r]) * rs[r] * gv + bv, (f32x4*)(out + O_YP + (size_t)t * D + c)); }
                }
            }
        }
        if (bx == 0) {
            ABResid ab{ysp, sstp, 0, sg, sb, RDA, 1.0f, 1, PWS + (size_t)l * 8 * D, CV1(l, CV_GATE), CV2(l, CV_GATE)};
            float v[32]; float s = 0.f, q = 0.f;
#pragma unroll
            for (int j = 0; j < 4; ++j) { float t8[8]; ab.val8(wave, lane * 8 + 512 * j, t8);
#pragma unroll
                for (int e = 0; e < 8; ++e) { v[8 * j + e] = t8[e]; s += t8[e]; q += t8[e] * t8[e]; } }
#pragma unroll
            for (int o = 32; o > 0; o >>= 1) { s += shx(s, o, lane); q += shx(q, o, lane); }
            const float mu = s * (1.f / 2048.f), rs = 1.0f / sqrtf(fmaxf(q * (1.f / 2048.f) - mu * mu, 0.f) + LN_EPS);
#pragma unroll
            for (int j = 0; j < 4; ++j)
#pragma unroll
                for (int e = 0; e < 8; ++e) { const int k = lane * 8 + 512 * j + e; out[O_YS + (size_t)wave * D + k] = (v[8 * j + e] - mu) * rs * g[k] + b[k]; }
        }
    }
#if defined(MK_STAMP)
    asm volatile("s_waitcnt vmcnt(0)" ::: "memory");
    if (bx == 0 && tid == 0) ((unsigned long long*)(ws + WS_CTL + 524288))[nstamp] = __builtin_amdgcn_s_memrealtime();
#endif
}
#undef ws
#undef out
#undef x_prompt
#undef x_sample
#undef cache_k
#undef cache_v
#undef state_ret
#undef p_prompt
#undef p_sample
#undef w_in
#undef w_out
#undef gn_g
#undef gn_b
#undef f1w1
#undef f1w3
#undef f1w2
#undef f2w1
#undef f2w3
#undef f2w2
#undef w_ple
#undef w_gate
#undef ln_g
#undef ln_b
#undef STATS
#undef CV
#undef SMP
#undef PART
#undef WB
#undef YB
#undef Y8
#undef H
#undef Z
#undef MIX
#undef OG
#undef LSE
#undef U
#undef PB
#undef PW
#undef YS
#undef SST
#undef RUP
#undef RDA
#undef RIN
#undef MIXS
#undef AP
#undef PWS
#undef RDB
#undef YBDUM
#undef STDUM
#undef gw
#undef NGW
#undef gt
#undef GT
#undef OPAQUE_IDS
#undef LNG
#undef LNB
#undef CV1
#undef CV2
#undef WL
#undef GRID_BAR
#undef RUNP
#undef REPS
#undef REPBAR
#undef DUMSEL
}

namespace mk { constexpr size_t WS_NEED = WS_END + (size_t)120 * 1024 * 1024; }
#define NL_RUN 4
#define STOP_RUN 0
#define REP_RUN 0


extern "C" void kernel_launch(void* const* d_in, const int* in_sizes, int n_in, void* d_out, int out_size, void* d_ws, size_t ws_size, hipStream_t stream) {
    using namespace mk;
    static int ok = 0;
    if (ok == 0) {
        ok = 1;
        if (n_in != 21 || (size_t)out_size != O_END || ws_size < WS_NEED) { fprintf(stderr, "kernel_launch: unexpected shapes (n_in %d out %d ws %zu need %zu)\n", n_in, out_size, ws_size, (size_t)WS_NEED); ok = -1; }
        else if (hipFuncSetAttribute((const void*)mega, hipFuncAttributeMaxDynamicSharedMemorySize, LDS_BYTES) != hipSuccess) { fprintf(stderr, "kernel_launch: hipFuncSetAttribute failed\n"); ok = -1; }
        else {
            int dev = 0, ncu = 0, per = 0;
            if (hipGetDevice(&dev) == hipSuccess && hipDeviceGetAttribute(&ncu, hipDeviceAttributeMultiprocessorCount, dev) == hipSuccess &&
                hipOccupancyMaxActiveBlocksPerMultiprocessor(&per, (const void*)mega, NTHR, LDS_BYTES) == hipSuccess && (long)per * ncu < 256)
                fprintf(stderr, "kernel_launch: 256 workgroups are not co-resident here (%d per CU x %d CUs)\n", per, ncu);
        }
    }
    if (ok < 0) return;
    unsigned char* ws = (unsigned char*)d_ws;

    (void)hipMemsetAsync(ws + WS_CTL, 0, CTL_BYTES, stream);
    Args a{};
    for (int i = 0; i < 21; ++i) a.in[i] = (const float*)d_in[i];
    a.out = (float*)d_out; a.ws = ws; a.nl = NL_RUN; a.stop = STOP_RUN; a.rep = REP_RUN;
#if defined(MK_DUP)
    a.pad = 1;
#endif
    hipLaunchKernelGGL(mega, dim3(256), dim3(NTHR), LDS_BYTES, stream, a);

}
```

```cpp
#include <hip/hip_runtime.h>
#include <cstdio>
#include <cstdint>

namespace pg8 {
#define PG8_LAS __attribute__((address_space(3)))
typedef unsigned short bf16_t;
typedef short bf16x8 __attribute__((ext_vector_type(8)));
typedef float f32x4 __attribute__((ext_vector_type(4)));
typedef unsigned u32x4 __attribute__((ext_vector_type(4)));
constexpr int BM = 256, BK = 64, HALF = 128, HTB = HALF * BK * 2  , STAGE_BYTES = 8 * HTB, NXCD = 8, WGM = 8;

__host__ __device__ __forceinline__ int lds_byte(int r, int c) { const int st = (r >> 4) * 2 + (c >> 5), rr = r & 15, cc = c & 31, ob = rr * 64 + cc * 2; return st * 1024 + (ob ^ (((ob >> 9) & 1) << 5)); }
__host__ __device__ __forceinline__ void stage_rc(int b, int& R, int& C) { const int st = b / 1024, sb = b % 1024, swz = sb ^ (((sb >> 9) & 1) << 5); R = (st >> 1) * 16 + swz / 64; C = (st & 1) * 32 + (swz % 64) / 2; }
__host__ __device__ __forceinline__ int perm32(int rho) { const int n = rho >> 4, i = rho & 15; return 8 * (i >> 2) + 4 * n + (i & 3); }

struct Unit { int pm, pn, idx, half; };
struct Gemm { const bf16_t* A; const bf16_t* Bt; int M, N, K; };

struct StaticOrder {
    int nM, nN, nwg, G, c, lim;
    __host__ __device__ void init(int M, int N, int G_, int c_) { nM = M / BM; nN = N / BM; nwg = nM * nN; G = G_; c = c_; lim = nwg; }
    __host__ __device__ bool next(int i, Unit& u) const {
        const long L = (long)i * G + c; if (L >= lim) return false;
        int wgid = (int)L; { const int q = nwg / NXCD, r = nwg % NXCD, xcd = wgid % NXCD, off = wgid / NXCD; wgid = (xcd < r ? xcd * (q + 1) : r * (q + 1) + (xcd - r) * q) + off; }
        const int nig = WGM * nN, gid = wgid / nig, fm = gid * WGM, gsz = (nM - fm) < WGM ? (nM - fm) : WGM;
        u.pm = fm + ((wgid % nig) % gsz); u.pn = (wgid % nig) / gsz; u.idx = i; u.half = 0; return true;
    }
    __device__ __forceinline__ void a_ready(const Unit&) const {}
    __device__ __forceinline__ void done(const Unit&) const {}
};

__device__ __forceinline__ unsigned cvt_pk_bf16(float lo, float hi) { unsigned r; asm volatile("v_cvt_pk_bf16_f32 %0, %1, %2" : "=v"(r) : "v"(lo), "v"(hi)); return r; }
typedef float f32x2 __attribute__((ext_vector_type(2)));
struct NoPre { __device__ __forceinline__ void operator()() const {} };
template <class S_> struct has_chain { template <class T> static auto f(int) -> decltype(T::HAS_CHAIN, char()); template <class T> static long f(...); static constexpr bool value = sizeof(f<S_>(0)) == 1; };
template <class Epi, class Sched, bool ALIGN_EPI = false, bool SP2 = false, bool HALF_M = false, bool FP8 = false, class Pre = NoPre, bool PRELOADED = false>
__device__ __forceinline__ void gemm_phase(PG8_LAS unsigned char* lds, const Gemm g, const Sched& S, const Epi& E, int wave_in, const Pre& pre = Pre()) {
    unsigned z_op = 0u; asm volatile("" : "+s"(z_op));
    int tid_op = (int)__builtin_amdgcn_mbcnt_hi(~0u, __builtin_amdgcn_mbcnt_lo(~0u, z_op)) + 64 * wave_in; asm volatile("" : "+v"(tid_op));
    const int tid = tid_op, wid = __builtin_amdgcn_readfirstlane(tid >> 6), lane = tid & 63, wr = wid >> 2, wc = wid & 3, fr = lane & 15, fq = lane >> 4;
    const int K = g.K, nt = K / BK;
    unsigned voffA[2], voffB[2];
#pragma unroll
    for (int i = 0; i < 2; ++i) { int R, C; stage_rc(tid * 16 + i * 8192, R, C); const int Rb = Epi::PERM ? ((R & ~31) + perm32(R & 31)) : R;
        voffA[i] = (unsigned)(R * K + C) * 2u; voffB[i] = (unsigned)(Rb * K + C) * 2u; }
    const int p1step = 64 * K * 2;
    const size_t kstep = (size_t)(BK * 2);
    const size_t hstep = (size_t)HALF * K * 2;
    const size_t tstep = 2 * hstep;
    const size_t hstepA = HALF_M ? (size_t)0 : hstep;
    static_assert(!HALF_M || SP2, "HALF_M is written for the SP2 loop");
    const unsigned ldsw = (unsigned)wid * 1024u;
    const int aoff = lds_byte(wr * 64 + fr, fq * 8), boff = lds_byte(wc * 32 + fr, fq * 8);
#define PG8_SA(b, h) (((b) * 2 + (h)) * HTB)
#define PG8_SB(b, h) ((4 + (b) * 2 + (h)) * HTB)
    const char* base_voffA = (const char*)g.A; const char* base_voffB = (const char*)g.Bt;
    const __amdgpu_buffer_rsrc_t rsrc_voffA = __builtin_amdgcn_make_buffer_rsrc((void*)g.A, (short)0, 0x7fffffff, 0x00020000), rsrc_voffB = __builtin_amdgcn_make_buffer_rsrc((void*)g.Bt, (short)0, 0x7fffffff, 0x00020000);
#define PG8_STAGE(bufoff, gbase, voff) do { const int so_ = (int)((gbase) - base_##voff); _Pragma("unroll") for (int _i = 0; _i < 2; ++_i) \
        __builtin_amdgcn_raw_ptr_buffer_load_lds(rsrc_##voff, (PG8_LAS void*)(lds + (bufoff) + ldsw + _i * 8192), 16, (int)(voff)[0], so_ + _i * p1step, 0, 0); } while (0)
#define PG8_LDA(dst, b, h) do { _Pragma("unroll") for (int m = 0; m < 4; ++m) _Pragma("unroll") for (int k = 0; k < 2; ++k) dst[m][k] = *(const PG8_LAS bf16x8*)(lds + PG8_SA(b, h) + aoff + m * 2048 + k * 1024); } while (0)
#define PG8_LDB(dst, b, h) do { _Pragma("unroll") for (int n = 0; n < 2; ++n) _Pragma("unroll") for (int k = 0; k < 2; ++k) dst[n][k] = *(const PG8_LAS bf16x8*)(lds + PG8_SB(b, h) + boff + n * 2048 + k * 1024); } while (0)
#define PG8_MMA(ai, bj, At, Bt) do { __builtin_amdgcn_s_setprio(1); _Pragma("unroll") for (int m = 0; m < 4; ++m) _Pragma("unroll") for (int n = 0; n < 2; ++n) { \
        if constexpr (FP8) {   \
            typedef int pg8_v8i __attribute__((ext_vector_type(8))); typedef int pg8_v4i __attribute__((ext_vector_type(4))); \
            const pg8_v4i b0_ = __builtin_bit_cast(pg8_v4i, Bt[n][0]), b1_ = __builtin_bit_cast(pg8_v4i, Bt[n][1]), a0_ = __builtin_bit_cast(pg8_v4i, At[m][0]), a1_ = __builtin_bit_cast(pg8_v4i, At[m][1]); \
            const pg8_v8i bb_ = (pg8_v8i){b0_[0], b0_[1], b0_[2], b0_[3], b1_[0], b1_[1], b1_[2], b1_[3]}, aa_ = (pg8_v8i){a0_[0], a0_[1], a0_[2], a0_[3], a1_[0], a1_[1], a1_[2], a1_[3]}; \
            acc[ai][bj][m][n] = __builtin_amdgcn_mfma_scale_f32_16x16x128_f8f6f4(bb_, aa_, acc[ai][bj][m][n], 0, 0, 0, 0x7F7F7F7F, 0, 0x7F7F7F7F); \
        } else { _Pragma("unroll") for (int k = 0; k < 2; ++k) \
        acc[ai][bj][m][n] = __builtin_amdgcn_mfma_f32_16x16x32_bf16(Bt[n][k], At[m][k], acc[ai][bj][m][n], 0, 0, 0); } } __builtin_amdgcn_s_setprio(0); } while (0)
#define PG8_WAIT_V(n) asm volatile("s_waitcnt vmcnt(" #n ")" ::: "memory")
#define PG8_WAIT_L(n) asm volatile("s_waitcnt lgkmcnt(" #n ")" ::: "memory")
#define PG8_BAR __builtin_amdgcn_s_barrier()
#define PG8_SCHED __builtin_amdgcn_sched_barrier(0)
    Unit cur, nxt; int ui = 0;
    if (!S.next(0, cur)) return;
    f32x4 acc[2][2][4][2];
#pragma unroll
    for (int a = 0; a < 2; ++a)
#pragma unroll
        for (int b = 0; b < 2; ++b)
#pragma unroll
            for (int m = 0; m < 4; ++m)
#pragma unroll
                for (int n = 0; n < 2; ++n) acc[a][b][m][n] = (f32x4){0.f, 0.f, 0.f, 0.f};
    bf16x8 At[4][2], B0[2][2], B1[2][2];
    const char* cA = (const char*)g.A + (size_t)cur.pm * tstep + (HALF_M ? (size_t)cur.half * hstep : (size_t)0); const char* cB = (const char*)g.Bt + (size_t)cur.pn * tstep;
    S.a_ready(cur);
    if constexpr (SP2 && PRELOADED) {
        pre();
        if (wr == 1) PG8_BAR;
        PG8_BAR;
        PG8_BAR;
    } else if constexpr (SP2) {
        PG8_STAGE(PG8_SB(0, 0), cB, voffB); PG8_STAGE(PG8_SB(0, 1), cB + hstep, voffB); PG8_STAGE(PG8_SA(0, 0), cA, voffA); if constexpr (!HALF_M) PG8_STAGE(PG8_SA(0, 1), cA + hstepA, voffA);
        pre();
        if (wr == 1) PG8_BAR;
        if constexpr (HALF_M) PG8_WAIT_V(0); else PG8_WAIT_V(2); PG8_BAR;
        PG8_STAGE(PG8_SB(1, 0), cB + kstep, voffB); PG8_STAGE(PG8_SA(1, 0), cA + kstep, voffA); PG8_STAGE(PG8_SB(1, 1), cB + hstep + kstep, voffB);
        PG8_WAIT_V(6); PG8_BAR;
    } else {
        PG8_STAGE(PG8_SB(0, 0), cB, voffB); PG8_STAGE(PG8_SA(0, 0), cA, voffA); PG8_STAGE(PG8_SB(0, 1), cB + hstep, voffB); PG8_STAGE(PG8_SA(0, 1), cA + hstepA, voffA);
        pre();
        if (wr == 1) PG8_BAR;
        PG8_WAIT_V(4); PG8_BAR;
        PG8_STAGE(PG8_SB(1, 0), cB + kstep, voffB); PG8_STAGE(PG8_SA(1, 0), cA + kstep, voffA); PG8_STAGE(PG8_SB(1, 1), cB + hstep + kstep, voffB);
        PG8_WAIT_V(6); PG8_BAR;
    }
    for (;;) {
        const bool has_next = S.next(ui + 1, nxt);
        bool pf = has_next;
        if constexpr (has_chain<Sched>::value) { if (!has_next) pf = S.chain(nxt); }
        const char* nA = pf ? (const char*)g.A + (size_t)nxt.pm * tstep + ((HALF_M || has_chain<Sched>::value) ? (size_t)nxt.half * hstep : (size_t)0) : cA; const char* nB = pf ? (const char*)g.Bt + (size_t)nxt.pn * tstep : cB;
        for (int t = 0; t < nt; t += 2) {
            const bool last = (t == nt - 2);
            const char* a1 = cA + (size_t)(t + 1) * kstep;
            const char* a2 = last ? nA : cA + (size_t)(t + 2) * kstep; const char* b2 = last ? nB : cB + (size_t)(t + 2) * kstep;
            const char* a3 = a2 + kstep; const char* b3 = b2 + kstep;
            if (last && has_next) S.a_ready(nxt);
            if constexpr (SP2) {
            PG8_LDB(B0, 0, 0); PG8_LDB(B1, 0, 1); PG8_SCHED; PG8_LDA(At, 0, 0); if constexpr (!HALF_M) PG8_STAGE(PG8_SA(1, 1), a1 + hstepA, voffA);
            PG8_WAIT_V(8); PG8_WAIT_L(0); PG8_BAR; PG8_MMA(0, 0, At, B0); PG8_MMA(0, 1, At, B1); PG8_BAR; PG8_SCHED;
            if constexpr (!HALF_M) PG8_LDA(At, 0, 1); PG8_STAGE(PG8_SB(0, 0), b2, voffB); PG8_STAGE(PG8_SB(0, 1), b2 + hstep, voffB); PG8_STAGE(PG8_SA(0, 0), a2, voffA);
            if constexpr (HALF_M) PG8_WAIT_V(6); else PG8_WAIT_V(8); PG8_WAIT_L(0); PG8_BAR; if constexpr (!HALF_M) { PG8_MMA(1, 0, At, B0); PG8_MMA(1, 1, At, B1); } PG8_BAR; PG8_SCHED;
            PG8_LDB(B0, 1, 0); PG8_LDB(B1, 1, 1); PG8_SCHED; PG8_LDA(At, 1, 0); if constexpr (!HALF_M) PG8_STAGE(PG8_SA(0, 1), a2 + hstepA, voffA);
            PG8_WAIT_V(8); PG8_WAIT_L(0); PG8_BAR; PG8_MMA(0, 0, At, B0); PG8_MMA(0, 1, At, B1); PG8_BAR; PG8_SCHED;
            if constexpr (!HALF_M) PG8_LDA(At, 1, 1); PG8_STAGE(PG8_SB(1, 0), b3, voffB); PG8_STAGE(PG8_SB(1, 1), b3 + hstep, voffB); PG8_STAGE(PG8_SA(1, 0), a3, voffA);
            if constexpr (HALF_M) PG8_WAIT_V(6); else PG8_WAIT_V(8); PG8_WAIT_L(0); PG8_BAR; if constexpr (!HALF_M) { PG8_MMA(1, 0, At, B0); PG8_MMA(1, 1, At, B1); } PG8_BAR; PG8_SCHED;
            } else {
            PG8_LDB(B0, 0, 0); PG8_SCHED; PG8_LDA(At, 0, 0); PG8_STAGE(PG8_SA(1, 1), a1 + hstepA, voffA);
            PG8_WAIT_L(8); PG8_BAR; PG8_WAIT_L(0); PG8_MMA(0, 0, At, B0); PG8_BAR; PG8_SCHED;
            PG8_LDB(B1, 0, 1); PG8_STAGE(PG8_SB(0, 0), b2, voffB);
            PG8_BAR; PG8_WAIT_L(0); PG8_MMA(0, 1, At, B1); PG8_BAR;
            PG8_LDA(At, 0, 1); PG8_STAGE(PG8_SA(0, 0), a2, voffA);
            PG8_BAR; PG8_WAIT_L(0); PG8_MMA(1, 0, At, B0); PG8_BAR; PG8_SCHED;
            PG8_STAGE(PG8_SB(0, 1), b2 + hstep, voffB);
            PG8_WAIT_V(6); PG8_BAR; PG8_MMA(1, 1, At, B1); PG8_BAR;
            PG8_LDB(B0, 1, 0); PG8_SCHED; PG8_LDA(At, 1, 0); PG8_STAGE(PG8_SA(0, 1), a2 + hstepA, voffA);
            PG8_WAIT_L(8); PG8_BAR; PG8_WAIT_L(0); PG8_MMA(0, 0, At, B0); PG8_BAR; PG8_SCHED;
            PG8_LDB(B1, 1, 1); PG8_STAGE(PG8_SB(1, 0), b3, voffB);
            PG8_BAR; PG8_WAIT_L(0); PG8_MMA(0, 1, At, B1); PG8_BAR;
            PG8_LDA(At, 1, 1); PG8_STAGE(PG8_SA(1, 0), a3, voffA);
            PG8_BAR; PG8_WAIT_L(0); PG8_MMA(1, 0, At, B0); PG8_BAR; PG8_SCHED;
            PG8_STAGE(PG8_SB(1, 1), b3 + hstep, voffB);
            PG8_WAIT_V(6); PG8_BAR; PG8_MMA(1, 1, At, B1); PG8_BAR;
            }
        }
        if constexpr (ALIGN_EPI) { if (wr == 0) PG8_BAR; }
        if constexpr (!Epi::AFTER_DRAIN) { E(acc, cur, wr, wc, fr, fq); S.done(cur); }
        if (!has_next) break;
#pragma unroll
        for (int a = 0; a < 2; ++a)
#pragma unroll
            for (int b = 0; b < 2; ++b)
#pragma unroll
                for (int m = 0; m < 4; ++m)
#pragma unroll
                    for (int n = 0; n < 2; ++n) acc[a][b][m][n] = (f32x4){0.f, 0.f, 0.f, 0.f};
        cur = nxt; cA = nA; cB = nB; ++ui;
        if constexpr (ALIGN_EPI) { if (wr == 1) PG8_BAR; }
    }
    PG8_WAIT_V(0);
    if constexpr (!ALIGN_EPI) { if (wr == 0) PG8_BAR; }
    PG8_BAR;
    if constexpr (Epi::AFTER_DRAIN) { E.fused(acc, cur, wr, wc, fr, fq, lds, wid, lane); S.done(cur); }
#undef PG8_SA
#undef PG8_SB
#undef PG8_STAGE
#undef PG8_LDA
#undef PG8_LDB
#undef PG8_MMA
#undef PG8_WAIT_V
#undef PG8_WAIT_L
#undef PG8_BAR
#undef PG8_SCHED
}
}

#define GAS __attribute__((address_space(1)))
#define LAS __attribute__((address_space(3)))
typedef unsigned short bf16;
typedef unsigned v4u __attribute__((ext_vector_type(4)));
typedef float f32x4 __attribute__((ext_vector_type(4)));
typedef short bf16x8 __attribute__((ext_vector_type(8)));
typedef GAS unsigned gu32;
typedef GAS unsigned long long gu64;
#define RLX_AGENT __ATOMIC_RELAXED, __HIP_MEMORY_SCOPE_AGENT
#define LDS_WAIT() asm volatile("s_waitcnt lgkmcnt(0)" ::: "memory")
#define VM_WAIT() asm volatile("s_waitcnt vmcnt(0)" ::: "memory")
__device__ __forceinline__ unsigned long long rt() { return __builtin_amdgcn_s_memrealtime(); }
__device__ __forceinline__ unsigned f2bf(float f) { unsigned u = __builtin_bit_cast(unsigned, f); return (u + 0x7fffu + ((u >> 16) & 1u)) >> 16; }
__device__ __forceinline__ unsigned pk2(float lo, float hi) { return f2bf(lo) | (f2bf(hi) << 16); }
#define XB_TMO      128
#define XB_XCNT(j)  (256  + 64 * (j))
#define XB_XSUB(j)  (1280 + 64 * (j))
#define XB_XGEN(j)  (2304 + 64 * (j))
#define XB_TOP      3328
#define XB_TOPGEN   3392
#define XCD_BAR_WORDS 3456
#define XB_SPIN_CAP (1u << 18)

__device__ __forceinline__ unsigned xb_ld(unsigned* p)              { return __hip_atomic_load(p, __ATOMIC_RELAXED, __HIP_MEMORY_SCOPE_AGENT); }
__device__ __forceinline__ unsigned xb_add(unsigned* p, unsigned v) { return __hip_atomic_fetch_add(p, v, __ATOMIC_RELAXED, __HIP_MEMORY_SCOPE_AGENT); }
__device__ __forceinline__ unsigned xb_xcc_id() { return (unsigned)__builtin_amdgcn_s_getreg((3 << 11) | 20) & 0xFu; }
#define XB_SPIN(cond, bar) do { unsigned _sp = 0; while (cond) { __builtin_amdgcn_s_sleep(1); \
    if ((++_sp & 255u) == 0u) { if (xb_ld(&(bar)[XB_TMO])) break; if (_sp > XB_SPIN_CAP) { atomicAdd(&(bar)[XB_TMO], 1u); break; } } } } while (0)

struct XcdBarrier {
    unsigned* bar; unsigned x;
    volatile LAS unsigned* st;
};

__device__ __forceinline__ XcdBarrier xcd_barrier_post(unsigned* bar, volatile LAS unsigned* st) {
    XcdBarrier b; b.bar = bar; b.x = xb_xcc_id(); b.st = st;
    if (threadIdx.x == 0) (void)xb_add(&bar[XB_XCNT(b.x)], 1u);
    return b;
}
__device__ __forceinline__ void xcd_barrier_complete(unsigned* bar, unsigned x, unsigned& nloc, unsigned& nx) {
    const unsigned G = gridDim.x * gridDim.y * gridDim.z;
    unsigned sum, cnt, mine, sp = 0u;
    for (;;) {
        sum = 0u; cnt = 0u; mine = 0u;
#pragma unroll
        for (unsigned j = 0; j < 16; ++j) { const unsigned c = xb_ld(&bar[XB_XCNT(j)]); sum += c; cnt += (c > 0u) ? 1u : 0u; mine = (j == x) ? c : mine; }
        if (sum == G) break;
        __builtin_amdgcn_s_sleep(1);
        if ((++sp & 255u) == 0u) { if (xb_ld(&bar[XB_TMO])) break; if (sp > XB_SPIN_CAP) { atomicAdd(&bar[XB_TMO], 1u); break; } }
    }
    nloc = mine > 0u ? mine : 1u; nx = cnt > 0u ? cnt : 1u;
}

__device__ __forceinline__ void xcd_barrier(const XcdBarrier& b) {
    asm volatile("s_waitcnt vmcnt(0)" ::: "memory");
    __syncthreads();
    if (threadIdx.x == 0) {
        unsigned* bar = b.bar;
        __builtin_amdgcn_s_waitcnt(0);
        unsigned nloc = b.st[0], nx = b.st[1];
        if (nloc == 0u) { xcd_barrier_complete(bar, b.x, nloc, nx); b.st[0] = nloc; b.st[1] = nx; }
        const unsigned old = xb_add(&bar[XB_XSUB(b.x)], 1u);
        const unsigned gen = old / nloc;
        if (old + 1u == (gen + 1u) * nloc) {
            __builtin_amdgcn_fence(__ATOMIC_RELEASE, "agent");
            asm volatile("s_waitcnt vmcnt(0)" ::: "memory");
            const unsigned og = xb_add(&bar[XB_TOP], 1u);
            const unsigned tg = og / nx;
            if (og + 1u == (tg + 1u) * nx) xb_add(&bar[XB_TOPGEN], 1u);
            else XB_SPIN(xb_ld(&bar[XB_TOPGEN]) == tg, bar);
            __builtin_amdgcn_fence(__ATOMIC_ACQUIRE, "agent");
            xb_add(&bar[XB_XGEN(b.x)], 1u);
            asm volatile("s_waitcnt vmcnt(0)" ::: "memory");
        } else {
            XB_SPIN(xb_ld(&bar[XB_XGEN(b.x)]) == gen, bar);
            __builtin_amdgcn_fence(__ATOMIC_ACQUIRE, "agent");
            asm volatile("s_waitcnt vmcnt(0)" ::: "memory");
        }
    }
    __syncthreads();
}

namespace mk {
using pg8::bf16_t; using pg8::Unit;
typedef unsigned u32x2 __attribute__((ext_vector_type(2)));
typedef unsigned u32x4 __attribute__((ext_vector_type(4)));
typedef short s16x4 __attribute__((ext_vector_type(4)));
typedef float f32x2 __attribute__((ext_vector_type(2)));

constexpr int D = 2048, T = 2048, NB = 4, M = NB * T, DEPTH = 4, SB = 8, FF = 5632, INW = 6144, PLE = 256, NUP = 2 * FF;
constexpr float ALPHA = 1.6817928305074290f, LN_EPS = 1e-5f, GN_EPS = 1e-5f, LOG2E = 1.4426950408889634f;
constexpr int NWAVES = 8, NTHR = 512;

constexpr size_t O_YP = 0, O_YS = O_YP + (size_t)M * D, O_KP = O_YS + (size_t)SB * D, O_VP = O_KP + (size_t)DEPTH * M * 1024, O_RP = O_VP + (size_t)DEPTH * M * 1024,
                 O_KS = O_RP + (size_t)DEPTH * NB * 8 * 64 * 128, O_VS = O_KS + (size_t)DEPTH * SB * 1024, O_RS = O_VS + (size_t)DEPTH * SB * 1024, O_END = O_RS + (size_t)DEPTH * SB * 8 * 64 * 128;

constexpr int CV_UP1 = 0, CV_IN = NUP, CV_UP2 = NUP + INW, CV_GATE = 2 * NUP + INW, NCV = 2 * NUP + INW + D;

constexpr size_t E_UP = (size_t)NUP * D, E_DN = (size_t)D * FF, E_IN = (size_t)INW * D, E_OUT = (size_t)D * D, E_GATE = (size_t)D * D, E_PLE = (size_t)D * PLE;
constexpr size_t W_UP1 = 0, W_DN1 = W_UP1 + E_UP, W_IN = W_DN1 + E_DN, W_OUT = W_IN + E_IN, W_UP2 = W_OUT + E_OUT, W_DN2 = W_UP2 + E_UP, W_GATE = W_DN2 + E_DN, W_PLE = W_GATE + E_GATE, LW = W_PLE + E_PLE;

constexpr size_t al256(size_t x) { return (x + 255) & ~(size_t)255; }
constexpr size_t WS_CTL = 0, CTL_BYTES = 1u << 20;
constexpr size_t WS_STATS = CTL_BYTES;
constexpr size_t WS_CV = WS_STATS + 2 * (size_t)M * 16 * 4;
constexpr size_t WS_SMP = al256(WS_CV + (size_t)DEPTH * 2 * NCV * 4);
constexpr size_t WS_PART = WS_SMP + (2u << 20);
constexpr size_t WS_W = al256(WS_PART + (size_t)DEPTH * 2 * 32 * NCV * 4);
constexpr size_t WS_YB = al256(WS_W + (size_t)DEPTH * LW * 2);
constexpr size_t WS_Y = WS_YB + 2 * (size_t)M * D * 2;
constexpr size_t WS_H = WS_Y + (size_t)M * D * 4;
constexpr size_t WS_Z = WS_H + (size_t)M * FF * 2;
constexpr size_t WS_MIX = WS_Z + (size_t)M * INW * 2;
constexpr size_t WS_OG = WS_MIX + (size_t)M * D * 2;
constexpr size_t WS_LSE = WS_OG + 3 * (size_t)M * 1024 * 2;
constexpr size_t WS_U = WS_LSE + 3 * (size_t)M * 8 * 4;
constexpr size_t WS_PB = WS_U + (size_t)NB * 8 * 16 * 8192 * 4;
constexpr size_t WS_PW = WS_PB + (size_t)DEPTH * M * PLE * 2;
constexpr size_t WS_END = WS_PW + (size_t)DEPTH * M * D * 2;
constexpr int SM_YS = 0;
constexpr int SM_ST = SM_YS + 2 * 8 * 2048;
constexpr int SM_RUP = SM_ST + 64;
constexpr int SM_RD = SM_RUP + 8 * NUP;
constexpr int SM_RIN = SM_RD + 8 * D;
constexpr int SM_MIX = SM_RIN + 8 * INW;
constexpr int SM_AP = SM_MIX + 8 * D;
constexpr int SM_PWS = SM_AP + 192 * 136;
constexpr int SM_RDB = SM_PWS + DEPTH * 8 * D;
constexpr int SM_HS = SM_RDB + 8 * D;
constexpr int SM_END = SM_HS + 8 * FF / 4;
static_assert(SM_END * 4 <= (2 << 20), "sample scratch");

constexpr int RING_BYTES = 131072, MISC_OFF = RING_BYTES + 320, LDS_BYTES = 147456;

__device__ __forceinline__ float bf2f(unsigned short u) { return __uint_as_float((unsigned)u << 16); }
__device__ __forceinline__ float bflo(unsigned u) { return __uint_as_float(u << 16); }
__device__ __forceinline__ float bfhi(unsigned u) { return __uint_as_float(u & 0xffff0000u); }
__device__ __forceinline__ unsigned pk(float lo, float hi) { return pg8::cvt_pk_bf16(lo, hi); }
__device__ __forceinline__ float shx(float v, int m, int lane) { return __int_as_float(__builtin_amdgcn_ds_bpermute((lane ^ m) << 2, __float_as_int(v))); }
__device__ __forceinline__ float sigmoid_f(float v) { return __builtin_amdgcn_rcpf(1.f + __builtin_amdgcn_exp2f(-v * LOG2E)); }

__device__ __forceinline__ float clamp448(float v) { return __builtin_amdgcn_fmed3f(v, -448.f, 448.f); }
__device__ __forceinline__ unsigned pk8(float a, float b, float c, float d) { int w = 0; w = __builtin_amdgcn_cvt_pk_fp8_f32(clamp448(a), clamp448(b), w, false); w = __builtin_amdgcn_cvt_pk_fp8_f32(clamp448(c), clamp448(d), w, true); return (unsigned)w; }
__device__ __forceinline__ unsigned pk8u(float a, float b, float c, float d) { int w = 0; w = __builtin_amdgcn_cvt_pk_fp8_f32(a, b, w, false); w = __builtin_amdgcn_cvt_pk_fp8_f32(c, d, w, true); return (unsigned)w; }
__device__ __forceinline__ float up8(unsigned w, int sel) { return sel == 0 ? __builtin_amdgcn_cvt_f32_fp8((int)w, 0) : sel == 1 ? __builtin_amdgcn_cvt_f32_fp8((int)w, 1) : sel == 2 ? __builtin_amdgcn_cvt_f32_fp8((int)w, 2) : __builtin_amdgcn_cvt_f32_fp8((int)w, 3); }
constexpr float W8S = 256.f, H8S = 64.f;

__device__ __forceinline__ void row_stats(const float* st, int row, float& mu, float& rs) {
    const f32x4* p = (const f32x4*)(st + (size_t)row * 16);
    const f32x4 a = p[0], b = p[1], c = p[2], d = p[3];
    const float s = ((a.x + a.z) + (b.x + b.z)) + ((c.x + c.z) + (d.x + d.z));
    const float q = ((a.y + a.w) + (b.y + b.w)) + ((c.y + c.w) + (d.y + d.w));
    mu = s * (1.f / 2048.f);
    const float var = fmaxf(q * (1.f / 2048.f) - mu * mu, 0.f);
    rs = 1.0f / sqrtf(var + LN_EPS);
}

constexpr int TAB_OFF = RING_BYTES + 1024;
template <class Sched> __device__ __forceinline__ void stats_table_fill(PG8_LAS unsigned char* lds, const Sched& S, const float* st, int tid) {
    PG8_LAS f32x2* tab = (PG8_LAS f32x2*)(lds + TAB_OFF);
#pragma unroll
    for (int k = 0; k < 3; ++k) {
        const int e = tid + 512 * k, slot = e >> 8, r = e & 255;
        Unit u;
        if (S.next(slot, u)) { float mu, rs; row_stats(st, u.pm * 256 + r, mu, rs); tab[e] = (f32x2){mu, rs}; }
    }
    __syncthreads();
}
__device__ __forceinline__ f32x2 tab_get(const Unit& u, int rowlocal) { extern __shared__ __attribute__((aligned(16))) unsigned char lds_tab_[]; return ((const PG8_LAS f32x2*)((PG8_LAS unsigned char*)lds_tab_ + TAB_OFF))[u.idx * 256 + rowlocal]; }

struct TailOrder {
    pg8::StaticOrder base; int first, nfull, c, total;
    __device__ bool next(int i, Unit& u) const {
        const int F = first + i * nfull + (c % nfull);
        if (c >= 2 * nfull || F >= total) return false;
        pg8::StaticOrder b = base; b.lim = b.nwg; b.G = 1; b.c = 0;
        if (!b.next(F, u)) return false;
        u.idx = i; u.half = c / nfull; return true;
    }
    __device__ __forceinline__ void a_ready(const Unit&) const {}
    __device__ __forceinline__ void done(const Unit&) const {}
};
struct ChainOrder {
    static constexpr bool HAS_CHAIN = true;
    pg8::StaticOrder base; int first, nfull;
    __device__ bool next(int i, Unit& u) const { return base.next(i, u); }
    __device__ bool chain(Unit& u) const { const TailOrder t{base, first, nfull, base.c, base.nwg}; return t.next(0, u); }
    __device__ __forceinline__ void a_ready(const Unit&) const {}
    __device__ __forceinline__ void done(const Unit&) const {}
};
__device__ __forceinline__ void stats_table_fill_half(PG8_LAS unsigned char* lds, const TailOrder& S, const float* st, int tid) {
    PG8_LAS f32x2* tab = (PG8_LAS f32x2*)(lds + TAB_OFF);
#pragma unroll
    for (int k = 0; k < 3; ++k) {
        const int e = tid + 512 * k, slot = e >> 7, r = e & 127;
        Unit u;
        if (S.next(slot, u)) { float mu, rs; row_stats(st, u.pm * 256 + u.half * 128 + r, mu, rs); tab[e] = (f32x2){mu, rs}; }
    }
    __syncthreads();
}
__device__ __forceinline__ f32x2 tab_get_half(const Unit& u, int rowlocal128) { extern __shared__ __attribute__((aligned(16))) unsigned char lds_tab_[]; return ((const PG8_LAS f32x2*)((PG8_LAS unsigned char*)lds_tab_ + TAB_OFF))[u.idx * 128 + rowlocal128]; }

template <class Sched> struct PreTab { PG8_LAS unsigned char* lds; const Sched& S; const float* st; int tid; int on;
    __device__ __forceinline__ void operator()() const { if (on) stats_table_fill(lds, S, st, tid); } };
struct PreTabHalf { PG8_LAS unsigned char* lds; const TailOrder& S; const float* st; int tid; int on;
    __device__ __forceinline__ void operator()() const { if (on) stats_table_fill_half(lds, S, st, tid); } };

template <bool HALF_M> struct EpiSwiGLU {
    static constexpr bool PERM = true, AFTER_DRAIN = false; static constexpr int NSTORE = HALF_M ? 4 : 8;
    unsigned char* H; const float* st; const float* c1; const float* c2; int ident;
#if defined(MK_PROBE)
    int nost;
#endif
    __device__ __forceinline__ void operator()(const f32x4 (&acc)[2][2][4][2], const Unit& u, int wr, int wc, int fr, int fq) const {
#if defined(MK_PROBE)
        if (nost & 2) return;
#endif
        const int hoff = HALF_M ? u.half * 128 : 0, row0 = u.pm * 256 + hoff + wr * 64 + fr;
        const int nc = u.pn * 256 + wc * 32 + 8 * fq, hc = u.pn * 128 + wc * 32 + 8 * fq;
        f32x4 c1g[2], c2g[2], c1u[2], c2u[2];
#pragma unroll
        for (int n = 0; n < 2; ++n) {
            if (ident) { c1g[n] = (f32x4){0.f, 0.f, 0.f, 0.f}; c2g[n] = c1g[n]; c1u[n] = c1g[n]; c2u[n] = c1g[n]; }
            else { c1g[n] = *(const f32x4*)(c1 + nc + 4 * n); c2g[n] = *(const f32x4*)(c2 + nc + 4 * n); c1u[n] = *(const f32x4*)(c1 + nc + 128 + 4 * n) * H8S; c2u[n] = *(const f32x4*)(c2 + nc + 128 + 4 * n) * H8S; }
        }
#pragma unroll
        for (int ai = 0; ai < (HALF_M ? 1 : 2); ++ai)
#pragma unroll
            for (int m = 0; m < 4; ++m) {
                const int r = row0 + ai * 128 + m * 16;
                float mu = 0.f, rs = 1.f;
                if (!ident) { const f32x2 ms = HALF_M ? tab_get_half(u, wr * 64 + m * 16 + fr) : tab_get(u, ai * 128 + wr * 64 + m * 16 + fr); mu = ms.x; rs = ms.y; }
                u32x2 w;
                const float rsg = rs * (1.f / W8S), rsu = rs * (H8S / W8S), nm = -mu * rs;
#pragma unroll
                for (int n = 0; n < 2; ++n) {
                    const f32x4 g4 = acc[ai][0][m][n] * rsg + (c1g[n] * nm + c2g[n]);
                    const f32x4 u4 = acc[ai][1][m][n] * rsu + (c1u[n] * nm + c2u[n]);
                    float h4[4];
#pragma unroll
                    for (int e = 0; e < 4; ++e) h4[e] = g4[e] * u4[e] * sigmoid_f(g4[e]);
                    w[n] = pk8(h4[0], h4[1], h4[2], h4[3]);
                }
#if defined(MK_PROBE)
                if (nost & 1) { asm volatile("" :: "v"(w)); continue; }
#endif
                *(u32x2*)(H + (size_t)r * FF + hc) = w;
            }
    }
};
struct EpiIn {
    static constexpr bool PERM = true, AFTER_DRAIN = false; static constexpr int NSTORE = 16;
    bf16_t* Z; float* kout; float* vout; const float* st; const float* c1; const float* c2;
    __device__ __forceinline__ void operator()(const f32x4 (&acc)[2][2][4][2], const Unit& u, int wr, int wc, int fr, int fq) const {
        const int row0 = u.pm * 256 + wr * 64 + fr, colb = u.pn * 256 + wc * 32 + 8 * fq;
        const float sc = (u.pn == 14 || u.pn == 15) ? 0.125f : 1.f;
        f32x4 c1v[2][2], c2v[2][2];
#pragma unroll
        for (int bj = 0; bj < 2; ++bj)
#pragma unroll
            for (int n = 0; n < 2; ++n) { c1v[bj][n] = *(const f32x4*)(c1 + colb + bj * 128 + 4 * n); c2v[bj][n] = *(const f32x4*)(c2 + colb + bj * 128 + 4 * n); }
#pragma unroll
        for (int ai = 0; ai < 2; ++ai)
#pragma unroll
            for (int m = 0; m < 4; ++m) {
                const int r = row0 + ai * 128 + m * 16;
                const f32x2 ms = tab_get(u, ai * 128 + wr * 64 + m * 16 + fr); const float mu = ms.x, rs = ms.y;
#pragma unroll
                for (int bj = 0; bj < 2; ++bj) {
                    const int col = colb + bj * 128;
                    const f32x4 z0 = (acc[ai][bj][m][0] - mu * c1v[bj][0]) * rs + c2v[bj][0];
                    const f32x4 z1 = (acc[ai][bj][m][1] - mu * c1v[bj][1]) * rs + c2v[bj][1];
                    if (u.pn >= 4 && u.pn < 12) {
                        float* dst = (u.pn < 8) ? (kout + (size_t)r * 1024 + (col - 1024)) : (vout + (size_t)r * 1024 + (col - 2048));
                        __builtin_nontemporal_store(z0, (f32x4*)dst); __builtin_nontemporal_store(z1, (f32x4*)(dst + 4));
                    }
                    u32x4 w; w.x = pk(z0[0] * sc, z0[1] * sc); w.y = pk(z0[2] * sc, z0[3] * sc); w.z = pk(z1[0] * sc, z1[1] * sc); w.w = pk(z1[2] * sc, z1[3] * sc);
                    *(u32x4*)(Z + (size_t)r * INW + col) = w;
                }
            }
    }
};
struct EpiPlain {
    static constexpr bool PERM = true, AFTER_DRAIN = false; static constexpr int NSTORE = 16;
    bf16_t* O; int ldc;
    __device__ __forceinline__ void operator()(const f32x4 (&acc)[2][2][4][2], const Unit& u, int wr, int wc, int fr, int fq) const {
        const int row0 = u.pm * 256 + wr * 64 + fr;
#pragma unroll
        for (int ai = 0; ai < 2; ++ai)
#pragma unroll
            for (int m = 0; m < 4; ++m)
#pragma unroll
                for (int bj = 0; bj < 2; ++bj) {
                    const int r = row0 + ai * 128 + m * 16, col = u.pn * 256 + bj * 128 + wc * 32 + 8 * fq;
                    const f32x4 z0 = acc[ai][bj][m][0], z1 = acc[ai][bj][m][1];
                    u32x4 w; w.x = pk(z0[0], z0[1]); w.y = pk(z0[2], z0[3]); w.z = pk(z1[0], z1[1]); w.w = pk(z1[2], z1[3]);
                    *(u32x4*)(O + (size_t)r * ldc + col) = w;
                }
    }
};
constexpr int PLE_TSTEP = (int)(LW * 2 / (256 * PLE * 2));
static_assert((LW * 2) % (256 * PLE * 2) == 0, "layer stride is a whole number of w_ple tile steps");
struct PleOrder {
    pg8::StaticOrder base;
    __device__ bool next(int i, Unit& u) const { if (i >= DEPTH || !base.next(0, u)) return false; u.pm += 32 * i; u.pn += PLE_TSTEP * i; u.idx = i; return true; }
    __device__ __forceinline__ void a_ready(const Unit&) const {}
    __device__ __forceinline__ void done(const Unit&) const {}
};
struct EpiPle {
    static constexpr bool PERM = true, AFTER_DRAIN = false; static constexpr int NSTORE = 16;
    bf16_t* O;
    __device__ __forceinline__ void operator()(const f32x4 (&acc)[2][2][4][2], const Unit& u, int wr, int wc, int fr, int fq) const {
        const int l = u.idx, pm0 = u.pm - 32 * l, pn0 = u.pn - PLE_TSTEP * l, row0 = pm0 * 256 + wr * 64 + fr;
        bf16_t* Ol = O + (size_t)l * M * D;
#pragma unroll
        for (int ai = 0; ai < 2; ++ai)
#pragma unroll
            for (int m = 0; m < 4; ++m)
#pragma unroll
                for (int bj = 0; bj < 2; ++bj) {
                    const int r = row0 + ai * 128 + m * 16, col = pn0 * 256 + bj * 128 + wc * 32 + 8 * fq;
                    const f32x4 z0 = acc[ai][bj][m][0], z1 = acc[ai][bj][m][1];
                    u32x4 w; w.x = pk(z0[0], z0[1]); w.y = pk(z0[2], z0[3]); w.z = pk(z1[0], z1[1]); w.w = pk(z1[2], z1[3]);
                    *(u32x4*)(Ol + (size_t)r * D + col) = w;
                }
    }
};
template <int MODE, bool HALF_M = false> struct EpiRes {
    static constexpr bool PERM = true, AFTER_DRAIN = true; static constexpr int NSTORE = 0;
    const float* prev32; const bf16_t* prevb; bf16_t* ybout; const float* st_prev; float* st_next; const float* g; const float* b; int ident; float scale;
    const bf16_t* pw; const float* c1; const float* c2; unsigned char* y8;
    __device__ __forceinline__ void fused(f32x4 (&acc)[2][2][4][2], const Unit& u, int wr, int wc, int fr, int fq, PG8_LAS unsigned char* lds, int wid, int lane) const {
        asm volatile("" : "+v"(lane));
        fr = lane & 15; fq = lane >> 4;
        const int hoff = HALF_M ? u.half * 128 : 0, col0 = u.pn * 256 + wc * 32 + 8 * fq, rowb = u.pm * 256 + hoff + wr * 64 + fr, cl0 = wc * 32 + 8 * fq;
        PG8_LAS f32x2* P = (PG8_LAS f32x2*)lds;
        PG8_LAS float* CVL = (PG8_LAS float*)(lds + 8192);
        {   const int t = wid * 64 + lane, cc = u.pn * 256 + (t & 255);
            if (t < 256) { CVL[t] = ident ? 1.f : g[cc]; CVL[256 + t] = ident ? 0.f : b[cc]; }
            else if (MODE == 1) { CVL[512 + (t & 255)] = c1[cc]; CVL[768 + (t & 255)] = c2[cc]; } }
        constexpr bool BOTH = (MODE == 0) && !HALF_M;
        u32x4 pvall[2][4][2];
        if constexpr (BOTH) {
#pragma unroll
            for (int a2 = 0; a2 < 2; ++a2)
#pragma unroll
                for (int m = 0; m < 4; ++m)
#pragma unroll
                    for (int bj = 0; bj < 2; ++bj) pvall[a2][m][bj] = ident ? (u32x4){0u, 0u, 0u, 0u} : *(const u32x4*)(prevb + (size_t)(rowb + a2 * 128 + m * 16) * D + col0 + bj * 128);
        }
#pragma unroll
        for (int ai = 0; ai < (HALF_M ? 1 : 2); ++ai) {
            u32x4 (&pv)[4][2] = pvall[ai]; u32x4 pq[4][2];
#pragma unroll
            for (int m = 0; m < 4; ++m)
#pragma unroll
                for (int bj = 0; bj < 2; ++bj) {
                    const size_t off = (size_t)(rowb + ai * 128 + m * 16) * D + col0 + bj * 128;
                    if constexpr (!BOTH) pv[m][bj] = ident ? (u32x4){0u, 0u, 0u, 0u} : *(const u32x4*)(prevb + off);
                    pq[m][bj] = (MODE == 1) ? *(const u32x4*)(pw + off) : (u32x4){0u, 0u, 0u, 0u};
                }
            if (ai == 0) __syncthreads();
#pragma unroll
            for (int m = 0; m < 4; ++m) {
                const int r = rowb + ai * 128 + m * 16;
                float mu = 0.f, rs = 1.f, ssum = 0.f, ssq = 0.f;
                if (!ident) { const f32x2 ms = HALF_M ? tab_get_half(u, wr * 64 + m * 16 + fr) : tab_get(u, ai * 128 + wr * 64 + m * 16 + fr); mu = ms.x; rs = ms.y; }
#pragma unroll
                for (int bj = 0; bj < 2; ++bj) {
                    const size_t offb = (size_t)r * D + col0 + bj * 128;
                    u32x4 wo; u32x2 w8;
#pragma unroll
                    for (int n = 0; n < 2; ++n) {
                        const int cl = cl0 + bj * 128 + 4 * n;
                        const unsigned pa = pv[m][bj][2 * n], pb = pv[m][bj][2 * n + 1], qa = pq[m][bj][2 * n], qb = pq[m][bj][2 * n + 1];
                        f32x4 x;
                        if (ident) x = *(const f32x4*)(prev32 + offb + 4 * n);
                        else { const f32x4 pvv = (f32x4){bflo(pa), bfhi(pa), bflo(pb), bfhi(pb)}; x = (pvv - mu) * rs * (*(const PG8_LAS f32x4*)(CVL + cl)) + *(const PG8_LAS f32x4*)(CVL + 256 + cl); }
                        const f32x4 a = acc[ai][bj][m][n];
                        f32x4 t;
                        if (MODE == 0) t = a * scale;
                        else {
                            const f32x4 zf = (a - mu * (*(const PG8_LAS f32x4*)(CVL + 512 + cl))) * rs + *(const PG8_LAS f32x4*)(CVL + 768 + cl);
                            t[0] = bflo(qa) * sigmoid_f(zf[0]); t[1] = bfhi(qa) * sigmoid_f(zf[1]); t[2] = bflo(qb) * sigmoid_f(zf[2]); t[3] = bfhi(qb) * sigmoid_f(zf[3]);
                        }
                        const f32x4 y = x * ALPHA + t;
                        const unsigned w0 = pk(y[0], y[1]), w1 = pk(y[2], y[3]);
                        wo[2 * n] = w0; wo[2 * n + 1] = w1;
                        w8[n] = pk8(y[0], y[1], y[2], y[3]);
                        const float y0 = bflo(w0), y1 = bfhi(w0), y2 = bflo(w1), y3 = bfhi(w1);
                        ssum += (y0 + y1) + (y2 + y3);
                        ssq += (y0 * y0 + y1 * y1) + (y2 * y2 + y3 * y3);
                    }
                    *(u32x4*)(ybout + offb) = wo;
                    if (y8) *(u32x2*)(y8 + offb) = w8;
                }
                ssum += shx(ssum, 16, lane); ssum += shx(ssum, 32, lane); ssq += shx(ssq, 16, lane); ssq += shx(ssq, 32, lane);
                if (fq == 0) P[(ai * 128 + wr * 64 + m * 16 + fr) * 4 + wc] = (f32x2){ssum, ssq};
            }
        }
        __syncthreads();
        const int tid = wid * 64 + lane;
        if (tid < (HALF_M ? 128 : 256)) {
            const f32x2 a0 = P[tid * 4 + 0], a1 = P[tid * 4 + 1], a2 = P[tid * 4 + 2], a3 = P[tid * 4 + 3];
            f32x2 o; o.x = (a0.x + a1.x) + (a2.x + a3.x); o.y = (a0.y + a1.y) + (a2.y + a3.y);
            *(f32x2*)(st_next + (size_t)(u.pm * 256 + hoff + tid) * 16 + u.pn * 2) = o;
        }
        __syncthreads();
    }
};

struct TrCtx { const float* W; bf16_t* WT; const float* gk; const float* bk; float* p1; float* p2; int K, N, drow0, n0, k0, f8; };
__device__ __forceinline__ void tr_load(const TrCtx& c, int lane, float (&wv)[32], float (&gv)[8], float (&bv)[8]) {
    const int cc = lane & 7;
#pragma unroll
    for (int e = 0; e < 8; ++e) { gv[e] = 1.f; bv[e] = 0.f; }
    if (c.gk) {
        const f32x4 g0 = *(const f32x4*)(c.gk + c.k0 + 8 * cc), g1 = *(const f32x4*)(c.gk + c.k0 + 8 * cc + 4), b0 = *(const f32x4*)(c.bk + c.k0 + 8 * cc), b1 = *(const f32x4*)(c.bk + c.k0 + 8 * cc + 4);
#pragma unroll
        for (int e = 0; e < 4; ++e) { gv[e] = g0[e]; gv[4 + e] = g1[e]; bv[e] = b0[e]; bv[4 + e] = b1[e]; }
    }
    const float* wp = c.W + (size_t)(c.k0 + (lane >> 5)) * c.N + c.n0 + (lane & 31);
#pragma unroll
    for (int i = 0; i < 32; ++i) wv[i] = __builtin_nontemporal_load(wp + (size_t)(2 * i) * c.N);
}
__device__ __forceinline__ void tr_proc(const TrCtx& c, PG8_LAS float* scr, int lane, const float (&wv)[32], const float (&gv)[8], const float (&bv)[8]) {
    const int cc = lane & 7;
#pragma unroll
    for (int i = 0; i < 32; ++i) scr[(2 * i + (lane >> 5)) * 33 + (lane & 31)] = wv[i];
    asm volatile("s_waitcnt lgkmcnt(0)" ::: "memory");
#pragma unroll
    for (int j = 0; j < 4; ++j) {
        const int n = (lane >> 3) + 8 * j; const PG8_LAS float* s = scr + (8 * cc) * 33 + n;
        float w[8];
#pragma unroll
        for (int e = 0; e < 8; ++e) w[e] = s[e * 33];
        float r1 = 0.f;
        if (c.f8) {
            float ws8[8];
#pragma unroll
            for (int e = 0; e < 8; ++e) ws8[e] = __builtin_amdgcn_fmed3f(w[e] * gv[e] * W8S, -448.f, 448.f);
            u32x2 o; o.x = pk8u(ws8[0], ws8[1], ws8[2], ws8[3]); o.y = pk8u(ws8[4], ws8[5], ws8[6], ws8[7]);
            __builtin_nontemporal_store(o, (u32x2*)((unsigned char*)c.WT + (size_t)(c.drow0 + n) * c.K + c.k0 + 8 * cc));
            if (c.gk) r1 = (((up8(o.x, 0) + up8(o.x, 1)) + (up8(o.x, 2) + up8(o.x, 3))) + ((up8(o.y, 0) + up8(o.y, 1)) + (up8(o.y, 2) + up8(o.y, 3)))) * (1.f / W8S);
        } else {
            u32x4 o; o.x = pk(w[0] * gv[0], w[1] * gv[1]); o.y = pk(w[2] * gv[2], w[3] * gv[3]); o.z = pk(w[4] * gv[4], w[5] * gv[5]); o.w = pk(w[6] * gv[6], w[7] * gv[7]);
            __builtin_nontemporal_store(o, (u32x4*)(c.WT + (size_t)(c.drow0 + n) * c.K + c.k0 + 8 * cc));
            if (c.gk) r1 = ((bflo(o.x) + bfhi(o.x)) + (bflo(o.y) + bfhi(o.y))) + ((bflo(o.z) + bfhi(o.z)) + (bflo(o.w) + bfhi(o.w)));
        }
        if (c.gk) {
            float r2 = 0.f;
#pragma unroll
            for (int e = 0; e < 8; ++e) r2 = fmaf(bv[e], w[e], r2);
            r1 += shx(r1, 1, lane); r1 += shx(r1, 2, lane); r1 += shx(r1, 4, lane);
            r2 += shx(r2, 1, lane); r2 += shx(r2, 2, lane); r2 += shx(r2, 4, lane);
            if (cc == 0) { c.p1[c.drow0 + n] = r1; c.p2[c.drow0 + n] = r2; }
        }
    }
    asm volatile("s_waitcnt lgkmcnt(0)" ::: "memory");
}
}

namespace mk {
typedef short bf16x8 __attribute__((ext_vector_type(8)));
#define MK_LAS __attribute__((address_space(3)))
#define MK_OPQF(name, val) float name = (val); asm volatile("" : "+v"(name))
__device__ __forceinline__ f32x4 mfma16(bf16x8 a, bf16x8 b, f32x4 c) { return __builtin_amdgcn_mfma_f32_16x16x32_bf16(a, b, c, 0, 0, 0); }
__device__ __forceinline__ s16x4 tr_rd(MK_LAS unsigned char* p) { return __builtin_bit_cast(s16x4, __builtin_amdgcn_ds_read_tr16_b64_v4i16((MK_LAS s16x4*)p)); }
__device__ __forceinline__ bf16x8 cat8(s16x4 a, s16x4 b) { return (bf16x8){a[0], a[1], a[2], a[3], b[0], b[1], b[2], b[3]}; }
__device__ __forceinline__ unsigned offb(unsigned row, unsigned ch) { return 256u * row + 16u * (ch ^ (((row & 3u) << 2) | ((row >> 2) & 3u))); }
__device__ __forceinline__ void glds16(const void* g, MK_LAS unsigned char* l) { __builtin_amdgcn_global_load_lds((const unsigned*)g, (MK_LAS unsigned*)l, 16, 0, 0); }
__device__ __forceinline__ void st_bf16(bf16_t* p, float v) { *p = (bf16_t)(pk(v, 0.f) & 0xffffu); }

struct AttnP { int b, h, gsel, r, nbk, kbeg, dsh; };
__device__ __forceinline__ AttnP attn_decode(int unit) {
    AttnP p; const int bh = unit / 48, rest = unit % 48, x = rest & 15; p.gsel = rest >> 4; p.b = bh >> 3; p.h = bh & 7; p.dsh = 2 * p.gsel;
    p.r = (p.gsel == 0) ? 0 : (p.gsel == 1 ? (x & 3) : x); p.nbk = (p.gsel == 0) ? x : (p.gsel == 1 ? (x >> 2) : 0); p.kbeg = (p.nbk == 0) ? 128 : 0; return p;
}
__device__ __forceinline__ void attn_stage(MK_LAS unsigned char* img, const bf16_t* Z, const AttnP& p, int coff, int wave, int lane) {
    const __amdgpu_buffer_rsrc_t rz = __builtin_amdgcn_make_buffer_rsrc((void*)Z, (short)0, 0x7fffffff, 0x00020000);
#pragma unroll
    for (int it = 0; it < 8; ++it) {
        const int inst = wave * 8 + it;
        if (inst * 4 >= p.kbeg) {
            const int row = 4 * inst + (lane >> 4), pc = lane & 15, ch = pc ^ (((row & 3) << 2) | ((row >> 2) & 3));
            const int t = ((128 * (p.nbk - 1) + row) << p.dsh) + p.r;
            const unsigned off = (unsigned)(((p.b * T + t) * INW + coff + p.h * 128 + ch * 8) * 2);
            __builtin_amdgcn_raw_ptr_buffer_load_lds(rz, (MK_LAS void*)(img + inst * 1024), 16, (int)off, 0, 0, 0);
        }
    }
}
__device__ __forceinline__ void attn_loadq(bf16x8 (&qf)[4], const bf16_t* Z, const AttnP& p, int wave, int lane) {
    const int qi = 16 * wave + (lane & 15);
    const bf16_t* qp = Z + ((size_t)p.b * T + (((128 * p.nbk + qi) << p.dsh) + p.r)) * INW + p.h * 128 + 8 * (lane >> 4);
#pragma unroll
    for (int ks = 0; ks < 4; ++ks) qf[ks] = *(const bf16x8*)(qp + 32 * ks);
}
#define MK_WAITBAR() do { asm volatile("s_waitcnt vmcnt(0) lgkmcnt(0)" ::: "memory"); __builtin_amdgcn_s_barrier(); asm volatile("" ::: "memory"); } while (0)
__device__ __forceinline__ void attn_phase(MK_LAS unsigned char* lds, const bf16_t* Z, bf16_t* OG, float* LSE, int first, int stride, int nunits, int wave, int lane) {
    asm volatile("" : "+v"(lane));
    MK_LAS unsigned char* KI = lds; MK_LAS unsigned char* VI = lds + 65536;
    const int fr = lane & 15, fq = lane >> 4, q4 = (lane & 15) >> 2, p4 = lane & 3;
    if (first >= nunits) return;
    AttnP p = attn_decode(first);
    bf16x8 qf[4];
    attn_stage(KI, Z, p, 1024, wave, lane);
    attn_loadq(qf, Z, p, wave, lane);
    const int s_lo = wave >> 1, s_hi = (wave >> 1) + 4;
    u32x4 dw[4]; float dl = 0.f; unsigned dofs = 0u, dlofs = 0u; bool dhave = false;
#define MK_ATTN_FLUSH() do { if (dhave) { _Pragma("unroll") for (int cp = 0; cp < 4; ++cp) *(u32x4*)(OG + dofs + 32 * cp) = dw[cp]; if (fq == 0) LSE[dlofs] = dl; } } while (0)
    for (int unit = first; unit < nunits; unit += stride) {
        const int qi = 16 * wave + fr;
        const size_t rowb = (size_t)p.b * T;
        MK_WAITBAR();
        asm volatile("" : "+v"(qf[0]), "+v"(qf[1]), "+v"(qf[2]), "+v"(qf[3]));
        attn_stage(VI, Z, p, 2048, wave, lane);
        MK_ATTN_FLUSH();
        f32x4 S[8][2];
        {
            unsigned kb[2][4];
#pragma unroll
            for (int u = 0; u < 2; ++u)
#pragma unroll
                for (int ks = 0; ks < 4; ++ks) kb[u][ks] = offb(8 * (fr >> 2) + 4 * u + (fr & 3), 4 * ks + fq);
#pragma unroll
            for (int s = 0; s < 8; ++s)
#pragma unroll
                for (int u = 0; u < 2; ++u) {
                    S[s][u] = (f32x4){0.f, 0.f, 0.f, 0.f};
                    if (32 * s >= p.kbeg && s >= s_lo && s <= s_hi) {
#pragma unroll
                        for (int ks = 0; ks < 4; ++ks) { const bf16x8 kf = *(const MK_LAS bf16x8*)(KI + kb[u][ks] + 8192 * s); S[s][u] = mfma16(kf, qf[ks], S[s][u]); }
                    }
                    asm volatile("" ::: "memory");
                }
        }
        MK_OPQF(sc2, 0.08838834764831845f * LOG2E); MK_OPQF(kneg, -1e30f); MK_OPQF(k128, 128.f);
        const float slope2 = __builtin_amdgcn_exp2f(-(float)(p.h + 1)) * LOG2E * (float)(1 << p.dsh);
        float mx = kneg;
        int qo = qi + 128 - 8 * fq; asm volatile("" : "+v"(qo));
        const float qof = (float)qo;
#pragma unroll
        for (int s = 0; s < 8; ++s) {
            const bool son = (32 * s >= p.kbeg) && s >= s_lo && s <= s_hi;
            if (!son) continue;
#pragma unroll
            for (int u = 0; u < 2; ++u)
#pragma unroll
                for (int i = 0; i < 4; ++i) {
                    const float dist = qof - (float)(32 * s + 4 * u + i);
                    const bool valid = son && (dist >= 0.f) && (dist <= k128);
                    const float v = valid ? (S[s][u][i] * sc2 - slope2 * dist) : kneg;
                    S[s][u][i] = v; mx = fmaxf(mx, v);
                }
        }
        mx = fmaxf(mx, shx(mx, 16, lane)); mx = fmaxf(mx, shx(mx, 32, lane));
        float l = 0.f;
        bf16x8 pf[8];
#pragma unroll
        for (int s = 0; s < 8; ++s) {
            if (!(32 * s >= p.kbeg && s >= s_lo && s <= s_hi)) { pf[s] = (bf16x8){0, 0, 0, 0, 0, 0, 0, 0}; continue; }
            float pp[8];
#pragma unroll
            for (int j = 0; j < 8; ++j) { pp[j] = __builtin_amdgcn_exp2f(S[s][j >> 2][j & 3] - mx); l += pp[j]; }
            u32x4 w; w.x = pk(pp[0], pp[1]); w.y = pk(pp[2], pp[3]); w.z = pk(pp[4], pp[5]); w.w = pk(pp[6], pp[7]);
            pf[s] = __builtin_bit_cast(bf16x8, w);
        }
        l += shx(l, 16, lane); l += shx(l, 32, lane);
        MK_WAITBAR();
        const AttnP pc = p;
        const int nu = unit + stride;
        if (nu < nunits) { p = attn_decode(nu); attn_stage(KI, Z, p, 1024, wave, lane); attn_loadq(qf, Z, p, wave, lane); }
        f32x4 O[8];
#pragma unroll
        for (int c = 0; c < 8; ++c) O[c] = (f32x4){0.f, 0.f, 0.f, 0.f};
        {
            unsigned vb[8][2];
            const unsigned vbase = (unsigned)(unsigned long long)VI;
#pragma unroll
            for (int c = 0; c < 8; ++c)
#pragma unroll
                for (int t2 = 0; t2 < 2; ++t2) vb[c][t2] = vbase + offb(8 * fq + q4 + 4 * t2, 4 * (c >> 1) + p4) + 8 * (c & 1);
#pragma unroll
            for (int s = 0; s < 8; ++s) {
                if (32 * s >= pc.kbeg && s >= s_lo && s <= s_hi) {
#pragma unroll
                    for (int ch = 0; ch < 2; ++ch) {
                        s16x4 va[4][2];
#pragma unroll
                        for (int c = 0; c < 4; ++c)
#pragma unroll
                            for (int t2 = 0; t2 < 2; ++t2) asm volatile("ds_read_b64_tr_b16 %0, %1 offset:%2" : "=v"(va[c][t2]) : "v"(vb[4 * ch + c][t2]), "n"(8192 * s));
                        asm volatile("s_waitcnt lgkmcnt(0)" : "+v"(va[0][0]), "+v"(va[0][1]), "+v"(va[1][0]), "+v"(va[1][1]), "+v"(va[2][0]), "+v"(va[2][1]), "+v"(va[3][0]), "+v"(va[3][1]));
#pragma unroll
                        for (int c = 0; c < 4; ++c) O[4 * ch + c] = mfma16(cat8(va[c][0], va[c][1]), pf[s], O[4 * ch + c]);
                    }
                }
                asm volatile("" ::: "memory");
            }
        }
        const float linv = 1.0f / l;
        {
            const int tq = ((128 * pc.nbk + qi) << pc.dsh) + pc.r;
            dofs = (unsigned)((size_t)pc.gsel * M * 1024 + (rowb + tq) * 1024 + pc.h * 128 + 8 * fq);
#pragma unroll
            for (int cp = 0; cp < 4; ++cp) { u32x4 w; w.x = pk(O[2 * cp][0] * linv, O[2 * cp][1] * linv); w.y = pk(O[2 * cp][2] * linv, O[2 * cp][3] * linv); w.z = pk(O[2 * cp + 1][0] * linv, O[2 * cp + 1][1] * linv); w.w = pk(O[2 * cp + 1][2] * linv, O[2 * cp + 1][3] * linv); dw[cp] = w; }
        }
        dlofs = (unsigned)((size_t)pc.gsel * M * 8 + (rowb + (((128 * pc.nbk + qi) << pc.dsh) + pc.r)) * 8 + pc.h);
        dl = (mx + __builtin_amdgcn_logf(l)) * (1.0f / LOG2E);
        dhave = true;
    }
    MK_ATTN_FLUSH();
#undef MK_ATTN_FLUSH
    asm volatile("s_waitcnt lgkmcnt(0)" ::: "memory"); __builtin_amdgcn_s_barrier(); asm volatile("" ::: "memory");
}

constexpr int KP = 144, VP = 320;
__device__ __forceinline__ void stage_rows64(MK_LAS unsigned char* img, const bf16_t* src0  , int tid, bool decay, float l2g) {
#pragma unroll
    for (int i = 0; i < 2; ++i) {
        const int idx = tid + 512 * i, row = idx >> 3, ch = idx & 7;
        u32x4 v = *(const u32x4*)(src0 + (size_t)row * INW + ch * 8);
        if (decay) {
            const float dc = __builtin_amdgcn_exp2f((float)(127 - row) * l2g);
            v.x = pk(bflo(v.x) * dc, bfhi(v.x) * dc); v.y = pk(bflo(v.y) * dc, bfhi(v.y) * dc); v.z = pk(bflo(v.z) * dc, bfhi(v.z) * dc); v.w = pk(bflo(v.w) * dc, bfhi(v.w) * dc);
        }
        *(MK_LAS u32x4*)(img + row * KP + ch * 16) = v;
    }
}
__device__ __forceinline__ void stage_rows128(MK_LAS unsigned char* img, const bf16_t* src0, int tid) {
#pragma unroll
    for (int i = 0; i < 4; ++i) {
        const int idx = tid + 512 * i, row = idx >> 4, ch = idx & 15;
        *(MK_LAS u32x4*)(img + row * VP + ch * 16) = *(const u32x4*)(src0 + (size_t)row * INW + ch * 8);
    }
}
__device__ __forceinline__ void retu_pair(MK_LAS unsigned char* lds, const bf16_t* Z, float* U, int u0, int u1, int tid, int wave, int lane) {
    asm volatile("" : "+v"(lane), "+v"(tid));
    const int half = wave >> 2, unit = half ? u1 : u0, ht = tid & 255, hw = wave & 3;
    MK_LAS unsigned char* KI = lds + half * 65536; MK_LAS unsigned char* VI = KI + 20480;
    const int bh = unit >> 4, c = unit & 15, b = bh >> 3, h = bh & 7;
    const float l2g = log2f(1.f - exp2f(-5.f - (float)h));
    const bf16_t* zr = Z + ((size_t)b * T + 128 * c) * INW;
    if (unit >= 0) {
        u32x4 kv[4], vv[8];
#pragma unroll
        for (int i = 0; i < 4; ++i) { const int idx = ht + 256 * i, row = idx >> 3, ch = idx & 7; kv[i] = *(const u32x4*)(zr + 3584 + h * 64 + (size_t)row * INW + ch * 8); }
#pragma unroll
        for (int i = 0; i < 8; ++i) { const int idx = ht + 256 * i, row = idx >> 4, ch = idx & 15; vv[i] = *(const u32x4*)(zr + 4096 + h * 128 + (size_t)row * INW + ch * 8); }
#pragma unroll
        for (int i = 0; i < 4; ++i) {
            const int idx = ht + 256 * i, row = idx >> 3, ch = idx & 7;
            const float dc = __builtin_amdgcn_exp2f((float)(127 - row) * l2g);
            u32x4 v = kv[i];
            v.x = pk(bflo(v.x) * dc, bfhi(v.x) * dc); v.y = pk(bflo(v.y) * dc, bfhi(v.y) * dc); v.z = pk(bflo(v.z) * dc, bfhi(v.z) * dc); v.w = pk(bflo(v.w) * dc, bfhi(v.w) * dc);
            *(MK_LAS u32x4*)(KI + row * KP + ch * 16) = v;
        }
#pragma unroll
        for (int i = 0; i < 8; ++i) { const int idx = ht + 256 * i, row = idx >> 4, ch = idx & 15; *(MK_LAS u32x4*)(VI + row * VP + ch * 16) = vv[i]; }
    }
    __syncthreads();
    if (unit >= 0) {
        const int fr = lane & 15, fq = lane >> 4, q4 = fr >> 2, p4 = lane & 3, rb = hw;
        f32x4 acc[8];
#pragma unroll
        for (int j = 0; j < 8; ++j) acc[j] = (f32x4){0.f, 0.f, 0.f, 0.f};
#pragma unroll
        for (int ks = 0; ks < 4; ++ks) {
            const int row0 = 32 * ks + 8 * fq + q4;
            const bf16x8 af = cat8(tr_rd(KI + row0 * KP + (16 * rb + 4 * p4) * 2), tr_rd(KI + (row0 + 4) * KP + (16 * rb + 4 * p4) * 2));
#pragma unroll
            for (int j = 0; j < 8; ++j) {
                const bf16x8 bf = cat8(tr_rd(VI + row0 * VP + (16 * j + 4 * p4) * 2), tr_rd(VI + (row0 + 4) * VP + (16 * j + 4 * p4) * 2));
                acc[j] = mfma16(af, bf, acc[j]);
            }
        }
        float* up = U + (size_t)unit * 8192;
#pragma unroll
        for (int j = 0; j < 8; ++j)
#pragma unroll
            for (int i = 0; i < 4; ++i) up[(16 * rb + 4 * fq + i) * 128 + 16 * j + fr] = acc[j][i];
    }
    __syncthreads();
}
__device__ __forceinline__ void retu_units(MK_LAS unsigned char* lds, const bf16_t* Z, float* U, int first, int stride, int nunits, int tid, int wave, int lane) {
    asm volatile("" : "+v"(lane), "+v"(tid));
    if (first >= nunits) return;
    MK_LAS unsigned char* KI = lds; MK_LAS unsigned char* VI = lds + 32768;
    u32x4 kv[2], vv[4];
#define MK_RETU_LOAD(unit_) do { const int bh_ = (unit_) >> 4, c_ = (unit_) & 15, b_ = bh_ >> 3, h_ = bh_ & 7; const bf16_t* zr_ = Z + ((size_t)b_ * T + 128 * c_) * INW; \
        _Pragma("unroll") for (int i = 0; i < 2; ++i) { const int idx = tid + 512 * i, row = idx >> 3, ch = idx & 7; kv[i] = *(const u32x4*)(zr_ + 3584 + h_ * 64 + (size_t)row * INW + ch * 8); } \
        _Pragma("unroll") for (int i = 0; i < 4; ++i) { const int idx = tid + 512 * i, row = idx >> 4, ch = idx & 15; vv[i] = *(const u32x4*)(zr_ + 4096 + h_ * 128 + (size_t)row * INW + ch * 8); } } while (0)
    MK_RETU_LOAD(first);
    for (int unit = first; unit < nunits; unit += stride) {
        const int h = (unit >> 4) & 7;
        const float l2g = log2f(1.f - exp2f(-5.f - (float)h));
#pragma unroll
        for (int i = 0; i < 2; ++i) {
            const int idx = tid + 512 * i, row = idx >> 3, ch = idx & 7;
            const float dc = __builtin_amdgcn_exp2f((float)(127 - row) * l2g);
            u32x4 v = kv[i];
            v.x = pk(bflo(v.x) * dc, bfhi(v.x) * dc); v.y = pk(bflo(v.y) * dc, bfhi(v.y) * dc); v.z = pk(bflo(v.z) * dc, bfhi(v.z) * dc); v.w = pk(bflo(v.w) * dc, bfhi(v.w) * dc);
            *(MK_LAS u32x4*)(KI + row * KP + ch * 16) = v;
        }
#pragma unroll
        for (int i = 0; i < 4; ++i) { const int idx = tid + 512 * i, row = idx >> 4, ch = idx & 15; *(MK_LAS u32x4*)(VI + row * VP + ch * 16) = vv[i]; }
        asm volatile("" ::: "memory");
        if (unit + stride < nunits) MK_RETU_LOAD(unit + stride);
        __syncthreads();
        const int fr = lane & 15, fq = lane >> 4, q4 = fr >> 2, p4 = lane & 3, rb = wave & 3, cb0 = 4 * (wave >> 2);
        f32x4 acc[4];
#pragma unroll
        for (int j = 0; j < 4; ++j) acc[j] = (f32x4){0.f, 0.f, 0.f, 0.f};
#pragma unroll
        for (int ks = 0; ks < 4; ++ks) {
            const int row0 = 32 * ks + 8 * fq + q4;
            const bf16x8 af = cat8(tr_rd(KI + row0 * KP + (16 * rb + 4 * p4) * 2), tr_rd(KI + (row0 + 4) * KP + (16 * rb + 4 * p4) * 2));
#pragma unroll
            for (int j = 0; j < 4; ++j) {
                const bf16x8 bf = cat8(tr_rd(VI + row0 * VP + (16 * (cb0 + j) + 4 * p4) * 2), tr_rd(VI + (row0 + 4) * VP + (16 * (cb0 + j) + 4 * p4) * 2));
                acc[j] = mfma16(af, bf, acc[j]);
            }
        }
        float* up = U + (size_t)unit * 8192;
#pragma unroll
        for (int j = 0; j < 4; ++j)
#pragma unroll
            for (int i = 0; i < 4; ++i) up[(16 * rb + 4 * fq + i) * 128 + 16 * (cb0 + j) + fr] = acc[j][i];
        __syncthreads();
    }
#undef MK_RETU_LOAD
}
struct NoJob { __device__ __forceinline__ void operator()() const {} };
template <class JPre = NoJob, class JPost = NoJob> __device__ __forceinline__ void reto_unit(MK_LAS unsigned char* lds, const bf16_t* Z, const float* U, bf16_t* MIX, const float* gng, const float* gnb, float* sfin  ,
                                          int unit, int tid, int wave, int lane, const JPre& jpre = JPre(), const JPost& jpost = JPost()) {
    asm volatile("" : "+v"(lane), "+v"(tid));
    const int pass = unit >> 8, idx = unit & 255, bh = (idx >> 3) , c = pass ? (idx & 7) : 15 - (idx & 7), b = bh >> 3, h = bh & 7;
    const float l2g = log2f(1.f - exp2f(-5.f - (float)h));
    const float G = __builtin_amdgcn_exp2f(128.f * l2g);
    const size_t row0g = (size_t)b * T + 128 * c;
    const bf16_t* zr = Z + row0g * INW;
    MK_LAS unsigned char* QI = lds; MK_LAS unsigned char* KI = lds + 18432; MK_LAS unsigned char* VI = lds + 36864; MK_LAS unsigned char* SI = lds + 77824;
    const float* ub = U + (size_t)bh * 16 * 8192;
    u32x4 qv[2], kv[2], vv[4];
#pragma unroll
    for (int i = 0; i < 2; ++i) { const int idx = tid + 512 * i, row = idx >> 3, ch = idx & 7; qv[i] = *(const u32x4*)(zr + 3072 + h * 64 + (size_t)row * INW + ch * 8); kv[i] = *(const u32x4*)(zr + 3584 + h * 64 + (size_t)row * INW + ch * 8); }
#pragma unroll
    for (int i = 0; i < 4; ++i) { const int idx = tid + 512 * i, row = idx >> 4, ch = idx & 15; vv[i] = *(const u32x4*)(zr + 4096 + h * 128 + (size_t)row * INW + ch * 8); }
    jpre();
    asm volatile("" ::: "memory");
    {
        f32x4 S[4];
#pragma unroll
        for (int k = 0; k < 4; ++k) S[k] = (f32x4){0.f, 0.f, 0.f, 0.f};
#pragma unroll 4
        for (int cc = 0; cc < c; ++cc) {
            f32x4 v[4];
#pragma unroll
            for (int k = 0; k < 4; ++k) v[k] = *(const f32x4*)(ub + (size_t)cc * 8192 + tid * 4 + 2048 * k);
#pragma unroll
            for (int k = 0; k < 4; ++k) S[k] = S[k] * G + v[k];
        }
#pragma unroll
        for (int k = 0; k < 4; ++k) {
            const int e = tid * 4 + 2048 * k;
            u32x2 w; w.x = pk(S[k][0], S[k][1]); w.y = pk(S[k][2], S[k][3]);
            *(MK_LAS u32x2*)(SI + (e >> 7) * VP + (e & 127) * 2) = w;
            if (c == 15) *(f32x4*)(sfin + (size_t)bh * 8192 + e) = S[k] * G + *(const f32x4*)(ub + (size_t)15 * 8192 + e);
        }
    }
    jpost();
#pragma unroll
    for (int i = 0; i < 2; ++i) { const int idx = tid + 512 * i, row = idx >> 3, ch = idx & 7; *(MK_LAS u32x4*)(QI + row * KP + ch * 16) = qv[i]; *(MK_LAS u32x4*)(KI + row * KP + ch * 16) = kv[i]; }
#pragma unroll
    for (int i = 0; i < 4; ++i) { const int idx = tid + 512 * i, row = idx >> 4, ch = idx & 15; *(MK_LAS u32x4*)(VI + row * VP + ch * 16) = vv[i]; }
    __syncthreads();
    const int fr = lane & 15, fq = lane >> 4, q4 = fr >> 2, p4 = lane & 3, i0 = 16 * wave, smax = wave >> 1;
    bf16x8 qf[2];
#pragma unroll
    for (int ks = 0; ks < 2; ++ks) qf[ks] = *(const MK_LAS bf16x8*)(QI + (i0 + fr) * KP + (32 * ks + 8 * fq) * 2);
    f32x4 O1[8], O2[8];
#pragma unroll
    for (int cb = 0; cb < 8; ++cb) { O1[cb] = (f32x4){0.f, 0.f, 0.f, 0.f}; O2[cb] = O1[cb]; }
    const int iq = i0 + fr;
#pragma unroll
    for (int s = 0; s < 4; ++s) {
        if (s <= smax) {
            float p[8];
#pragma unroll
            for (int u = 0; u < 2; ++u) {
                const int krow = 32 * s + 8 * (fr >> 2) + 4 * u + (fr & 3);
                f32x4 P = (f32x4){0.f, 0.f, 0.f, 0.f};
#pragma unroll
                for (int ks = 0; ks < 2; ++ks) { const bf16x8 kf = *(const MK_LAS bf16x8*)(KI + krow * KP + (32 * ks + 8 * fq) * 2); P = mfma16(kf, qf[ks], P); }
#pragma unroll
                for (int i = 0; i < 4; ++i) { const int kap = 32 * s + 8 * fq + 4 * u + i; p[4 * u + i] = (iq >= kap) ? P[i] * __builtin_amdgcn_exp2f((float)(iq - kap) * l2g) : 0.f; }
            }
            u32x4 w; w.x = pk(p[0], p[1]); w.y = pk(p[2], p[3]); w.z = pk(p[4], p[5]); w.w = pk(p[6], p[7]);
            const bf16x8 pfr = __builtin_bit_cast(bf16x8, w);
            const int row0 = 32 * s + 8 * fq + q4;
#pragma unroll
            for (int cb = 0; cb < 8; ++cb) {
                const int dch = (32 * (cb >> 1) + 8 * p4 + 4 * (cb & 1)) * 2;
                const bf16x8 vf = cat8(tr_rd(VI + row0 * VP + dch), tr_rd(VI + (row0 + 4) * VP + dch));
                O1[cb] = mfma16(vf, pfr, O1[cb]);
            }
        }
    }
#pragma unroll
    for (int ks = 0; ks < 2; ++ks) {
        const int row0 = 32 * ks + 8 * fq + q4;
#pragma unroll
        for (int cb = 0; cb < 8; ++cb) {
            const int dch = (32 * (cb >> 1) + 8 * p4 + 4 * (cb & 1)) * 2;
            const bf16x8 sf = cat8(tr_rd(SI + row0 * VP + dch), tr_rd(SI + (row0 + 4) * VP + dch));
            O2[cb] = mfma16(sf, qf[ks], O2[cb]);
        }
    }
    {
        const int il = i0 + fr;
        const float qd = __builtin_amdgcn_exp2f((float)(il + 1) * l2g);
        float s = 0.f;
#pragma unroll
        for (int cb = 0; cb < 8; ++cb) { O1[cb] = O1[cb] + qd * O2[cb]; s += (O1[cb][0] + O1[cb][1]) + (O1[cb][2] + O1[cb][3]); }
        s += shx(s, 16, lane); s += shx(s, 32, lane);
        const float mu = s * (1.f / 128.f);
        float q = 0.f;
#pragma unroll
        for (int cb = 0; cb < 8; ++cb)
#pragma unroll
            for (int i = 0; i < 4; ++i) { const float dd = O1[cb][i] - mu; q += dd * dd; }
        q += shx(q, 16, lane); q += shx(q, 32, lane);
        const float rstd = 1.0f / sqrtf(q * (1.f / 128.f) + GN_EPS);
        const size_t trow = row0g + il;
        u32x4 gzv[4]; f32x4 g0v[4], g1v[4], b0v[4], b1v[4];
#pragma unroll
        for (int cp = 0; cp < 4; ++cp) {
            const int dv = h * 128 + 32 * cp + 8 * fq;
            gzv[cp] = *(const u32x4*)(Z + trow * INW + 5120 + dv);
            g0v[cp] = *(const f32x4*)(gng + dv); g1v[cp] = *(const f32x4*)(gng + dv + 4); b0v[cp] = *(const f32x4*)(gnb + dv); b1v[cp] = *(const f32x4*)(gnb + dv + 4);
        }
        asm volatile("" ::: "memory");
#pragma unroll
        for (int cp = 0; cp < 4; ++cp) {
            const int dv = h * 128 + 32 * cp + 8 * fq;
            const u32x4 gz = gzv[cp];
            const f32x4 g0 = g0v[cp], g1 = g1v[cp], b0 = b0v[cp], b1 = b1v[cp];
            float r[8];
#pragma unroll
            for (int j = 0; j < 8; ++j) {
                const unsigned gw_ = gz[j >> 1];
                const float gbv = (j & 1) ? bfhi(gw_) : bflo(gw_);
                const float ov = O1[2 * cp + (j >> 2)][j & 3], gg = (j < 4) ? g0[j & 3] : g1[j & 3], bb = (j < 4) ? b0[j & 3] : b1[j & 3];
                r[j] = ((ov - mu) * rstd * gg + bb) * gbv * sigmoid_f(gbv);
            }
            u32x4 w; w.x = pk(r[0], r[1]); w.y = pk(r[2], r[3]); w.z = pk(r[4], r[5]); w.w = pk(r[6], r[7]);
            *(u32x4*)(MIX + trow * D + 1024 + dv) = w;
        }
    }
    __syncthreads();
}
struct CombRegs2 { u32x4 a[2][2], b[2][2], c[2][2]; float l0[2][2], l1[2][2], l2[2][2]; };
__device__ __forceinline__ void combine_load2(const bf16_t* __restrict__ OG, const float* __restrict__ LSE, int t0, int tstride, int lane, CombRegs2& R) {
#pragma unroll
    for (int r = 0; r < 2; ++r)
#pragma unroll
        for (int j = 0; j < 2; ++j) {
            const int t = t0 + r * tstride, c8 = lane + 64 * j, h = c8 >> 4;
            R.l0[r][j] = LSE[(size_t)t * 8 + h]; R.l1[r][j] = LSE[(size_t)M * 8 + (size_t)t * 8 + h]; R.l2[r][j] = LSE[(size_t)2 * M * 8 + (size_t)t * 8 + h];
            R.a[r][j] = *(const u32x4*)(OG + (size_t)t * 1024 + 8 * c8); R.b[r][j] = *(const u32x4*)(OG + (size_t)M * 1024 + (size_t)t * 1024 + 8 * c8); R.c[r][j] = *(const u32x4*)(OG + (size_t)2 * M * 1024 + (size_t)t * 1024 + 8 * c8);
        }
}
__device__ __forceinline__ void combine_finish2(bf16_t* __restrict__ MIX, int t0, int tstride, int lane, const CombRegs2& R) {
#pragma unroll
    for (int r = 0; r < 2; ++r)
#pragma unroll
        for (int j = 0; j < 2; ++j) {
            const int t = t0 + r * tstride, c8 = lane + 64 * j;
            const float mx = fmaxf(R.l0[r][j], fmaxf(R.l1[r][j], R.l2[r][j]));
            float w0 = __builtin_amdgcn_exp2f((R.l0[r][j] - mx) * LOG2E), w1 = __builtin_amdgcn_exp2f((R.l1[r][j] - mx) * LOG2E), w2 = __builtin_amdgcn_exp2f((R.l2[r][j] - mx) * LOG2E);
            const float inv = 1.0f / (w0 + w1 + w2); w0 *= inv; w1 *= inv; w2 *= inv;
            u32x4 o;
#pragma unroll
            for (int e = 0; e < 4; ++e) o[e] = pk(w0 * bflo(R.a[r][j][e]) + w1 * bflo(R.b[r][j][e]) + w2 * bflo(R.c[r][j][e]), w0 * bfhi(R.a[r][j][e]) + w1 * bfhi(R.b[r][j][e]) + w2 * bfhi(R.c[r][j][e]));
            *(u32x4*)(MIX + (size_t)t * D + 8 * c8) = o;
        }
}
template <int NR> __device__ __forceinline__ void combine_rows(const bf16_t* __restrict__ OG, const float* __restrict__ LSE, bf16_t* __restrict__ MIX, int t0, int tstride, int lane) {
    asm volatile("" : "+v"(lane));
    u32x4 a[NR][2], b[NR][2], c[NR][2]; float l0[NR][2], l1[NR][2], l2[NR][2];
#pragma unroll
    for (int r = 0; r < NR; ++r)
#pragma unroll
        for (int j = 0; j < 2; ++j) {
            const int t = t0 + r * tstride, c8 = lane + 64 * j, h = c8 >> 4;
            l0[r][j] = LSE[(size_t)t * 8 + h]; l1[r][j] = LSE[(size_t)M * 8 + (size_t)t * 8 + h]; l2[r][j] = LSE[(size_t)2 * M * 8 + (size_t)t * 8 + h];
            a[r][j] = *(const u32x4*)(OG + (size_t)t * 1024 + 8 * c8); b[r][j] = *(const u32x4*)(OG + (size_t)M * 1024 + (size_t)t * 1024 + 8 * c8); c[r][j] = *(const u32x4*)(OG + (size_t)2 * M * 1024 + (size_t)t * 1024 + 8 * c8);
        }
#pragma unroll
    for (int r = 0; r < NR; ++r)
#pragma unroll
        for (int j = 0; j < 2; ++j) {
            const int t = t0 + r * tstride, c8 = lane + 64 * j;
            const float mx = fmaxf(l0[r][j], fmaxf(l1[r][j], l2[r][j]));
            float w0 = __builtin_amdgcn_exp2f((l0[r][j] - mx) * LOG2E), w1 = __builtin_amdgcn_exp2f((l1[r][j] - mx) * LOG2E), w2 = __builtin_amdgcn_exp2f((l2[r][j] - mx) * LOG2E);
            const float inv = 1.0f / (w0 + w1 + w2); w0 *= inv; w1 *= inv; w2 *= inv;
            u32x4 o;
#pragma unroll
            for (int e = 0; e < 4; ++e) o[e] = pk(w0 * bflo(a[r][j][e]) + w1 * bflo(b[r][j][e]) + w2 * bflo(c[r][j][e]), w0 * bfhi(a[r][j][e]) + w1 * bfhi(b[r][j][e]) + w2 * bfhi(c[r][j][e]));
            *(u32x4*)(MIX + (size_t)t * D + 8 * c8) = o;
        }
}

__device__ __forceinline__ void ld8(const float* p, float (&v)[8]) { const f32x4 a = *(const f32x4*)p, b = *(const f32x4*)(p + 4); v[0] = a[0]; v[1] = a[1]; v[2] = a[2]; v[3] = a[3]; v[4] = b[0]; v[5] = b[1]; v[6] = b[2]; v[7] = b[3]; }
struct ABDirect { const float* src; int ld; __device__ __forceinline__ void val8(int row, int k0, float (&v)[8]) const { ld8(src + row * ld + k0, v); } };
struct ABResid {
    const float* ys; const float* sst; int ident; const float* g; const float* b; const float* rawp; float scale; int mode; const float* pws; const float* c1; const float* c2;
    __device__ __forceinline__ void val8(int row, int k0, float (&v)[8]) const {
        float y[8], rp[8]; ld8(ys + row * D + k0, y); ld8(rawp + row * D + k0, rp);
        float mu = 0.f, rs = 1.f;
        if (!ident) { mu = sst[2 * row]; rs = sst[2 * row + 1]; float gg[8], bb[8]; ld8(g + k0, gg); ld8(b + k0, bb);
#pragma unroll
            for (int e = 0; e < 8; ++e) y[e] = (y[e] - mu) * rs * gg[e] + bb[e]; }
        if (mode == 0) {
#pragma unroll
            for (int e = 0; e < 8; ++e) v[e] = __builtin_fmaf(ALPHA, y[e], scale * rp[e]);
        } else {
            float pp[8], a1[8], a2[8]; ld8(pws + row * D + k0, pp); ld8(c1 + k0, a1); ld8(c2 + k0, a2);
#pragma unroll
            for (int e = 0; e < 8; ++e) v[e] = __builtin_fmaf(ALPHA, y[e], pp[e] * sigmoid_f(__builtin_fmaf(rp[e] - mu * a1[e], rs, a2[e])));
        }
    }
};
struct ABSwi {
    const float* raw; const float* sst; int ident; const float* c1; const float* c2;
    __device__ __forceinline__ void val8(int row, int k0, float (&v)[8]) const {
        const int gi = 256 * (k0 >> 7) + (k0 & 127);
        float gg[8], uu[8]; ld8(raw + row * NUP + gi, gg); ld8(raw + row * NUP + gi + 128, uu);
        if (!ident) { const float mu = sst[2 * row], rs = sst[2 * row + 1]; float a1[8], a2[8], b1[8], b2[8]; ld8(c1 + gi, a1); ld8(c2 + gi, a2); ld8(c1 + gi + 128, b1); ld8(c2 + gi + 128, b2);
#pragma unroll
            for (int e = 0; e < 8; ++e) { gg[e] = (gg[e] - mu * a1[e]) * rs + a2[e]; uu[e] = (uu[e] - mu * b1[e]) * rs + b2[e]; } }
#pragma unroll
        for (int e = 0; e < 8; ++e) v[e] = gg[e] * uu[e] * sigmoid_f(gg[e]);
    }
};
template <int KS32, class AB, int NG = 1> __device__ __forceinline__ void skinny(const bf16_t* Wt, int N, float* raw, const AB& ab, MK_LAS float* red, int tid, int wave, int lane, int gfirst, int gstride) {
    asm volatile("" : "+v"(lane), "+v"(tid));
    constexpr int K = KS32 * 32 * 8;
    const int fr = lane & 15, fq = lane >> 4, k0 = wave * (KS32 * 32), ng = N >> 4;
    if (gfirst < 0 || gfirst >= ng) return;
    bf16x8 bfr[NG][KS32];
#pragma unroll
    for (int gi = 0; gi < NG; ++gi) {
        const int g = gfirst + gi * gstride;
        if (g < ng) {
            const bf16_t* wp0 = Wt + (size_t)(16 * g + fr) * K + k0 + 8 * fq;
#pragma unroll
            for (int s = 0; s < KS32; ++s) bfr[gi][s] = *(const bf16x8*)(wp0 + 32 * s);
        }
    }
    bf16x8 afr[KS32];
#pragma unroll
    for (int s = 0; s < KS32; ++s) {
        u32x4 w = (u32x4){0u, 0u, 0u, 0u};
        if (fr < 8) { float v[8]; ab.val8(fr, k0 + 32 * s + 8 * fq, v); w.x = pk(v[0], v[1]); w.y = pk(v[2], v[3]); w.z = pk(v[4], v[5]); w.w = pk(v[6], v[7]); }
        afr[s] = __builtin_bit_cast(bf16x8, w);
    }
    for (int g0 = gfirst; g0 < ng; g0 += NG * gstride) {
        if (g0 != gfirst) {
#pragma unroll
            for (int gi = 0; gi < NG; ++gi) {
                const int g = g0 + gi * gstride;
                if (g < ng) {
                    const bf16_t* wp = Wt + (size_t)(16 * g + fr) * K + k0 + 8 * fq;
#pragma unroll
                    for (int s = 0; s < KS32; ++s) bfr[gi][s] = *(const bf16x8*)(wp + 32 * s);
                }
            }
        }
#pragma unroll
        for (int gi = 0; gi < NG; ++gi) {
            if (g0 + gi * gstride < ng) {
                f32x4 acc = (f32x4){0.f, 0.f, 0.f, 0.f};
#pragma unroll
                for (int s = 0; s < KS32; ++s) acc = mfma16(afr[s], bfr[gi][s], acc);
                if (fq < 2) {
#pragma unroll
                    for (int i = 0; i < 4; ++i) red[(gi * 8 + wave) * 128 + (4 * fq + i) * 16 + fr] = acc[i];
                }
            }
        }
        __syncthreads();
        if (tid < NG * 128) {
            const int gi = tid >> 7, idx = tid & 127, g = g0 + gi * gstride;
            if (g < ng) {
                float s = 0.f;
#pragma unroll
                for (int w8 = 0; w8 < 8; ++w8) s += red[(gi * 8 + w8) * 128 + idx];
                raw[(size_t)(idx >> 4) * N + 16 * g + (idx & 15)] = s;
            }
        }
        __syncthreads();
    }
}
struct ABRaw8 { const unsigned char* src; };
template <int NS, class AB, int NG = 1, int UNR = 2, bool RAW8 = false> __device__ __forceinline__ void skinny8(const unsigned char* W8, int N, int K, float* raw, const AB& ab, float ascale, float oscale, MK_LAS unsigned char* lds, int tid, int wave, int lane, int gfirst, int gstride) {
    asm volatile("" : "+v"(lane), "+v"(tid));
    typedef int v8i __attribute__((ext_vector_type(8)));
    MK_LAS unsigned char* ai = lds;
    MK_LAS float* red = (MK_LAS float*)(lds + 49152);
    const int fr = lane & 15, fq = lane >> 4, ng = N >> 4, nst = K >> 7, base = nst >> 3, rem = nst & 7, k8n = K >> 3;
    const int cnt = base + (wave < rem ? 1 : 0), s0 = wave * base + (wave < rem ? wave : rem);
    if (gfirst < 0 || gfirst >= ng) return;
    v8i bfr[NG][NS];
#pragma unroll
    for (int gi = 0; gi < NG; ++gi) {
        const int g = gfirst + gi * gstride;
        const unsigned char* wp = W8 + (size_t)(16 * g + fr) * K + 128 * s0 + 32 * fq;
#pragma unroll
        for (int s = 0; s < NS; ++s) {
            if (g < ng && s < cnt) { const u32x4 b0 = *(const u32x4*)(wp + 128 * s), b1 = *(const u32x4*)(wp + 128 * s + 16); bfr[gi][s] = (v8i){(int)b0.x, (int)b0.y, (int)b0.z, (int)b0.w, (int)b1.x, (int)b1.y, (int)b1.z, (int)b1.w}; }
            else bfr[gi][s] = (v8i){0, 0, 0, 0, 0, 0, 0, 0};
        }
    }
    if constexpr (RAW8) {
        u32x4 cp[6];
#pragma unroll
        for (int j = 0; j < 6; ++j) { const int it = tid + j * NTHR; if (16 * it < 8 * K) cp[j] = *(const u32x4*)(ab.src + 16 * it); }
#pragma unroll
        for (int j = 0; j < 6; ++j) { const int it = tid + j * NTHR; if (16 * it < 8 * K) *(MK_LAS u32x4*)(ai + 16 * it) = cp[j]; }
    } else
    for (int it0 = tid; it0 < K; it0 += UNR * NTHR) {
        float v[UNR][8];
#pragma unroll
        for (int j = 0; j < UNR; ++j) { const int it = it0 + j * NTHR; if (it < K) { const int row = it / k8n, k8 = it - row * k8n; if constexpr (!RAW8) ab.val8(row, 8 * k8, v[j]); } }
#pragma unroll
        for (int j = 0; j < UNR; ++j) {
            const int it = it0 + j * NTHR;
            if (it < K) { const int row = it / k8n, k8 = it - row * k8n;
                u32x2 w; w.x = pk8(v[j][0] * ascale, v[j][1] * ascale, v[j][2] * ascale, v[j][3] * ascale); w.y = pk8(v[j][4] * ascale, v[j][5] * ascale, v[j][6] * ascale, v[j][7] * ascale);
                *(MK_LAS u32x2*)(ai + row * K + 8 * k8) = w; }
        }
    }
    __syncthreads();
    v8i afr[NS];
#pragma unroll
    for (int s = 0; s < NS; ++s) {
        afr[s] = (v8i){0, 0, 0, 0, 0, 0, 0, 0};
        if (fr < 8 && s < cnt) { const MK_LAS unsigned char* ap = ai + fr * K + 128 * (s0 + s) + 32 * fq; const u32x4 a0 = *(const MK_LAS u32x4*)ap, a1 = *(const MK_LAS u32x4*)(ap + 16);
            afr[s] = (v8i){(int)a0.x, (int)a0.y, (int)a0.z, (int)a0.w, (int)a1.x, (int)a1.y, (int)a1.z, (int)a1.w}; }
    }
    for (int g0 = gfirst; g0 < ng; g0 += NG * gstride) {
        if (g0 != gfirst) {
#pragma unroll
            for (int gi = 0; gi < NG; ++gi) {
                const int g = g0 + gi * gstride;
                const unsigned char* wp = W8 + (size_t)(16 * g + fr) * K + 128 * s0 + 32 * fq;
#pragma unroll
                for (int s = 0; s < NS; ++s) {
                    if (g < ng && s < cnt) { const u32x4 b0 = *(const u32x4*)(wp + 128 * s), b1 = *(const u32x4*)(wp + 128 * s + 16); bfr[gi][s] = (v8i){(int)b0.x, (int)b0.y, (int)b0.z, (int)b0.w, (int)b1.x, (int)b1.y, (int)b1.z, (int)b1.w}; }
                    else bfr[gi][s] = (v8i){0, 0, 0, 0, 0, 0, 0, 0};
                }
            }
        }
#pragma unroll
        for (int gi = 0; gi < NG; ++gi) {
            if (g0 + gi * gstride < ng) {
                f32x4 acc = (f32x4){0.f, 0.f, 0.f, 0.f};
#pragma unroll
                for (int s = 0; s < NS; ++s) acc = __builtin_amdgcn_mfma_scale_f32_16x16x128_f8f6f4(afr[s], bfr[gi][s], acc, 0, 0, 0, 0x7F7F7F7F, 0, 0x7F7F7F7F);
                if (fq < 2) {
#pragma unroll
                    for (int i = 0; i < 4; ++i) red[(gi * 8 + wave) * 128 + (4 * fq + i) * 16 + fr] = acc[i];
                }
            }
        }
        __syncthreads();
        if (tid < NG * 128) {
            const int gi = tid >> 7, idx = tid & 127, g = g0 + gi * gstride;
            if (g < ng) {
                float s = 0.f;
#pragma unroll
                for (int w8 = 0; w8 < 8; ++w8) s += red[(gi * 8 + w8) * 128 + idx];
                raw[(size_t)(idx >> 4) * N + 16 * g + (idx & 15)] = s * oscale;
            }
        }
        __syncthreads();
    }
}
template <class AB> __device__ __forceinline__ void skinny8_swi(const unsigned char* W8, const AB& ab, int ident, const float* c1, const float* c2, unsigned char* HS, MK_LAS unsigned char* lds, int tid, int wave, int lane, int bx) {
    asm volatile("" : "+v"(lane), "+v"(tid));
    typedef int v8i __attribute__((ext_vector_type(8)));
    constexpr int K = D, NS = 2, NG = 4, NP = NUP / 32;
    MK_LAS unsigned char* ai = lds;
    MK_LAS float* stp = (MK_LAS float*)(lds + 16384);
    MK_LAS float* stt = (MK_LAS float*)(lds + 16384 + 512);
    MK_LAS float* zt = (MK_LAS float*)(lds + 20480);
    MK_LAS float* red = (MK_LAS float*)(lds + 49152);
    const int fr = lane & 15, fq = lane >> 4, s0 = wave * 2;
    v8i bfr[NG][NS];
#pragma unroll
    for (int gi = 0; gi < NG; ++gi) {
        const int p = bx + 256 * (gi >> 1), g = 16 * (p >> 3) + (p & 7) + 8 * (gi & 1);
        const unsigned char* wp = W8 + (size_t)(16 * g + fr) * K + 128 * s0 + 32 * fq;
#pragma unroll
        for (int s = 0; s < NS; ++s) {
            if (p < NP) { const u32x4 b0 = *(const u32x4*)(wp + 128 * s), b1 = *(const u32x4*)(wp + 128 * s + 16); bfr[gi][s] = (v8i){(int)b0.x, (int)b0.y, (int)b0.z, (int)b0.w, (int)b1.x, (int)b1.y, (int)b1.z, (int)b1.w}; }
            else bfr[gi][s] = (v8i){0, 0, 0, 0, 0, 0, 0, 0};
        }
    }
    {
        float v[4][8];
#pragma unroll
        for (int j = 0; j < 4; ++j) ab.val8((tid >> 8) + 2 * j, 8 * (tid & 255), v[j]);
#pragma unroll
        for (int j = 0; j < 4; ++j) {
            float sm = 0.f, sq = 0.f;
#pragma unroll
            for (int e = 0; e < 8; ++e) { sm += v[j][e]; sq += v[j][e] * v[j][e]; }
#pragma unroll
            for (int o = 32; o > 0; o >>= 1) { sm += shx(sm, o, lane); sq += shx(sq, o, lane); }
            if (lane == 0) { stp[(wave * 4 + j) * 2] = sm; stp[(wave * 4 + j) * 2 + 1] = sq; }
            u32x2 w; w.x = pk8(v[j][0], v[j][1], v[j][2], v[j][3]); w.y = pk8(v[j][4], v[j][5], v[j][6], v[j][7]);
            *(MK_LAS u32x2*)(ai + ((tid >> 8) + 2 * j) * K + 8 * (tid & 255)) = w;
        }
    }
    __syncthreads();
    if (tid < 8) {
        float sm = 0.f, sq = 0.f;
#pragma unroll
        for (int w4 = 0; w4 < 4; ++w4) { sm += stp[((4 * (tid & 1) + w4) * 4 + (tid >> 1)) * 2]; sq += stp[((4 * (tid & 1) + w4) * 4 + (tid >> 1)) * 2 + 1]; }
        const float mu = sm * (1.f / 2048.f), var = fmaxf(sq * (1.f / 2048.f) - mu * mu, 0.f);
        stt[2 * tid] = mu; stt[2 * tid + 1] = 1.0f / sqrtf(var + LN_EPS);
    }
    v8i afr[NS];
#pragma unroll
    for (int s = 0; s < NS; ++s) {
        afr[s] = (v8i){0, 0, 0, 0, 0, 0, 0, 0};
        if (fr < 8) { const MK_LAS unsigned char* ap = ai + fr * K + 128 * (s0 + s) + 32 * fq; const u32x4 a0 = *(const MK_LAS u32x4*)ap, a1 = *(const MK_LAS u32x4*)(ap + 16);
            afr[s] = (v8i){(int)a0.x, (int)a0.y, (int)a0.z, (int)a0.w, (int)a1.x, (int)a1.y, (int)a1.z, (int)a1.w}; }
    }
#pragma unroll
    for (int gi = 0; gi < NG; ++gi) {
        if (bx + 256 * (gi >> 1) < NP) {
            f32x4 acc = (f32x4){0.f, 0.f, 0.f, 0.f};
#pragma unroll
            for (int s = 0; s < NS; ++s) acc = __builtin_amdgcn_mfma_scale_f32_16x16x128_f8f6f4(afr[s], bfr[gi][s], acc, 0, 0, 0, 0x7F7F7F7F, 0, 0x7F7F7F7F);
            if (fq < 2) {
#pragma unroll
                for (int i = 0; i < 4; ++i) red[(gi * 8 + wave) * 128 + (4 * fq + i) * 16 + fr] = acc[i];
            }
        }
    }
    __syncthreads();
    const int gi = tid >> 7, idx = tid & 127, p = bx + 256 * (gi >> 1), r = idx >> 4;
    if (p < NP) {
        float sm = 0.f;
#pragma unroll
        for (int w8 = 0; w8 < 8; ++w8) sm += red[(gi * 8 + w8) * 128 + idx];
        MK_OPQF(kinv, 1.f / W8S);
        const float val = sm * kinv;
        const int col = 16 * (16 * (p >> 3) + (p & 7) + 8 * (gi & 1)) + (idx & 15);
        zt[gi * 128 + idx] = ident ? val : (val - stt[2 * r] * c1[col]) * stt[2 * r + 1] + c2[col];
    }
    __syncthreads();
    if (p < NP && (gi & 1) == 0) {
        const float gg = zt[gi * 128 + idx], uu = zt[(gi + 1) * 128 + idx];
        const float h = gg * uu * sigmoid_f(gg) * H8S;
        HS[(size_t)r * FF + (p >> 3) * 128 + 16 * (p & 7) + (idx & 15)] = (unsigned char)(pk8(h, 0.f, 0.f, 0.f) & 0xffu);
    }
}
template <class AB> __device__ __forceinline__ void smp_update(const AB& ab, float* ysn, float* sstn, int wave, int lane) {
    float s = 0.f, q = 0.f;
    float vall[4][8];
#pragma unroll
    for (int j = 0; j < 4; ++j) ab.val8(wave, lane * 8 + 512 * j, vall[j]);
    asm volatile("" ::: "memory");
#pragma unroll
    for (int j = 0; j < 4; ++j) {
        const int kb = lane * 8 + 512 * j;
        float (&v)[8] = vall[j];
        *(f32x4*)(ysn + wave * D + kb) = (f32x4){v[0], v[1], v[2], v[3]}; *(f32x4*)(ysn + wave * D + kb + 4) = (f32x4){v[4], v[5], v[6], v[7]};
#pragma unroll
        for (int e = 0; e < 8; ++e) { s += v[e]; q += v[e] * v[e]; }
    }
#pragma unroll
    for (int o = 32; o > 0; o >>= 1) { s += shx(s, o, lane); q += shx(q, o, lane); }
    if (lane == 0) { const float mu = s * (1.f / 2048.f); const float var = fmaxf(q * (1.f / 2048.f) - mu * mu, 0.f); sstn[2 * wave] = mu; sstn[2 * wave + 1] = 1.0f / sqrtf(var + LN_EPS); }
}
struct ZsFold { const float* raw; const float* sst; const float* c1; const float* c2;
    __device__ __forceinline__ float operator()(int b, int col) const { return (raw[b * INW + col] - sst[2 * b] * c1[col]) * sst[2 * b + 1] + c2[col]; } };
__device__ __forceinline__ void smp_attn(MK_LAS float* ls, const ZsFold& zf, const float* ck, const float* cv, float* ap, float* kout, float* vout, int task, int tid, int wave, int lane) {
    asm volatile("" : "+v"(lane), "+v"(tid));
    const int b = task / 24, h = (task % 24) / 3, g = task % 3, dd = 1 << (2 * g);
    MK_LAS float* qs = ls; MK_LAS float* sc = ls + 128; MK_LAS float* kn = ls + 384; MK_LAS float* vn = ls + 512; MK_LAS float* po = ls + 640;
    const int d = tid & 127, part = tid >> 7;
    f32x2 kk[17]; float vv[33];
#pragma unroll
    for (int i = 0; i < 17; ++i) { const int j = wave + 8 * i; kk[i] = (j >= 1 && j < 129) ? *(const f32x2*)(ck + (((size_t)b * 2048 + (2048 - j * dd)) * 8 + h) * 128 + 2 * lane) : (f32x2){0.f, 0.f}; }
#pragma unroll
    for (int i = 0; i < 33; ++i) { const int j = part + 4 * i; vv[i] = (j >= 1 && j < 129) ? cv[(((size_t)b * 2048 + (2048 - j * dd)) * 8 + h) * 128 + d] : 0.f; }
    if (tid < 128) { qs[tid] = zf(b, h * 128 + tid); const float kv = zf(b, 1024 + h * 128 + tid), vv = zf(b, 2048 + h * 128 + tid); kn[tid] = kv; vn[tid] = vv;
        if (g == 0) { kout[b * 1024 + h * 128 + tid] = kv; vout[b * 1024 + h * 128 + tid] = vv; } }
    __syncthreads();
    const float slope = __builtin_amdgcn_exp2f(-(float)(h + 1));
    {
        if (wave == 0) kk[0] = (f32x2){kn[2 * lane], kn[2 * lane + 1]};
        const float q0 = qs[2 * lane], q1 = qs[2 * lane + 1];
        MK_OPQF(kscale, 0.08838834764831845f);
#pragma unroll
        for (int i = 0; i < 17; ++i) {
            const int j = wave + 8 * i;
            float dot = q0 * kk[i].x + q1 * kk[i].y;
#pragma unroll
            for (int o = 32; o > 0; o >>= 1) dot += shx(dot, o, lane);
            if (lane == 0 && j < 129) sc[j] = __builtin_fmaf(dot, kscale, -slope * (float)(j * dd));
        }
    }
    __syncthreads();
    float mx = -1e30f;
    for (int j = 0; j < 129; ++j) mx = fmaxf(mx, sc[j]);
    float l = 0.f;
    for (int j = 0; j < 129; ++j) l += __expf(sc[j] - mx);
    float o = 0.f;
    {
        if (part == 0) vv[0] = vn[d];
#pragma unroll
        for (int i = 0; i < 33; ++i) { const int j = part + 4 * i; if (j < 129) o = fmaf(__expf(sc[j] - mx), vv[i], o); }
    }
    po[part * 128 + d] = o;
    __syncthreads();
    if (tid < 128) { ap[task * 136 + 8 + tid] = (po[tid] + po[128 + tid]) + (po[256 + tid] + po[384 + tid]); if (tid == 0) { ap[task * 136] = mx; ap[task * 136 + 1] = l; } }
    __syncthreads();
}
__device__ __forceinline__ void smp_ret(MK_LAS float* ls, const ZsFold& zf, const float* s0, float* sout, const float* gng, const float* gnb, float* mixs, int task, int tid) {
    asm volatile("" : "+v"(tid));
    const int b = task >> 3, h = task & 7;
    MK_LAS float* qs = ls; MK_LAS float* ks = ls + 64; MK_LAS float* po = ls + 128; MK_LAS float* os = ls + 640;
    const int e = tid & 127, part = tid >> 7;
    float s0v[16];
#pragma unroll
    for (int i = 0; i < 16; ++i) s0v[i] = s0[(((size_t)b * 8 + h) * 64 + 16 * part + i) * 128 + e];
    if (tid < 64) qs[tid] = zf(b, 3072 + h * 64 + tid);
    else if (tid < 128) ks[tid - 64] = zf(b, 3584 + h * 64 + (tid - 64)) * 0.125f;
    __syncthreads();
    const float gam = 1.f - __builtin_amdgcn_exp2f(-5.f - (float)h);
    const float v = zf(b, 4096 + h * 128 + e);
    float o = 0.f;
#pragma unroll
    for (int i = 0; i < 16; ++i) {
        const int dk = 16 * part + i; const size_t idx = (((size_t)b * 8 + h) * 64 + dk) * 128 + e;
        const float sn = fmaf(gam, s0v[i], ks[dk] * v);
        sout[idx] = sn; o = fmaf(qs[dk], sn, o);
    }
    po[part * 128 + e] = o;
    __syncthreads();
    if (tid < 128) os[tid] = (po[tid] + po[128 + tid]) + (po[256 + tid] + po[384 + tid]);
    __syncthreads();
    if (tid < 128) {
        float s = 0.f;
        for (int i = 0; i < 128; ++i) s += os[i];
        const float mu = s * (1.f / 128.f); float q = 0.f;
        for (int i = 0; i < 128; ++i) { const float dd = os[i] - mu; q += dd * dd; }
        const float rstd = 1.0f / sqrtf(q * (1.f / 128.f) + GN_EPS);
        const int c = h * 128 + tid; const float gbv = zf(b, 5120 + c);
        mixs[b * D + 1024 + c] = ((os[tid] - mu) * rstd * gng[c] + gnb[c]) * gbv * sigmoid_f(gbv);
    }
    __syncthreads();
}
}

namespace mk {
struct Args { const float* in[21]; float* out; unsigned char* ws; int nl; int stop; int rep; int pad; };
static_assert(sizeof(Args) == 21 * 8 + 8 + 8 + 16, "Args has no padding");

__global__ void __launch_bounds__(NTHR, 2) mega(Args a) {
    extern __shared__ __attribute__((aligned(16))) unsigned char lds_raw[];
    MK_LAS unsigned char* lds = (MK_LAS unsigned char*)lds_raw;
    int wave = __builtin_amdgcn_readfirstlane((int)threadIdx.x >> 6);
    int lane = (int)__builtin_amdgcn_mbcnt_hi(~0u, __builtin_amdgcn_mbcnt_lo(~0u, 0u)), tid = wave * 64 + lane;
    int G = gridDim.x, bx = blockIdx.x;
#define OPAQUE_IDS() do { unsigned z_ = 0u; asm volatile("" : "+s"(z_)); lane = (int)__builtin_amdgcn_mbcnt_hi(~0u, __builtin_amdgcn_mbcnt_lo(~0u, z_)); tid = wave * 64 + lane; asm volatile("" : "+v"(tid), "+v"(lane), "+s"(wave), "+s"(G), "+s"(bx), "+s"(KP)); } while (0)
    for (int u = tid; u < (LDS_BYTES - RING_BYTES) / 4; u += NTHR) ((MK_LAS unsigned*)(lds + RING_BYTES))[u] = 0u;
    __syncthreads();
    typedef const __attribute__((address_space(4))) Args* KArgs;
    KArgs KP = (KArgs)__builtin_amdgcn_kernarg_segment_ptr();
#define ws (KP->ws)
#define out (KP->out)
#define x_prompt (KP->in[0])
#define x_sample (KP->in[1])
#define cache_k (KP->in[2])
#define cache_v (KP->in[3])
#define state_ret (KP->in[4])
#define p_prompt (KP->in[5])
#define p_sample (KP->in[6])
#define w_in (KP->in[7])
#define w_out (KP->in[8])
#define gn_g (KP->in[9])
#define gn_b (KP->in[10])
#define f1w1 (KP->in[11])
#define f1w3 (KP->in[12])
#define f1w2 (KP->in[13])
#define f2w1 (KP->in[14])
#define f2w3 (KP->in[15])
#define f2w2 (KP->in[16])
#define w_ple (KP->in[17])
#define w_gate (KP->in[18])
#define ln_g (KP->in[19])
#define ln_b (KP->in[20])
#define STATS ((float*)(ws + WS_STATS))
#define CV ((float*)(ws + WS_CV))
#define SMP ((float*)(ws + WS_SMP))
#define PART ((float*)(ws + WS_PART))
#define WB ((bf16_t*)(ws + WS_W))
#define YB ((bf16_t*)(ws + WS_YB))
#define Y8 ((unsigned char*)(ws + WS_Y))
#define H ((unsigned char*)(ws + WS_H))
#define Z ((bf16_t*)(ws + WS_Z))
#define MIX ((bf16_t*)(ws + WS_MIX))
#define OG ((bf16_t*)(ws + WS_OG))
#define LSE ((float*)(ws + WS_LSE))
#define U ((float*)(ws + WS_U))
#define PB ((bf16_t*)(ws + WS_PB))
#define PW ((bf16_t*)(ws + WS_PW))
#define YS (SMP + SM_YS)
#define SST (SMP + SM_ST)
#define RUP (SMP + SM_RUP)
#define RDA (SMP + SM_RD)
#define RIN (SMP + SM_RIN)
#define MIXS (SMP + SM_MIX)
#define AP (SMP + SM_AP)
#define PWS (SMP + SM_PWS)
#define RDB (SMP + SM_RDB)
#define HSS ((unsigned char*)(SMP + SM_HS))
#define YBDUM ((bf16_t*)(ws + WS_END + (size_t)M * D * 4))
#define STDUM ((float*)(ws + WS_END + (size_t)M * D * 6))
    XcdBarrier bar = xcd_barrier_post((unsigned*)(ws + WS_CTL) + 4096, (volatile LAS unsigned*)(lds + MISC_OFF) + 8);
    MK_LAS float* red = (MK_LAS float*)lds;
#if defined(MK_STAMP)
    int nstamp = 1; if (bx == 0 && tid == 0) ((unsigned long long*)(ws + WS_CTL + 524288))[0] = __builtin_amdgcn_s_memrealtime();
#endif
#define gw (bx * NWAVES + wave)
#define NGW (G * NWAVES)
#define gt (bx * NTHR + tid)
#define GT (G * NTHR)
#define LNG(l, i) (ln_g + ((size_t)(l) * 4 + (i)) * D)
#define LNB(l, i) (ln_b + ((size_t)(l) * 4 + (i)) * D)
#define CV1(l, off) (CV + ((size_t)(l) * 2 + 0) * NCV + (off))
#define CV2(l, off) (CV + ((size_t)(l) * 2 + 1) * NCV + (off))
#define WL(l, off) (WB + (size_t)(l) * LW + (off))
#if defined(MK_STAMP)
#define GRID_BAR() do { xcd_barrier(bar); if (bx == 0 && tid == 0) { ((unsigned long long*)(ws + WS_CTL + 524288))[nstamp] = __builtin_amdgcn_s_memrealtime(); } ++nstamp; } while (0)
#else
#if defined(MK_PROBE)
#define GRID_BAR() do { xcd_barrier(bar); if ((KP->rep >> 15) & 1) xcd_barrier(bar); } while (0)
#else
#define GRID_BAR() xcd_barrier(bar)
#endif
#endif
#define RUNP(id) (KP->stop == 0 || (id) < KP->stop)
#if defined(MK_PROBE)
#if defined(MK_PROBE_KIND)
#define REPS(kind) for (int rep_ = 0, nrep_ = ((kind) == MK_PROBE_KIND && ((KP->rep >> (kind)) & 1)) ? 2 : 1; rep_ < nrep_; ++rep_)
#else
#define REPS(kind) for (int rep_ = 0, nrep_ = ((KP->rep >> (kind)) & 1) ? 2 : 1; rep_ < nrep_; ++rep_)
#endif
#define REPBAR() do { OPAQUE_IDS(); if (rep_) GRID_BAR(); } while (0)
#define DUMSEL (nrep_ == 2 && rep_ == 0)
#else
#define REPS(kind)
#define REPBAR() do { } while (0)
#define DUMSEL false
#endif

    REPS(10) {
        REPBAR();
        MK_LAS float* scr = (MK_LAS float*)(lds + wave * 16384);
        constexpr int IPL = 44288, NIT = DEPTH * IPL;
#define TR_DECODE(it_, c_) do { \
            const int l = (it_) / IPL; int r = (it_) % IPL; \
            const float* W; int K = D, N; size_t woff; int kind = 0, lnl = -1, lni = 0, cvoff = 0, f8 = 0;     \
            if (r < 5632) { W = f1w1 + (size_t)l * D * FF; N = FF; woff = W_UP1; kind = 1; lnl = l - 1; lni = 3; cvoff = CV_UP1; f8 = 1; } \
            else if ((r -= 5632) < 5632) { W = f1w3 + (size_t)l * D * FF; N = FF; woff = W_UP1; kind = 2; lnl = l - 1; lni = 3; cvoff = CV_UP1; f8 = 1; } \
            else if ((r -= 5632) < 5632) { W = f1w2 + (size_t)l * FF * D; K = FF; N = D; woff = W_DN1; f8 = 1; } \
            else if ((r -= 5632) < 6144) { W = w_in + (size_t)l * D * INW; N = INW; woff = W_IN; lnl = l; lni = 0; cvoff = CV_IN; } \
            else if ((r -= 6144) < 2048) { W = w_out + (size_t)l * D * D; N = D; woff = W_OUT; } \
            else if ((r -= 2048) < 5632) { W = f2w1 + (size_t)l * D * FF; N = FF; woff = W_UP2; kind = 1; lnl = l; lni = 1; cvoff = CV_UP2; f8 = 1; } \
            else if ((r -= 5632) < 5632) { W = f2w3 + (size_t)l * D * FF; N = FF; woff = W_UP2; kind = 2; lnl = l; lni = 1; cvoff = CV_UP2; f8 = 1; } \
            else if ((r -= 5632) < 5632) { W = f2w2 + (size_t)l * FF * D; K = FF; N = D; woff = W_DN2; f8 = 1; } \
            else if ((r -= 5632) < 2048) { W = w_gate + (size_t)l * D * D; N = D; woff = W_GATE; lnl = l; lni = 2; cvoff = CV_GATE; } \
            else { r -= 2048; W = w_ple + (size_t)l * PLE * D; K = PLE; N = D; woff = W_PLE; } \
            const int nblk = N >> 5, kb = r / nblk, nb = r % nblk, n0 = nb * 32; \
            (c_).W = W; (c_).WT = WL(l, woff); (c_).K = K; (c_).N = N; (c_).n0 = n0; (c_).k0 = kb * 64; (c_).f8 = f8; \
            (c_).drow0 = (kind == 0) ? n0 : (256 * (n0 >> 7) + (n0 & 127) + (kind == 2 ? 128 : 0)); \
            (c_).gk = nullptr; (c_).bk = nullptr; if (lnl >= 0) { (c_).gk = LNG(lnl, lni); (c_).bk = LNB(lnl, lni); } \
            (c_).p1 = PART + (((size_t)l * 2 + 0) * 32 + kb) * NCV + cvoff; (c_).p2 = PART + (((size_t)l * 2 + 1) * 32 + kb) * NCV + cvoff; } while (0)
        {
            TrCtx cA, cB; float wA[32], gA[8], bA[8], wB[32], gB[8], bB[8];
            int it = gw; bool vA = it < NIT;
            if (vA) { TR_DECODE(it, cA); tr_load(cA, lane, wA, gA, bA); }
            while (vA) {
                const int itB = it + NGW; const bool vB = itB < NIT;
                if (vB) { TR_DECODE(itB, cB); tr_load(cB, lane, wB, gB, bB); }
                tr_proc(cA, scr, lane, wA, gA, bA);
                if (!vB) break;
                it = itB + NGW; vA = it < NIT;
                if (vA) { TR_DECODE(it, cA); tr_load(cA, lane, wA, gA, bA); }
                tr_proc(cB, scr, lane, wB, gB, bB);
            }
        }
#undef TR_DECODE
        for (int i0 = gt; i0 < M * D / 4; i0 += 8 * GT) {
            f32x4 v[8];
#pragma unroll
            for (int j = 0; j < 8; ++j) { const int i = i0 + j * GT; v[j] = (i < M * D / 4) ? __builtin_nontemporal_load((const f32x4*)x_prompt + i) : (f32x4){0.f, 0.f, 0.f, 0.f}; }
#pragma unroll
            for (int j = 0; j < 8; ++j) { const int i = i0 + j * GT; if (i < M * D / 4) ((unsigned*)Y8)[i] = pk8(v[j][0], v[j][1], v[j][2], v[j][3]); }
        }
        for (int i0 = gt; i0 < DEPTH * M * PLE / 4; i0 += 8 * GT) {
            f32x4 v[8];
#pragma unroll
            for (int j = 0; j < 8; ++j) { const int i = i0 + j * GT; v[j] = (i < DEPTH * M * PLE / 4) ? __builtin_nontemporal_load((const f32x4*)p_prompt + i) : (f32x4){0.f, 0.f, 0.f, 0.f}; }
#pragma unroll
            for (int j = 0; j < 8; ++j) { const int i = i0 + j * GT; if (i < DEPTH * M * PLE / 4) { u32x2 w; w.x = pk(v[j][0], v[j][1]); w.y = pk(v[j][2], v[j][3]); ((u32x2*)PB)[i] = w; } }
        }
    }
    GRID_BAR();
    REPS(11) {
        REPBAR();
        for (int i = gt; i < DEPTH * NCV; i += GT) {
            const int l = i / NCV, col = i % NCV;
            if (l == 0 && col < CV_IN) continue;
            float s1 = 0.f, s2 = 0.f;
            for (int kb = 0; kb < 32; ++kb) { s1 += PART[(((size_t)l * 2 + 0) * 32 + kb) * NCV + col]; s2 += PART[(((size_t)l * 2 + 1) * 32 + kb) * NCV + col]; }
            CV[((size_t)l * 2 + 0) * NCV + col] = s1; CV[((size_t)l * 2 + 1) * NCV + col] = s2;
        }
        {
            OPAQUE_IDS();
            pg8::Gemm g{PB, WL(0, W_PLE), DEPTH * M, D, PLE}; PleOrder S; S.base.init(M, D, G, bx);
            EpiPle E{PW};
            pg8::gemm_phase<EpiPle, PleOrder, false, true>(lds, g, S, E, wave);
        }
        {
            OPAQUE_IDS();
            const int l = bx >> 6, gf = bx & 63;
            if (G == 256 && l < DEPTH) skinny<1, ABDirect, 2>(WL(l, W_PLE), D, PWS + (size_t)l * 8 * D, ABDirect{p_sample + (size_t)l * 8 * PLE, PLE}, red, tid, wave, lane, gf, 64);
            else if (G != 256) for (int l2 = 0; l2 < DEPTH; ++l2) skinny<1>(WL(l2, W_PLE), D, PWS + (size_t)l2 * 8 * D, ABDirect{p_sample + (size_t)l2 * 8 * PLE, PLE}, red, tid, wave, lane, bx, G);
        }
    }
    GRID_BAR();

#if defined(MK_DUP)
#define MK_DUPLOOP(k) for (int rr_ = 0, nr_ = (MK_DUP == (k)) ? 1 + KP->pad : 1; rr_ < nr_; ++rr_)
#else
#define MK_DUPLOOP(k)
#endif
    int cur = 0;
    const float* ysp = x_sample; const float* sstp = SST; int sid = 1; const float* sg = ln_g; const float* sb = ln_b; int ss = 0;
    for (int l = 0; l < KP->nl; ++l) {
        OPAQUE_IDS();
        float* k_out = out + O_KP + (size_t)l * M * 1024; float* v_out = out + O_VP + (size_t)l * M * 1024;
        for (int sub = 0; sub < 2; ++sub) {
            OPAQUE_IDS();
            if (sub == 1) {
                if (RUNP(l * 16 + 3)) REPS(3) {
                    REPBAR();
                    pg8::Gemm g{YB + (size_t)cur * M * D, WL(l, W_IN), M, INW, D}; pg8::StaticOrder S; S.init(M, INW, G, bx);
                    EpiIn E{Z, k_out, v_out, STATS + (size_t)cur * M * 16, CV1(l, CV_IN), CV2(l, CV_IN)};
                    const PreTab<pg8::StaticOrder> PT{lds, S, STATS + (size_t)cur * M * 16, tid, 1};
                    pg8::gemm_phase<EpiIn, pg8::StaticOrder, true, true, false, false, PreTab<pg8::StaticOrder>>(lds, g, S, E, wave, PT);
                    ABResid ab{ysp, sstp, sid, sg, sb, RDB, 0.5f, 0, nullptr, nullptr, nullptr};
                    if (bx == 0) smp_update(ab, YS + ss * 8 * D, SST + ss * 16, wave, lane);
                    MK_DUPLOOP(6) skinny<8, ABResid, 2>(WL(l, W_IN), INW, RIN, ab, red, tid, wave, lane, bx, G);
                }
                ysp = YS + ss * 8 * D; sstp = SST + ss * 16; sid = 0; sg = LNG(l, 0); sb = LNB(l, 0); ss ^= 1;
                GRID_BAR();
                if (RUNP(l * 16 + 4)) REPS(4) {
                    REPBAR();
                    const int xa_ = (G == 256) ? ((4 * (bx & 7) + (bx >> 6)) * 48 + ((bx >> 3) & 7)) : bx, xs_ = (G == 256) ? 8 : G, xn_ = (G == 256) ? ((4 * (bx & 7) + (bx >> 6)) * 48 + 48) : 1536;
                    const int ra_ = (G == 256) ? ((4 * (bx & 7) + (bx >> 6)) * 16 + ((bx >> 3) & 7)) : bx, rn_ = (G == 256) ? ((4 * (bx & 7) + (bx >> 6)) * 16 + 16) : 512;
                    MK_DUPLOOP(1) { OPAQUE_IDS(); attn_phase(lds, Z, OG, LSE, xa_, xs_, xn_, wave, lane); }
                    MK_DUPLOOP(2) { OPAQUE_IDS(); if (G == 256) retu_pair(lds, Z, U, ra_, ra_ + 8, tid, wave, lane); else retu_units(lds, Z, U, ra_, xs_, rn_, tid, wave, lane); }
                    const ZsFold zf{RIN, sstp, CV1(l, CV_IN), CV2(l, CV_IN)};
                    MK_DUPLOOP(3) for (int t = bx; t < 256; t += G) {
                        if (t < 192) smp_attn((MK_LAS float*)lds, zf, cache_k + (size_t)l * SB * 2048 * 1024, cache_v + (size_t)l * SB * 2048 * 1024, AP, out + O_KS + (size_t)l * SB * 1024, out + O_VS + (size_t)l * SB * 1024, t, tid, wave, lane);
                        else smp_ret((MK_LAS float*)lds, zf, state_ret + (size_t)l * SB * 8 * 8192, out + O_RS + (size_t)l * SB * 8 * 8192, gn_g + (size_t)l * 1024, gn_b + (size_t)l * 1024, MIXS, t - 192, tid);
                    }
                }
                GRID_BAR();
                if (RUNP(l * 16 + 5)) REPS(5) {
                    REPBAR();
                    {
                        const int ub_ = (G == 256) ? ((4 * (bx & 7) + (bx >> 6)) * 8 + ((bx >> 3) & 7)) : bx;
                        if (G == 256 && NGW * 4 == M) {
                            int ui_ = 0;
                            for (int u = ub_; u < 512; u += 256) {
                                CombRegs2 cr; const int t0_ = gw + 2 * ui_ * NGW;
                                const auto jpre = [&]() { combine_load2(OG, LSE, t0_, NGW, lane, cr); };
                                const auto jpost = [&]() { combine_finish2(MIX, t0_, NGW, lane, cr); };
                                reto_unit(lds, Z, U, MIX, gn_g + (size_t)l * 1024, gn_b + (size_t)l * 1024, out + O_RP + (size_t)l * NB * 8 * 8192, u, tid, wave, lane, jpre, jpost);
                                ++ui_;
                            }
                        } else {
                            for (int u = ub_; u < 512; u += G) reto_unit(lds, Z, U, MIX, gn_g + (size_t)l * 1024, gn_b + (size_t)l * 1024, out + O_RP + (size_t)l * NB * 8 * 8192, u, tid, wave, lane);
                            for (int t = gw; t < M; t += NGW) combine_rows<1>(OG, LSE, MIX, t, 0, lane);
                        }
                    }
                    for (int t = bx; t < 64; t += G) {
                        if (tid < 128) {
                            const float* p0 = AP + (t * 3 + 0) * 136; const float* p1 = AP + (t * 3 + 1) * 136; const float* p2 = AP + (t * 3 + 2) * 136;
                            const float mx = fmaxf(p0[0], fmaxf(p1[0], p2[0]));
                            const float e0 = __expf(p0[0] - mx), e1 = __expf(p1[0] - mx), e2 = __expf(p2[0] - mx);
                            const float L = p0[1] * e0 + p1[1] * e1 + p2[1] * e2;
                            MIXS[(t >> 3) * D + (t & 7) * 128 + tid] = (p0[8 + tid] * e0 + p1[8 + tid] * e1 + p2[8 + tid] * e2) / L;
                        }
                    }
                }
                GRID_BAR();
                if (RUNP(l * 16 + 6)) REPS(6) {
                    REPBAR(); const bool dum = DUMSEL;
                    pg8::Gemm g{MIX, WL(l, W_OUT), M, D, D}; pg8::StaticOrder S; S.init(M, D, G, bx);
                    EpiRes<0> E{nullptr, YB + (size_t)cur * M * D, dum ? YBDUM : YB + (size_t)(cur ^ 1) * M * D, STATS + (size_t)cur * M * 16, dum ? STDUM : STATS + (size_t)(cur ^ 1) * M * 16, LNG(l, 0), LNB(l, 0), 0, 1.0f, nullptr, nullptr, nullptr, dum ? nullptr : Y8};
                    const PreTab<pg8::StaticOrder> PT{lds, S, STATS + (size_t)cur * M * 16, tid, 1};
                    pg8::gemm_phase<EpiRes<0>, pg8::StaticOrder, false, true, false, false, PreTab<pg8::StaticOrder>>(lds, g, S, E, wave, PT);
                    MK_DUPLOOP(6) skinny<8>(WL(l, W_OUT), D, RDA, ABDirect{MIXS, D}, red, tid, wave, lane, bx, G);
                }
                cur ^= 1;
                GRID_BAR();
            }
            const size_t wup = sub ? W_UP2 : W_UP1, wdn = sub ? W_DN2 : W_DN1; const int cvu = sub ? CV_UP2 : CV_UP1;
            const int idn = (l == 0 && sub == 0) ? 1 : 0;
            if (RUNP(l * 16 + (sub ? 7 : 1))) REPS(1) {
                REPBAR();
                pg8::Gemm g{(const bf16_t*)Y8, WL(l, wup), M, NUP, D / 2}; pg8::StaticOrder S; S.init(M, NUP, G, bx);
                const bool tail = (G == 256);
                if (tail) S.lim = 1280;
#if defined(MK_PROBE)
                const int nost_ = DUMSEL ? (int)((KP->rep >> 16) & 3) : 0;
                EpiSwiGLU<false> E{H, STATS + (size_t)cur * M * 16, CV1(l, cvu), CV2(l, cvu), idn, nost_};
#else
                EpiSwiGLU<false> E{H, STATS + (size_t)cur * M * 16, CV1(l, cvu), CV2(l, cvu), idn};
#endif
                TailOrder ST{S, 1280, G / 2, bx, S.nwg};
                const PreTab<pg8::StaticOrder> PT{lds, S, STATS + (size_t)cur * M * 16, tid, !idn};
                {
                    const ChainOrder SC{S, 1280, G / 2};
                    pg8::gemm_phase<EpiSwiGLU<false>, ChainOrder, true, true, false, true, PreTab<pg8::StaticOrder>>(lds, g, SC, E, wave, PT);
                }
                OPAQUE_IDS();
                if (tail) {
#if defined(MK_PROBE)
                    EpiSwiGLU<true> ET{H, STATS + (size_t)cur * M * 16, CV1(l, cvu), CV2(l, cvu), idn, nost_};
#else
                    EpiSwiGLU<true> ET{H, STATS + (size_t)cur * M * 16, CV1(l, cvu), CV2(l, cvu), idn};
#endif
                    const PreTabHalf PTH{lds, ST, STATS + (size_t)cur * M * 16, tid, !idn}; pg8::gemm_phase<EpiSwiGLU<true>, TailOrder, false, true, true, true, PreTabHalf, true>(lds, g, ST, ET, wave, PTH); }
                OPAQUE_IDS();
                const int sgf = bx, sgs = G;
                if (idn) skinny8_swi((const unsigned char*)WL(l, wup), ABDirect{x_sample, D}, 1, nullptr, nullptr, HSS, lds, tid, wave, lane, bx);
                else {
                    const int gm = (sub == 0) ? 1 : 0;
                    ABResid ab{ysp, sstp, 0, sg, sb, RDA, 1.0f, gm, gm ? PWS + (size_t)(l - 1) * 8 * D : nullptr, gm ? CV1(l - 1, CV_GATE) : nullptr, gm ? CV2(l - 1, CV_GATE) : nullptr};
                    if (sgf == 0) smp_update(ab, YS + ss * 8 * D, SST + ss * 16, wave, lane);
                    OPAQUE_IDS();
                    skinny8_swi((const unsigned char*)WL(l, wup), ab, 0, CV1(l, cvu), CV2(l, cvu), HSS, lds, tid, wave, lane, bx);
                }
            }
            if (!idn) { ysp = YS + ss * 8 * D; sstp = SST + ss * 16; sid = 0; if (sub == 0) { sg = LNG(l - 1, 3); sb = LNB(l - 1, 3); } else { sg = LNG(l, 1); sb = LNB(l, 1); } ss ^= 1; }
            GRID_BAR();
            if (RUNP(l * 16 + (sub ? 8 : 2))) REPS(2) {
                REPBAR(); const bool dum = DUMSEL;
                pg8::Gemm g{(const bf16_t*)H, WL(l, wdn), M, D, FF / 2}; pg8::StaticOrder S; S.init(M, D, G, bx);
                const float* pg = idn ? ln_g : (sub ? LNG(l, 1) : LNG(l - 1, 3)); const float* pb = idn ? ln_b : (sub ? LNB(l, 1) : LNB(l - 1, 3));
                EpiRes<0> E{x_prompt, YB + (size_t)cur * M * D, dum ? YBDUM : YB + (size_t)(cur ^ 1) * M * D, STATS + (size_t)cur * M * 16, dum ? STDUM : STATS + (size_t)(cur ^ 1) * M * 16, pg, pb, idn, 0.5f / (W8S * H8S), nullptr, nullptr, nullptr, nullptr};
                const PreTab<pg8::StaticOrder> PT{lds, S, STATS + (size_t)cur * M * 16, tid, !idn};
                pg8::gemm_phase<EpiRes<0>, pg8::StaticOrder, false, true, false, true, PreTab<pg8::StaticOrder>>(lds, g, S, E, wave, PT);
                OPAQUE_IDS();
                skinny8<6, ABRaw8, 1, 3, true>((const unsigned char*)WL(l, wdn), D, FF, RDB, ABRaw8{HSS}, 1.f, 1.f / (W8S * H8S), lds, tid, wave, lane, bx, G);
            }
            cur ^= 1;
            GRID_BAR();
        }
        OPAQUE_IDS();
        if (RUNP(l * 16 + 9)) REPS(9) {
            REPBAR(); const bool dum = DUMSEL;
            pg8::Gemm g{YB + (size_t)cur * M * D, WL(l, W_GATE), M, D, D}; pg8::StaticOrder S; S.init(M, D, G, bx);
            EpiRes<1> E{nullptr, YB + (size_t)cur * M * D, dum ? YBDUM : YB + (size_t)(cur ^ 1) * M * D, STATS + (size_t)cur * M * 16, dum ? STDUM : STATS + (size_t)(cur ^ 1) * M * 16, LNG(l, 2), LNB(l, 2), 0, 1.0f, PW + (size_t)l * M * D, CV1(l, CV_GATE), CV2(l, CV_GATE), dum ? nullptr : Y8};
            const PreTab<pg8::StaticOrder> PT{lds, S, STATS + (size_t)cur * M * 16, tid, 1};
            pg8::gemm_phase<EpiRes<1>, pg8::StaticOrder, false, true, false, false, PreTab<pg8::StaticOrder>>(lds, g, S, E, wave, PT);
            ABResid ab{ysp, sstp, 0, sg, sb, RDB, 0.5f, 0, nullptr, nullptr, nullptr};
            if (bx == 0) smp_update(ab, YS + ss * 8 * D, SST + ss * 16, wave, lane);
            MK_DUPLOOP(6) skinny<8>(WL(l, W_GATE), D, RDA, ab, red, tid, wave, lane, bx, G);
        }
        ysp = YS + ss * 8 * D; sstp = SST + ss * 16; sid = 0; sg = LNG(l, 2); sb = LNB(l, 2); ss ^= 1;
        cur ^= 1;
        GRID_BAR();
    }
    {
        OPAQUE_IDS();
        const int l = KP->nl - 1;
        const float* st = STATS + (size_t)cur * M * 16; const float* g = LNG(l, 3); const float* b = LNB(l, 3);
        for (int t0 = gw; t0 < M; t0 += 4 * NGW) {
            u32x2 pq[4][8]; float mu[4], rs[4];
#pragma unroll
            for (int r = 0; r < 4; ++r) {
                const int t = t0 + r * NGW;
                if (t < M) { row_stats(st, t, mu[r], rs[r]);
#pragma unroll
                    for (int j = 0; j < 8; ++j) pq[r][j] = *(const u32x2*)(YB + (size_t)cur * M * D + (size_t)t * D + 4 * lane + 256 * j); }
            }
#pragma unroll
            for (int j = 0; j < 8; ++j) {
                const int c = 4 * lane + 256 * j; const f32x4 gv = *(const f32x4*)(g + c), bv = *(const f32x4*)(b + c);
#pragma unroll
                for (int r = 0; r < 4; ++r) {
                    const int t = t0 + r * NGW;
                    if (t < M) { const f32x4 v = (f32x4){bflo(pq[r][j].x), bfhi(pq[r][j].x), bflo(pq[r][j].y), bfhi(pq[r][j].y)}; __builtin_nontemporal_store((v - mu[r]) * rs[r] * gv + bv, (f32x4*)(out + O_YP + (size_t)t * D + c)); }
                }
            }
        }
        if (bx == 0) {
            ABResid ab{ysp, sstp, 0, sg, sb, RDA, 1.0f, 1, PWS + (size_t)l * 8 * D, CV1(l, CV_GATE), CV2(l, CV_GATE)};
            float v[32]; float s = 0.f, q = 0.f;
#pragma unroll
            for (int j = 0; j < 4; ++j) { float t8[8]; ab.val8(wave, lane * 8 + 512 * j, t8);
#pragma unroll
                for (int e = 0; e < 8; ++e) { v[8 * j + e] = t8[e]; s += t8[e]; q += t8[e] * t8[e]; } }
#pragma unroll
            for (int o = 32; o > 0; o >>= 1) { s += shx(s, o, lane); q += shx(q, o, lane); }
            const float mu = s * (1.f / 2048.f), rs = 1.0f / sqrtf(fmaxf(q * (1.f / 2048.f) - mu * mu, 0.f) + LN_EPS);
#pragma unroll
            for (int j = 0; j < 4; ++j)
#pragma unroll
                for (int e = 0; e < 8; ++e) { const int k = lane * 8 + 512 * j + e; out[O_YS + (size_t)wave * D + k] = (v[8 * j + e] - mu) * rs * g[k] + b[k]; }
        }
    }
#if defined(MK_STAMP)
    asm volatile("s_waitcnt vmcnt(0)" ::: "memory");
    if (bx == 0 && tid == 0) ((unsigned long long*)(ws + WS_CTL + 524288))[nstamp] = __builtin_amdgcn_s_memrealtime();
#endif
}
#undef ws
#undef out
#undef x_prompt
#undef x_sample
#undef cache_k
#undef cache_v
#undef state_ret
#undef p_prompt
#undef p_sample
#undef w_in
#undef w_out
#undef gn_g
#undef gn_b
#undef f1w1
#undef f1w3
#undef f1w2
#undef f2w1
#undef f2w3
#undef f2w2
#undef w_ple
#undef w_gate
#undef ln_g
#undef ln_b
#undef STATS
#undef CV
#undef SMP
#undef PART
#undef WB
#undef YB
#undef Y8
#undef H
#undef Z
#undef MIX
#undef OG
#undef LSE
#undef U
#undef PB
#undef PW
#undef YS
#undef SST
#undef RUP
#undef RDA
#undef RIN
#undef MIXS
#undef AP
#undef PWS
#undef RDB
#undef YBDUM
#undef STDUM
#undef gw
#undef NGW
#undef gt
#undef GT
#undef OPAQUE_IDS
#undef LNG
#undef LNB
#undef CV1
#undef CV2
#undef WL
#undef GRID_BAR
#undef RUNP
#undef REPS
#undef REPBAR
#undef DUMSEL
}

namespace mk { constexpr size_t WS_NEED = WS_END + (size_t)120 * 1024 * 1024; }
#define NL_RUN 4
#define STOP_RUN 0
#define REP_RUN 0


extern "C" void kernel_launch(void* const* d_in, const int* in_sizes, int n_in, void* d_out, int out_size, void* d_ws, size_t ws_size, hipStream_t stream) {
    using namespace mk;
    static int ok = 0;
    if (ok == 0) {
        ok = 1;
        if (n_in != 21 || (size_t)out_size != O_END || ws_size < WS_NEED) { fprintf(stderr, "kernel_launch: unexpected shapes (n_in %d out %d ws %zu need %zu)\n", n_in, out_size, ws_size, (size_t)WS_NEED); ok = -1; }
        else if (hipFuncSetAttribute((const void*)mega, hipFuncAttributeMaxDynamicSharedMemorySize, LDS_BYTES) != hipSuccess) { fprintf(stderr, "kernel_launch: hipFuncSetAttribute failed\n"); ok = -1; }
        else {
            int dev = 0, ncu = 0, per = 0;
            if (hipGetDevice(&dev) == hipSuccess && hipDeviceGetAttribute(&ncu, hipDeviceAttributeMultiprocessorCount, dev) == hipSuccess &&
                hipOccupancyMaxActiveBlocksPerMultiprocessor(&per, (const void*)mega, NTHR, LDS_BYTES) == hipSuccess && (long)per * ncu < 256)
                fprintf(stderr, "kernel_launch: 256 workgroups are not co-resident here (%d per CU x %d CUs)\n", per, ncu);
        }
    }
    if (ok < 0) return;
    unsigned char* ws = (unsigned char*)d_ws;

    (void)hipMemsetAsync(ws + WS_CTL, 0, CTL_BYTES, stream);
    Args a{};
    for (int i = 0; i < 21; ++i) a.in[i] = (const float*)d_in[i];
    a.out = (float*)d_out; a.ws = ws; a.nl = NL_RUN; a.stop = STOP_RUN; a.rep = REP_RUN;
#if defined(MK_DUP)
    a.pad = 1;
#endif
    hipLaunchKernelGGL(mega, dim3(256), dim3(NTHR), LDS_BYTES, stream, a);

}
```

```cpp
#include <hip/hip_runtime.h>
#include <cstdio>
#include <cstdint>

namespace pg8 {
#define PG8_LAS __attribute__((address_space(3)))
typedef unsigned short bf16_t;
typedef short bf16x8 __attribute__((ext_vector_type(8)));
typedef float f32x4 __attribute__((ext_vector_type(4)));
typedef unsigned u32x4 __attribute__((ext_vector_type(4)));
constexpr int BM = 256, BK = 64, HALF = 128, HTB = HALF * BK * 2  , STAGE_BYTES = 8 * HTB, NXCD = 8, WGM = 8;

__host__ __device__ __forceinline__ int lds_byte(int r, int c) { const int st = (r >> 4) * 2 + (c >> 5), rr = r & 15, cc = c & 31, ob = rr * 64 + cc * 2; return st * 1024 + (ob ^ (((ob >> 9) & 1) << 5)); }
__host__ __device__ __forceinline__ void stage_rc(int b, int& R, int& C) { const int st = b / 1024, sb = b % 1024, swz = sb ^ (((sb >> 9) & 1) << 5); R = (st >> 1) * 16 + swz / 64; C = (st & 1) * 32 + (swz % 64) / 2; }
__host__ __device__ __forceinline__ int perm32(int rho) { const int n = rho >> 4, i = rho & 15; return 8 * (i >> 2) + 4 * n + (i & 3); }

struct Unit { int pm, pn, idx, half; };
struct Gemm { const bf16_t* A; const bf16_t* Bt; int M, N, K; };

struct StaticOrder {
    int nM, nN, nwg, G, c, lim;
    __host__ __device__ void init(int M, int N, int G_, int c_) { nM = M / BM; nN = N / BM; nwg = nM * nN; G = G_; c = c_; lim = nwg; }
    __host__ __device__ bool next(int i, Unit& u) const {
        const long L = (long)i * G + c; if (L >= lim) return false;
        int wgid = (int)L; { const int q = nwg / NXCD, r = nwg % NXCD, xcd = wgid % NXCD, off = wgid / NXCD; wgid = (xcd < r ? xcd * (q + 1) : r * (q + 1) + (xcd - r) * q) + off; }
        const int nig = WGM * nN, gid = wgid / nig, fm = gid * WGM, gsz = (nM - fm) < WGM ? (nM - fm) : WGM;
        u.pm = fm + ((wgid % nig) % gsz); u.pn = (wgid % nig) / gsz; u.idx = i; u.half = 0; return true;
    }
    __device__ __forceinline__ void a_ready(const Unit&) const {}
    __device__ __forceinline__ void done(const Unit&) const {}
};

__device__ __forceinline__ unsigned cvt_pk_bf16(float lo, float hi) { unsigned r; asm volatile("v_cvt_pk_bf16_f32 %0, %1, %2" : "=v"(r) : "v"(lo), "v"(hi)); return r; }
typedef float f32x2 __attribute__((ext_vector_type(2)));
struct NoPre { __device__ __forceinline__ void operator()() const {} };
template <class S_> struct has_chain { template <class T> static auto f(int) -> decltype(T::HAS_CHAIN, char()); template <class T> static long f(...); static constexpr bool value = sizeof(f<S_>(0)) == 1; };
template <class Epi, class Sched, bool ALIGN_EPI = false, bool SP2 = false, bool HALF_M = false, bool FP8 = false, class Pre = NoPre, bool PRELOADED = false>
__device__ __forceinline__ void gemm_phase(PG8_LAS unsigned char* lds, const Gemm g, const Sched& S, const Epi& E, int wave_in, const Pre& pre = Pre()) {
    unsigned z_op = 0u; asm volatile("" : "+s"(z_op));
    int tid_op = (int)__builtin_amdgcn_mbcnt_hi(~0u, __builtin_amdgcn_mbcnt_lo(~0u, z_op)) + 64 * wave_in; asm volatile("" : "+v"(tid_op));
    const int tid = tid_op, wid = __builtin_amdgcn_readfirstlane(tid >> 6), lane = tid & 63, wr = wid >> 2, wc = wid & 3, fr = lane & 15, fq = lane >> 4;
    const int K = g.K, nt = K / BK;
    unsigned voffA[2], voffB[2];
#pragma unroll
    for (int i = 0; i < 2; ++i) { int R, C; stage_rc(tid * 16 + i * 8192, R, C); const int Rb = Epi::PERM ? ((R & ~31) + perm32(R & 31)) : R;
        voffA[i] = (unsigned)(R * K + C) * 2u; voffB[i] = (unsigned)(Rb * K + C) * 2u; }
    const int p1step = 64 * K * 2;
    const size_t kstep = (size_t)(BK * 2);
    const size_t hstep = (size_t)HALF * K * 2;
    const size_t tstep = 2 * hstep;
    const size_t hstepA = HALF_M ? (size_t)0 : hstep;
    static_assert(!HALF_M || SP2, "HALF_M is written for the SP2 loop");
    const unsigned ldsw = (unsigned)wid * 1024u;
    const int aoff = lds_byte(wr * 64 + fr, fq * 8), boff = lds_byte(wc * 32 + fr, fq * 8);
#define PG8_SA(b, h) (((b) * 2 + (h)) * HTB)
#define PG8_SB(b, h) ((4 + (b) * 2 + (h)) * HTB)
    const char* base_voffA = (const char*)g.A; const char* base_voffB = (const char*)g.Bt;
    const __amdgpu_buffer_rsrc_t rsrc_voffA = __builtin_amdgcn_make_buffer_rsrc((void*)g.A, (short)0, 0x7fffffff, 0x00020000), rsrc_voffB = __builtin_amdgcn_make_buffer_rsrc((void*)g.Bt, (short)0, 0x7fffffff, 0x00020000);
#define PG8_STAGE(bufoff, gbase, voff) do { const int so_ = (int)((gbase) - base_##voff); _Pragma("unroll") for (int _i = 0; _i < 2; ++_i) \
        __builtin_amdgcn_raw_ptr_buffer_load_lds(rsrc_##voff, (PG8_LAS void*)(lds + (bufoff) + ldsw + _i * 8192), 16, (int)(voff)[0], so_ + _i * p1step, 0, 0); } while (0)
#define PG8_LDA(dst, b, h) do { _Pragma("unroll") for (int m = 0; m < 4; ++m) _Pragma("unroll") for (int k = 0; k < 2; ++k) dst[m][k] = *(const PG8_LAS bf16x8*)(lds + PG8_SA(b, h) + aoff + m * 2048 + k * 1024); } while (0)
#define PG8_LDB(dst, b, h) do { _Pragma("unroll") for (int n = 0; n < 2; ++n) _Pragma("unroll") for (int k = 0; k < 2; ++k) dst[n][k] = *(const PG8_LAS bf16x8*)(lds + PG8_SB(b, h) + boff + n * 2048 + k * 1024); } while (0)
#define PG8_MMA(ai, bj, At, Bt) do { __builtin_amdgcn_s_setprio(1); _Pragma("unroll") for (int m = 0; m < 4; ++m) _Pragma("unroll") for (int n = 0; n < 2; ++n) { \
        if constexpr (FP8) {   \
            typedef int pg8_v8i __attribute__((ext_vector_type(8))); typedef int pg8_v4i __attribute__((ext_vector_type(4))); \
            const pg8_v4i b0_ = __builtin_bit_cast(pg8_v4i, Bt[n][0]), b1_ = __builtin_bit_cast(pg8_v4i, Bt[n][1]), a0_ = __builtin_bit_cast(pg8_v4i, At[m][0]), a1_ = __builtin_bit_cast(pg8_v4i, At[m][1]); \
            const pg8_v8i bb_ = (pg8_v8i){b0_[0], b0_[1], b0_[2], b0_[3], b1_[0], b1_[1], b1_[2], b1_[3]}, aa_ = (pg8_v8i){a0_[0], a0_[1], a0_[2], a0_[3], a1_[0], a1_[1], a1_[2], a1_[3]}; \
            acc[ai][bj][m][n] = __builtin_amdgcn_mfma_scale_f32_16x16x128_f8f6f4(bb_, aa_, acc[ai][bj][m][n], 0, 0, 0, 0x7F7F7F7F, 0, 0x7F7F7F7F); \
        } else { _Pragma("unroll") for (int k = 0; k < 2; ++k) \
        acc[ai][bj][m][n] = __builtin_amdgcn_mfma_f32_16x16x32_bf16(Bt[n][k], At[m][k], acc[ai][bj][m][n], 0, 0, 0); } } __builtin_amdgcn_s_setprio(0); } while (0)
#define PG8_WAIT_V(n) asm volatile("s_waitcnt vmcnt(" #n ")" ::: "memory")
#define PG8_WAIT_L(n) asm volatile("s_waitcnt lgkmcnt(" #n ")" ::: "memory")
#define PG8_BAR __builtin_amdgcn_s_barrier()
#define PG8_SCHED __builtin_amdgcn_sched_barrier(0)
    Unit cur, nxt; int ui = 0;
    if (!S.next(0, cur)) return;
    f32x4 acc[2][2][4][2];
#pragma unroll
    for (int a = 0; a < 2; ++a)
#pragma unroll
        for (int b = 0; b < 2; ++b)
#pragma unroll
            for (int m = 0; m < 4; ++m)
#pragma unroll
                for (int n = 0; n < 2; ++n) acc[a][b][m][n] = (f32x4){0.f, 0.f, 0.f, 0.f};
    bf16x8 At[4][2], B0[2][2], B1[2][2];
    const char* cA = (const char*)g.A + (size_t)cur.pm * tstep + (HALF_M ? (size_t)cur.half * hstep : (size_t)0); const char* cB = (const char*)g.Bt + (size_t)cur.pn * tstep;
    S.a_ready(cur);
    if constexpr (SP2 && PRELOADED) {
        pre();
        if (wr == 1) PG8_BAR;
        PG8_BAR;
        PG8_BAR;
    } else if constexpr (SP2) {
        PG8_STAGE(PG8_SB(0, 0), cB, voffB); PG8_STAGE(PG8_SB(0, 1), cB + hstep, voffB); PG8_STAGE(PG8_SA(0, 0), cA, voffA); if constexpr (!HALF_M) PG8_STAGE(PG8_SA(0, 1), cA + hstepA, voffA);
        pre();
        if (wr == 1) PG8_BAR;
        if constexpr (HALF_M) PG8_WAIT_V(0); else PG8_WAIT_V(2); PG8_BAR;
        PG8_STAGE(PG8_SB(1, 0), cB + kstep, voffB); PG8_STAGE(PG8_SA(1, 0), cA + kstep, voffA); PG8_STAGE(PG8_SB(1, 1), cB + hstep + kstep, voffB);
        PG8_WAIT_V(6); PG8_BAR;
    } else {
        PG8_STAGE(PG8_SB(0, 0), cB, voffB); PG8_STAGE(PG8_SA(0, 0), cA, voffA); PG8_STAGE(PG8_SB(0, 1), cB + hstep, voffB); PG8_STAGE(PG8_SA(0, 1), cA + hstepA, voffA);
        pre();
        if (wr == 1) PG8_BAR;
        PG8_WAIT_V(4); PG8_BAR;
        PG8_STAGE(PG8_SB(1, 0), cB + kstep, voffB); PG8_STAGE(PG8_SA(1, 0), cA + kstep, voffA); PG8_STAGE(PG8_SB(1, 1), cB + hstep + kstep, voffB);
        PG8_WAIT_V(6); PG8_BAR;
    }
    for (;;) {
        const bool has_next = S.next(ui + 1, nxt);
        bool pf = has_next;
        if constexpr (has_chain<Sched>::value) { if (!has_next) pf = S.chain(nxt); }
        const char* nA = pf ? (const char*)g.A + (size_t)nxt.pm * tstep + ((HALF_M || has_chain<Sched>::value) ? (size_t)nxt.half * hstep : (size_t)0) : cA; const char* nB = pf ? (const char*)g.Bt + (size_t)nxt.pn * tstep : cB;
        for (int t = 0; t < nt; t += 2) {
            const bool last = (t == nt - 2);
            const char* a1 = cA + (size_t)(t + 1) * kstep;
            const char* a2 = last ? nA : cA + (size_t)(t + 2) * kstep; const char* b2 = last ? nB : cB + (size_t)(t + 2) * kstep;
            const char* a3 = a2 + kstep; const char* b3 = b2 + kstep;
            if (last && has_next) S.a_ready(nxt);
            if constexpr (SP2) {
            PG8_LDB(B0, 0, 0); PG8_LDB(B1, 0, 1); PG8_SCHED; PG8_LDA(At, 0, 0); if constexpr (!HALF_M) PG8_STAGE(PG8_SA(1, 1), a1 + hstepA, voffA);
            PG8_WAIT_V(8); PG8_WAIT_L(0); PG8_BAR; PG8_MMA(0, 0, At, B0); PG8_MMA(0, 1, At, B1); PG8_BAR; PG8_SCHED;
            if constexpr (!HALF_M) PG8_LDA(At, 0, 1); PG8_STAGE(PG8_SB(0, 0), b2, voffB); PG8_STAGE(PG8_SB(0, 1), b2 + hstep, voffB); PG8_STAGE(PG8_SA(0, 0), a2, voffA);
            if constexpr (HALF_M) PG8_WAIT_V(6); else PG8_WAIT_V(8); PG8_WAIT_L(0); PG8_BAR; if constexpr (!HALF_M) { PG8_MMA(1, 0, At, B0); PG8_MMA(1, 1, At, B1); } PG8_BAR; PG8_SCHED;
            PG8_LDB(B0, 1, 0); PG8_LDB(B1, 1, 1); PG8_SCHED; PG8_LDA(At, 1, 0); if constexpr (!HALF_M) PG8_STAGE(PG8_SA(0, 1), a2 + hstepA, voffA);
            PG8_WAIT_V(8); PG8_WAIT_L(0); PG8_BAR; PG8_MMA(0, 0, At, B0); PG8_MMA(0, 1, At, B1); PG8_BAR; PG8_SCHED;
            if constexpr (!HALF_M) PG8_LDA(At, 1, 1); PG8_STAGE(PG8_SB(1, 0), b3, voffB); PG8_STAGE(PG8_SB(1, 1), b3 + hstep, voffB); PG8_STAGE(PG8_SA(1, 0), a3, voffA);
            if constexpr (HALF_M) PG8_WAIT_V(6); else PG8_WAIT_V(8); PG8_WAIT_L(0); PG8_BAR; if constexpr (!HALF_M) { PG8_MMA(1, 0, At, B0); PG8_MMA(1, 1, At, B1); } PG8_BAR; PG8_SCHED;
            } else {
            PG8_LDB(B0, 0, 0); PG8_SCHED; PG8_LDA(At, 0, 0); PG8_STAGE(PG8_SA(1, 1), a1 + hstepA, voffA);
            PG8_WAIT_L(8); PG8_BAR; PG8_WAIT_L(0); PG8_MMA(0, 0, At, B0); PG8_BAR; PG8_SCHED;
            PG8_LDB(B1, 0, 1); PG8_STAGE(PG8_SB(0, 0), b2, voffB);
            PG8_BAR; PG8_WAIT_L(0); PG8_MMA(0, 1, At, B1); PG8_BAR;
            PG8_LDA(At, 0, 1); PG8_STAGE(PG8_SA(0, 0), a2, voffA);
            PG8_BAR; PG8_WAIT_L(0); PG8_MMA(1, 0, At, B0); PG8_BAR; PG8_SCHED;
            PG8_STAGE(PG8_SB(0, 1), b2 + hstep, voffB);
            PG8_WAIT_V(6); PG8_BAR; PG8_MMA(1, 1, At, B1); PG8_BAR;
            PG8_LDB(B0, 1, 0); PG8_SCHED; PG8_LDA(At, 1, 0); PG8_STAGE(PG8_SA(0, 1), a2 + hstepA, voffA);
            PG8_WAIT_L(8); PG8_BAR; PG8_WAIT_L(0); PG8_MMA(0, 0, At, B0); PG8_BAR; PG8_SCHED;
            PG8_LDB(B1, 1, 1); PG8_STAGE(PG8_SB(1, 0), b3, voffB);
            PG8_BAR; PG8_WAIT_L(0); PG8_MMA(0, 1, At, B1); PG8_BAR;
            PG8_LDA(At, 1, 1); PG8_STAGE(PG8_SA(1, 0), a3, voffA);
            PG8_BAR; PG8_WAIT_L(0); PG8_MMA(1, 0, At, B0); PG8_BAR; PG8_SCHED;
            PG8_STAGE(PG8_SB(1, 1), b3 + hstep, voffB);
            PG8_WAIT_V(6); PG8_BAR; PG8_MMA(1, 1, At, B1); PG8_BAR;
            }
        }
        if constexpr (ALIGN_EPI) { if (wr == 0) PG8_BAR; }
        if constexpr (!Epi::AFTER_DRAIN) { E(acc, cur, wr, wc, fr, fq); S.done(cur); }
        if (!has_next) break;
#pragma unroll
        for (int a = 0; a < 2; ++a)
#pragma unroll
            for (int b = 0; b < 2; ++b)
#pragma unroll
                for (int m = 0; m < 4; ++m)
#pragma unroll
                    for (int n = 0; n < 2; ++n) acc[a][b][m][n] = (f32x4){0.f, 0.f, 0.f, 0.f};
        cur = nxt; cA = nA; cB = nB; ++ui;
        if constexpr (ALIGN_EPI) { if (wr == 1) PG8_BAR; }
    }
    PG8_WAIT_V(0);
    if constexpr (!ALIGN_EPI) { if (wr == 0) PG8_BAR; }
    PG8_BAR;
    if constexpr (Epi::AFTER_DRAIN) { E.fused(acc, cur, wr, wc, fr, fq, lds, wid, lane); S.done(cur); }
#undef PG8_SA
#undef PG8_SB
#undef PG8_STAGE
#undef PG8_LDA
#undef PG8_LDB
#undef PG8_MMA
#undef PG8_WAIT_V
#undef PG8_WAIT_L
#undef PG8_BAR
#undef PG8_SCHED
}
}

#define GAS __attribute__((address_space(1)))
#define LAS __attribute__((address_space(3)))
typedef unsigned short bf16;
typedef unsigned v4u __attribute__((ext_vector_type(4)));
typedef float f32x4 __attribute__((ext_vector_type(4)));
typedef short bf16x8 __attribute__((ext_vector_type(8)));
typedef GAS unsigned gu32;
typedef GAS unsigned long long gu64;
#define RLX_AGENT __ATOMIC_RELAXED, __HIP_MEMORY_SCOPE_AGENT
#define LDS_WAIT() asm volatile("s_waitcnt lgkmcnt(0)" ::: "memory")
#define VM_WAIT() asm volatile("s_waitcnt vmcnt(0)" ::: "memory")
__device__ __forceinline__ unsigned long long rt() { return __builtin_amdgcn_s_memrealtime(); }
__device__ __forceinline__ unsigned f2bf(float f) { unsigned u = __builtin_bit_cast(unsigned, f); return (u + 0x7fffu + ((u >> 16) & 1u)) >> 16; }
__device__ __forceinline__ unsigned pk2(float lo, float hi) { return f2bf(lo) | (f2bf(hi) << 16); }
#define XB_TMO      128
#define XB_XCNT(j)  (256  + 64 * (j))
#define XB_XSUB(j)  (1280 + 64 * (j))
#define XB_XGEN(j)  (2304 + 64 * (j))
#define XB_TOP      3328
#define XB_TOPGEN   3392
#define XCD_BAR_WORDS 3456
#define XB_SPIN_CAP (1u << 18)

__device__ __forceinline__ unsigned xb_ld(unsigned* p)              { return __hip_atomic_load(p, __ATOMIC_RELAXED, __HIP_MEMORY_SCOPE_AGENT); }
__device__ __forceinline__ unsigned xb_add(unsigned* p, unsigned v) { return __hip_atomic_fetch_add(p, v, __ATOMIC_RELAXED, __HIP_MEMORY_SCOPE_AGENT); }
__device__ __forceinline__ unsigned xb_xcc_id() { return (unsigned)__builtin_amdgcn_s_getreg((3 << 11) | 20) & 0xFu; }
#define XB_SPIN(cond, bar) do { unsigned _sp = 0; while (cond) { __builtin_amdgcn_s_sleep(1); \
    if ((++_sp & 255u) == 0u) { if (xb_ld(&(bar)[XB_TMO])) break; if (_sp > XB_SPIN_CAP) { atomicAdd(&(bar)[XB_TMO], 1u); break; } } } } while (0)

struct XcdBarrier {
    unsigned* bar; unsigned x;
    volatile LAS unsigned* st;
};

__device__ __forceinline__ XcdBarrier xcd_barrier_post(unsigned* bar, volatile LAS unsigned* st) {
    XcdBarrier b; b.bar = bar; b.x = xb_xcc_id(); b.st = st;
    if (threadIdx.x == 0) (void)xb_add(&bar[XB_XCNT(b.x)], 1u);
    return b;
}
__device__ __forceinline__ void xcd_barrier_complete(unsigned* bar, unsigned x, unsigned& nloc, unsigned& nx) {
    const unsigned G = gridDim.x * gridDim.y * gridDim.z;
    unsigned sum, cnt, mine, sp = 0u;
    for (;;) {
        sum = 0u; cnt = 0u; mine = 0u;
#pragma unroll
        for (unsigned j = 0; j < 16; ++j) { const unsigned c = xb_ld(&bar[XB_XCNT(j)]); sum += c; cnt += (c > 0u) ? 1u : 0u; mine = (j == x) ? c : mine; }
        if (sum == G) break;
        __builtin_amdgcn_s_sleep(1);
        if ((++sp & 255u) == 0u) { if (xb_ld(&bar[XB_TMO])) break; if (sp > XB_SPIN_CAP) { atomicAdd(&bar[XB_TMO], 1u); break; } }
    }
    nloc = mine > 0u ? mine : 1u; nx = cnt > 0u ? cnt : 1u;
}

__device__ __forceinline__ void xcd_barrier(const XcdBarrier& b) {
    asm volatile("s_waitcnt vmcnt(0)" ::: "memory");
    __syncthreads();
    if (threadIdx.x == 0) {
        unsigned* bar = b.bar;
        __builtin_amdgcn_s_waitcnt(0);
        unsigned nloc = b.st[0], nx = b.st[1];
        if (nloc == 0u) { xcd_barrier_complete(bar, b.x, nloc, nx); b.st[0] = nloc; b.st[1] = nx; }
        const unsigned old = xb_add(&bar[XB_XSUB(b.x)], 1u);
        const unsigned gen = old / nloc;
        if (old + 1u == (gen + 1u) * nloc) {
            __builtin_amdgcn_fence(__ATOMIC_RELEASE, "agent");
            asm volatile("s_waitcnt vmcnt(0)" ::: "memory");
            const unsigned og = xb_add(&bar[XB_TOP], 1u);
            const unsigned tg = og / nx;
            if (og + 1u == (tg + 1u) * nx) xb_add(&bar[XB_TOPGEN], 1u);
            else XB_SPIN(xb_ld(&bar[XB_TOPGEN]) == tg, bar);
            __builtin_amdgcn_fence(__ATOMIC_ACQUIRE, "agent");
            xb_add(&bar[XB_XGEN(b.x)], 1u);
            asm volatile("s_waitcnt vmcnt(0)" ::: "memory");
        } else {
            XB_SPIN(xb_ld(&bar[XB_XGEN(b.x)]) == gen, bar);
            __builtin_amdgcn_fence(__ATOMIC_ACQUIRE, "agent");
            asm volatile("s_waitcnt vmcnt(0)" ::: "memory");
        }
    }
    __syncthreads();
}

namespace mk {
using pg8::bf16_t; using pg8::Unit;
typedef unsigned u32x2 __attribute__((ext_vector_type(2)));
typedef unsigned u32x4 __attribute__((ext_vector_type(4)));
typedef short s16x4 __attribute__((ext_vector_type(4)));
typedef float f32x2 __attribute__((ext_vector_type(2)));

constexpr int D = 2048, T = 2048, NB = 4, M = NB * T, DEPTH = 4, SB = 8, FF = 5632, INW = 6144, PLE = 256, NUP = 2 * FF;
constexpr float ALPHA = 1.6817928305074290f, LN_EPS = 1e-5f, GN_EPS = 1e-5f, LOG2E = 1.4426950408889634f;
constexpr int NWAVES = 8, NTHR = 512;

constexpr size_t O_YP = 0, O_YS = O_YP + (size_t)M * D, O_KP = O_YS + (size_t)SB * D, O_VP = O_KP + (size_t)DEPTH * M * 1024, O_RP = O_VP + (size_t)DEPTH * M * 1024,
                 O_KS = O_RP + (size_t)DEPTH * NB * 8 * 64 * 128, O_VS = O_KS + (size_t)DEPTH * SB * 1024, O_RS = O_VS + (size_t)DEPTH * SB * 1024, O_END = O_RS + (size_t)DEPTH * SB * 8 * 64 * 128;

constexpr int CV_UP1 = 0, CV_IN = NUP, CV_UP2 = NUP + INW, CV_GATE = 2 * NUP + INW, NCV = 2 * NUP + INW + D;

constexpr size_t E_UP = (size_t)NUP * D, E_DN = (size_t)D * FF, E_IN = (size_t)INW * D, E_OUT = (size_t)D * D, E_GATE = (size_t)D * D, E_PLE = (size_t)D * PLE;
constexpr size_t W_UP1 = 0, W_DN1 = W_UP1 + E_UP, W_IN = W_DN1 + E_DN, W_OUT = W_IN + E_IN, W_UP2 = W_OUT + E_OUT, W_DN2 = W_UP2 + E_UP, W_GATE = W_DN2 + E_DN, W_PLE = W_GATE + E_GATE, LW = W_PLE + E_PLE;

constexpr size_t al256(size_t x) { return (x + 255) & ~(size_t)255; }
constexpr size_t WS_CTL = 0, CTL_BYTES = 1u << 20;
constexpr size_t WS_STATS = CTL_BYTES;
constexpr size_t WS_CV = WS_STATS + 2 * (size_t)M * 16 * 4;
constexpr size_t WS_SMP = al256(WS_CV + (size_t)DEPTH * 2 * NCV * 4);
constexpr size_t WS_PART = WS_SMP + (2u << 20);
constexpr size_t WS_W = al256(WS_PART + (size_t)DEPTH * 2 * 32 * NCV * 4);
constexpr size_t WS_YB = al256(WS_W + (size_t)DEPTH * LW * 2);
constexpr size_t WS_Y = WS_YB + 2 * (size_t)M * D * 2;
constexpr size_t WS_H = WS_Y + (size_t)M * D * 4;
constexpr size_t WS_Z = WS_H + (size_t)M * FF * 2;
constexpr size_t WS_MIX = WS_Z + (size_t)M * INW * 2;
constexpr size_t WS_OG = WS_MIX + (size_t)M * D * 2;
constexpr size_t WS_LSE = WS_OG + 3 * (size_t)M * 1024 * 2;
constexpr size_t WS_U = WS_LSE + 3 * (size_t)M * 8 * 4;
constexpr size_t WS_PB = WS_U + (size_t)NB * 8 * 16 * 8192 * 4;
constexpr size_t WS_PW = WS_PB + (size_t)DEPTH * M * PLE * 2;
constexpr size_t WS_END = WS_PW + (size_t)DEPTH * M * D * 2;
constexpr int SM_YS = 0;
constexpr int SM_ST = SM_YS + 2 * 8 * 2048;
constexpr int SM_RUP = SM_ST + 64;
constexpr int SM_RD = SM_RUP + 8 * NUP;
constexpr int SM_RIN = SM_RD + 8 * D;
constexpr int SM_MIX = SM_RIN + 8 * INW;
constexpr int SM_AP = SM_MIX + 8 * D;
constexpr int SM_PWS = SM_AP + 192 * 136;
constexpr int SM_RDB = SM_PWS + DEPTH * 8 * D;
constexpr int SM_HS = SM_RDB + 8 * D;
constexpr int SM_END = SM_HS + 8 * FF / 4;
static_assert(SM_END * 4 <= (2 << 20), "sample scratch");

constexpr int RING_BYTES = 131072, MISC_OFF = RING_BYTES + 320, LDS_BYTES = 147456;

__device__ __forceinline__ float bf2f(unsigned short u) { return __uint_as_float((unsigned)u << 16); }
__device__ __forceinline__ float bflo(unsigned u) { return __uint_as_float(u << 16); }
__device__ __forceinline__ float bfhi(unsigned u) { return __uint_as_float(u & 0xffff0000u); }
__device__ __forceinline__ unsigned pk(float lo, float hi) { return pg8::cvt_pk_bf16(lo, hi); }
__device__ __forceinline__ float shx(float v, int m, int lane) { return __int_as_float(__builtin_amdgcn_ds_bpermute((lane ^ m) << 2, __float_as_int(v))); }
__device__ __forceinline__ float sigmoid_f(float v) { return __builtin_amdgcn_rcpf(1.f + __builtin_amdgcn_exp2f(-v * LOG2E)); }

__device__ __forceinline__ float clamp448(float v) { return __builtin_amdgcn_fmed3f(v, -448.f, 448.f); }
__device__ __forceinline__ unsigned pk8(float a, float b, float c, float d) { int w = 0; w = __builtin_amdgcn_cvt_pk_fp8_f32(clamp448(a), clamp448(b), w, false); w = __builtin_amdgcn_cvt_pk_fp8_f32(clamp448(c), clamp448(d), w, true); return (unsigned)w; }
__device__ __forceinline__ unsigned pk8u(float a, float b, float c, float d) { int w = 0; w = __builtin_amdgcn_cvt_pk_fp8_f32(a, b, w, false); w = __builtin_amdgcn_cvt_pk_fp8_f32(c, d, w, true); return (unsigned)w; }
__device__ __forceinline__ float up8(unsigned w, int sel) { return sel == 0 ? __builtin_amdgcn_cvt_f32_fp8((int)w, 0) : sel == 1 ? __builtin_amdgcn_cvt_f32_fp8((int)w, 1) : sel == 2 ? __builtin_amdgcn_cvt_f32_fp8((int)w, 2) : __builtin_amdgcn_cvt_f32_fp8((int)w, 3); }
constexpr float W8S = 256.f, H8S = 64.f;

__device__ __forceinline__ void row_stats(const float* st, int row, float& mu, float& rs) {
    const f32x4* p = (const f32x4*)(st + (size_t)row * 16);
    const f32x4 a = p[0], b = p[1], c = p[2], d = p[3];
    const float s = ((a.x + a.z) + (b.x + b.z)) + ((c.x + c.z) + (d.x + d.z));
    const float q = ((a.y + a.w) + (b.y + b.w)) + ((c.y + c.w) + (d.y + d.w));
    mu = s * (1.f / 2048.f);
    const float var = fmaxf(q * (1.f / 2048.f) - mu * mu, 0.f);
    rs = 1.0f / sqrtf(var + LN_EPS);
}

constexpr int TAB_OFF = RING_BYTES + 1024;
template <class Sched> __device__ __forceinline__ void stats_table_fill(PG8_LAS unsigned char* lds, const Sched& S, const float* st, int tid) {
    PG8_LAS f32x2* tab = (PG8_LAS f32x2*)(lds + TAB_OFF);
#pragma unroll
    for (int k = 0; k < 3; ++k) {
        const int e = tid + 512 * k, slot = e >> 8, r = e & 255;
        Unit u;
        if (S.next(slot, u)) { float mu, rs; row_stats(st, u.pm * 256 + r, mu, rs); tab[e] = (f32x2){mu, rs}; }
    }
    __syncthreads();
}
__device__ __forceinline__ f32x2 tab_get(const Unit& u, int rowlocal) { extern __shared__ __attribute__((aligned(16))) unsigned char lds_tab_[]; return ((const PG8_LAS f32x2*)((PG8_LAS unsigned char*)lds_tab_ + TAB_OFF))[u.idx * 256 + rowlocal]; }

struct TailOrder {
    pg8::StaticOrder base; int first, nfull, c, total;
    __device__ bool next(int i, Unit& u) const {
        const int F = first + i * nfull + (c % nfull);
        if (c >= 2 * nfull || F >= total) return false;
        pg8::StaticOrder b = base; b.lim = b.nwg; b.G = 1; b.c = 0;
        if (!b.next(F, u)) return false;
        u.idx = i; u.half = c / nfull; return true;
    }
    __device__ __forceinline__ void a_ready(const Unit&) const {}
    __device__ __forceinline__ void done(const Unit&) const {}
};
struct ChainOrder {
    static constexpr bool HAS_CHAIN = true;
    pg8::StaticOrder base; int first, nfull;
    __device__ bool next(int i, Unit& u) const { return base.next(i, u); }
    __device__ bool chain(Unit& u) const { const TailOrder t{base, first, nfull, base.c, base.nwg}; return t.next(0, u); }
    __device__ __forceinline__ void a_ready(const Unit&) const {}
    __device__ __forceinline__ void done(const Unit&) const {}
};
__device__ __forceinline__ void stats_table_fill_half(PG8_LAS unsigned char* lds, const TailOrder& S, const float* st, int tid) {
    PG8_LAS f32x2* tab = (PG8_LAS f32x2*)(lds + TAB_OFF);
#pragma unroll
    for (int k = 0; k < 3; ++k) {
        const int e = tid + 512 * k, slot = e >> 7, r = e & 127;
        Unit u;
        if (S.next(slot, u)) { float mu, rs; row_stats(st, u.pm * 256 + u.half * 128 + r, mu, rs); tab[e] = (f32x2){mu, rs}; }
    }
    __syncthreads();
}
__device__ __forceinline__ f32x2 tab_get_half(const Unit& u, int rowlocal128) { extern __shared__ __attribute__((aligned(16))) unsigned char lds_tab_[]; return ((const PG8_LAS f32x2*)((PG8_LAS unsigned char*)lds_tab_ + TAB_OFF))[u.idx * 128 + rowlocal128]; }

template <class Sched> struct PreTab { PG8_LAS unsigned char* lds; const Sched& S; const float* st; int tid; int on;
    __device__ __forceinline__ void operator()() const { if (on) stats_table_fill(lds, S, st, tid); } };
struct PreTabHalf { PG8_LAS unsigned char* lds; const TailOrder& S; const float* st; int tid; int on;
    __device__ __forceinline__ void operator()() const { if (on) stats_table_fill_half(lds, S, st, tid); } };

template <bool HALF_M> struct EpiSwiGLU {
    static constexpr bool PERM = true, AFTER_DRAIN = false; static constexpr int NSTORE = HALF_M ? 4 : 8;
    unsigned char* H; const float* st; const float* c1; const float* c2; int ident;
#if defined(MK_PROBE)
    int nost;
#endif
    __device__ __forceinline__ void operator()(const f32x4 (&acc)[2][2][4][2], const Unit& u, int wr, int wc, int fr, int fq) const {
#if defined(MK_PROBE)
        if (nost & 2) return;
#endif
        const int hoff = HALF_M ? u.half * 128 : 0, row0 = u.pm * 256 + hoff + wr * 64 + fr;
        const int nc = u.pn * 256 + wc * 32 + 8 * fq, hc = u.pn * 128 + wc * 32 + 8 * fq;
        f32x4 c1g[2], c2g[2], c1u[2], c2u[2];
#pragma unroll
        for (int n = 0; n < 2; ++n) {
            if (ident) { c1g[n] = (f32x4){0.f, 0.f, 0.f, 0.f}; c2g[n] = c1g[n]; c1u[n] = c1g[n]; c2u[n] = c1g[n]; }
            else { c1g[n] = *(const f32x4*)(c1 + nc + 4 * n); c2g[n] = *(const f32x4*)(c2 + nc + 4 * n); c1u[n] = *(const f32x4*)(c1 + nc + 128 + 4 * n) * H8S; c2u[n] = *(const f32x4*)(c2 + nc + 128 + 4 * n) * H8S; }
        }
#pragma unroll
        for (int ai = 0; ai < (HALF_M ? 1 : 2); ++ai)
#pragma unroll
            for (int m = 0; m < 4; ++m) {
                const int r = row0 + ai * 128 + m * 16;
                float mu = 0.f, rs = 1.f;
                if (!ident) { const f32x2 ms = HALF_M ? tab_get_half(u, wr * 64 + m * 16 + fr) : tab_get(u, ai * 128 + wr * 64 + m * 16 + fr); mu = ms.x; rs = ms.y; }
                u32x2 w;
                const float rsg = rs * (1.f / W8S), rsu = rs * (H8S / W8S), nm = -mu * rs;
#pragma unroll
                for (int n = 0; n < 2; ++n) {
                    const f32x4 g4 = acc[ai][0][m][n] * rsg + (c1g[n] * nm + c2g[n]);
                    const f32x4 u4 = acc[ai][1][m][n] * rsu + (c1u[n] * nm + c2u[n]);
                    float h4[4];
#pragma unroll
                    for (int e = 0; e < 4; ++e) h4[e] = g4[e] * u4[e] * sigmoid_f(g4[e]);
                    w[n] = pk8(h4[0], h4[1], h4[2], h4[3]);
                }
#if defined(MK_PROBE)
                if (nost & 1) { asm volatile("" :: "v"(w)); continue; }
#endif
                *(u32x2*)(H + (size_t)r * FF + hc) = w;
            }
    }
};
struct EpiIn {
    static constexpr bool PERM = true, AFTER_DRAIN = false; static constexpr int NSTORE = 16;
    bf16_t* Z; float* kout; float* vout; const float* st; const float* c1; const float* c2;
    __device__ __forceinline__ void operator()(const f32x4 (&acc)[2][2][4][2], const Unit& u, int wr, int wc, int fr, int fq) const {
        const int row0 = u.pm * 256 + wr * 64 + fr, colb = u.pn * 256 + wc * 32 + 8 * fq;
        const float sc = (u.pn == 14 || u.pn == 15) ? 0.125f : 1.f;
        f32x4 c1v[2][2], c2v[2][2];
#pragma unroll
        for (int bj = 0; bj < 2; ++bj)
#pragma unroll
            for (int n = 0; n < 2; ++n) { c1v[bj][n] = *(const f32x4*)(c1 + colb + bj * 128 + 4 * n); c2v[bj][n] = *(const f32x4*)(c2 + colb + bj * 128 + 4 * n); }
#pragma unroll
        for (int ai = 0; ai < 2; ++ai)
#pragma unroll
            for (int m = 0; m < 4; ++m) {
                const int r = row0 + ai * 128 + m * 16;
                const f32x2 ms = tab_get(u, ai * 128 + wr * 64 + m * 16 + fr); const float mu = ms.x, rs = ms.y;
#pragma unroll
                for (int bj = 0; bj < 2; ++bj) {
                    const int col = colb + bj * 128;
                    const f32x4 z0 = (acc[ai][bj][m][0] - mu * c1v[bj][0]) * rs + c2v[bj][0];
                    const f32x4 z1 = (acc[ai][bj][m][1] - mu * c1v[bj][1]) * rs + c2v[bj][1];
                    if (u.pn >= 4 && u.pn < 12) {
                        float* dst = (u.pn < 8) ? (kout + (size_t)r * 1024 + (col - 1024)) : (vout + (size_t)r * 1024 + (col - 2048));
                        __builtin_nontemporal_store(z0, (f32x4*)dst); __builtin_nontemporal_store(z1, (f32x4*)(dst + 4));
                    }
                    u32x4 w; w.x = pk(z0[0] * sc, z0[1] * sc); w.y = pk(z0[2] * sc, z0[3] * sc); w.z = pk(z1[0] * sc, z1[1] * sc); w.w = pk(z1[2] * sc, z1[3] * sc);
                    *(u32x4*)(Z + (size_t)r * INW + col) = w;
                }
            }
    }
};
struct EpiPlain {
    static constexpr bool PERM = true, AFTER_DRAIN = false; static constexpr int NSTORE = 16;
    bf16_t* O; int ldc;
    __device__ __forceinline__ void operator()(const f32x4 (&acc)[2][2][4][2], const Unit& u, int wr, int wc, int fr, int fq) const {
        const int row0 = u.pm * 256 + wr * 64 + fr;
#pragma unroll
        for (int ai = 0; ai < 2; ++ai)
#pragma unroll
            for (int m = 0; m < 4; ++m)
#pragma unroll
                for (int bj = 0; bj < 2; ++bj) {
                    const int r = row0 + ai * 128 + m * 16, col = u.pn * 256 + bj * 128 + wc * 32 + 8 * fq;
                    const f32x4 z0 = acc[ai][bj][m][0], z1 = acc[ai][bj][m][1];
                    u32x4 w; w.x = pk(z0[0], z0[1]); w.y = pk(z0[2], z0[3]); w.z = pk(z1[0], z1[1]); w.w = pk(z1[2], z1[3]);
                    *(u32x4*)(O + (size_t)r * ldc + col) = w;
                }
    }
};
constexpr int PLE_TSTEP = (int)(LW * 2 / (256 * PLE * 2));
static_assert((LW * 2) % (256 * PLE * 2) == 0, "layer stride is a whole number of w_ple tile steps");
struct PleOrder {
    pg8::StaticOrder base;
    __device__ bool next(int i, Unit& u) const { if (i >= DEPTH || !base.next(0, u)) return false; u.pm += 32 * i; u.pn += PLE_TSTEP * i; u.idx = i; return true; }
    __device__ __forceinline__ void a_ready(const Unit&) const {}
    __device__ __forceinline__ void done(const Unit&) const {}
};
struct EpiPle {
    static constexpr bool PERM = true, AFTER_DRAIN = false; static constexpr int NSTORE = 16;
    bf16_t* O;
    __device__ __forceinline__ void operator()(const f32x4 (&acc)[2][2][4][2], const Unit& u, int wr, int wc, int fr, int fq) const {
        const int l = u.idx, pm0 = u.pm - 32 * l, pn0 = u.pn - PLE_TSTEP * l, row0 = pm0 * 256 + wr * 64 + fr;
        bf16_t* Ol = O + (size_t)l * M * D;
#pragma unroll
        for (int ai = 0; ai < 2; ++ai)
#pragma unroll
            for (int m = 0; m < 4; ++m)
#pragma unroll
                for (int bj = 0; bj < 2; ++bj) {
                    const int r = row0 + ai * 128 + m * 16, col = pn0 * 256 + bj * 128 + wc * 32 + 8 * fq;
                    const f32x4 z0 = acc[ai][bj][m][0], z1 = acc[ai][bj][m][1];
                    u32x4 w; w.x = pk(z0[0], z0[1]); w.y = pk(z0[2], z0[3]); w.z = pk(z1[0], z1[1]); w.w = pk(z1[2], z1[3]);
                    *(u32x4*)(Ol + (size_t)r * D + col) = w;
                }
    }
};
template <int MODE, bool HALF_M = false> struct EpiRes {
    static constexpr bool PERM = true, AFTER_DRAIN = true; static constexpr int NSTORE = 0;
    const float* prev32; const bf16_t* prevb; bf16_t* ybout; const float* st_prev; float* st_next; const float* g; const float* b; int ident; float scale;
    const bf16_t* pw; const float* c1; const float* c2; unsigned char* y8;
    __device__ __forceinline__ void fused(f32x4 (&acc)[2][2][4][2], const Unit& u, int wr, int wc, int fr, int fq, PG8_LAS unsigned char* lds, int wid, int lane) const {
        asm volatile("" : "+v"(lane));
        fr = lane & 15; fq = lane >> 4;
        const int hoff = HALF_M ? u.half * 128 : 0, col0 = u.pn * 256 + wc * 32 + 8 * fq, rowb = u.pm * 256 + hoff + wr * 64 + fr, cl0 = wc * 32 + 8 * fq;
        PG8_LAS f32x2* P = (PG8_LAS f32x2*)lds;
        PG8_LAS float* CVL = (PG8_LAS float*)(lds + 8192);
        {   const int t = wid * 64 + lane, cc = u.pn * 256 + (t & 255);
            if (t < 256) { CVL[t] = ident ? 1.f : g[cc]; CVL[256 + t] = ident ? 0.f : b[cc]; }
            else if (MODE == 1) { CVL[512 + (t & 255)] = c1[cc]; CVL[768 + (t & 255)] = c2[cc]; } }
        constexpr bool BOTH = (MODE == 0) && !HALF_M;
        u32x4 pvall[2][4][2];
        if constexpr (BOTH) {
#pragma unroll
            for (int a2 = 0; a2 < 2; ++a2)
#pragma unroll
                for (int m = 0; m < 4; ++m)
#pragma unroll
                    for (int bj = 0; bj < 2; ++bj) pvall[a2][m][bj] = ident ? (u32x4){0u, 0u, 0u, 0u} : *(const u32x4*)(prevb + (size_t)(rowb + a2 * 128 + m * 16) * D + col0 + bj * 128);
        }
#pragma unroll
        for (int ai = 0; ai < (HALF_M ? 1 : 2); ++ai) {
            u32x4 (&pv)[4][2] = pvall[ai]; u32x4 pq[4][2];
#pragma unroll
            for (int m = 0; m < 4; ++m)
#pragma unroll
                for (int bj = 0; bj < 2; ++bj) {
                    const size_t off = (size_t)(rowb + ai * 128 + m * 16) * D + col0 + bj * 128;
                    if constexpr (!BOTH) pv[m][bj] = ident ? (u32x4){0u, 0u, 0u, 0u} : *(const u32x4*)(prevb + off);
                    pq[m][bj] = (MODE == 1) ? *(const u32x4*)(pw + off) : (u32x4){0u, 0u, 0u, 0u};
                }
            if (ai == 0) __syncthreads();
#pragma unroll
            for (int m = 0; m < 4; ++m) {
                const int r = rowb + ai * 128 + m * 16;
                float mu = 0.f, rs = 1.f, ssum = 0.f, ssq = 0.f;
                if (!ident) { const f32x2 ms = HALF_M ? tab_get_half(u, wr * 64 + m * 16 + fr) : tab_get(u, ai * 128 + wr * 64 + m * 16 + fr); mu = ms.x; rs = ms.y; }
#pragma unroll
                for (int bj = 0; bj < 2; ++bj) {
                    const size_t offb = (size_t)r * D + col0 + bj * 128;
                    u32x4 wo; u32x2 w8;
#pragma unroll
                    for (int n = 0; n < 2; ++n) {
                        const int cl = cl0 + bj * 128 + 4 * n;
                        const unsigned pa = pv[m][bj][2 * n], pb = pv[m][bj][2 * n + 1], qa = pq[m][bj][2 * n], qb = pq[m][bj][2 * n + 1];
                        f32x4 x;
                        if (ident) x = *(const f32x4*)(prev32 + offb + 4 * n);
                        else { const f32x4 pvv = (f32x4){bflo(pa), bfhi(pa), bflo(pb), bfhi(pb)}; x = (pvv - mu) * rs * (*(const PG8_LAS f32x4*)(CVL + cl)) + *(const PG8_LAS f32x4*)(CVL + 256 + cl); }
                        const f32x4 a = acc[ai][bj][m][n];
                        f32x4 t;
                        if (MODE == 0) t = a * scale;
                        else {
                            const f32x4 zf = (a - mu * (*(const PG8_LAS f32x4*)(CVL + 512 + cl))) * rs + *(const PG8_LAS f32x4*)(CVL + 768 + cl);
                            t[0] = bflo(qa) * sigmoid_f(zf[0]); t[1] = bfhi(qa) * sigmoid_f(zf[1]); t[2] = bflo(qb) * sigmoid_f(zf[2]); t[3] = bfhi(qb) * sigmoid_f(zf[3]);
                        }
                        const f32x4 y = x * ALPHA + t;
                        const unsigned w0 = pk(y[0], y[1]), w1 = pk(y[2], y[3]);
                        wo[2 * n] = w0; wo[2 * n + 1] = w1;
                        w8[n] = pk8(y[0], y[1], y[2], y[3]);
                        const float y0 = bflo(w0), y1 = bfhi(w0), y2 = bflo(w1), y3 = bfhi(w1);
                        ssum += (y0 + y1) + (y2 + y3);
                        ssq += (y0 * y0 + y1 * y1) + (y2 * y2 + y3 * y3);
                    }
                    *(u32x4*)(ybout + offb) = wo;
                    if (y8) *(u32x2*)(y8 + offb) = w8;
                }
                ssum += shx(ssum, 16, lane); ssum += shx(ssum, 32, lane); ssq += shx(ssq, 16, lane); ssq += shx(ssq, 32, lane);
                if (fq == 0) P[(ai * 128 + wr * 64 + m * 16 + fr) * 4 + wc] = (f32x2){ssum, ssq};
            }
        }
        __syncthreads();
        const int tid = wid * 64 + lane;
        if (tid < (HALF_M ? 128 : 256)) {
            const f32x2 a0 = P[tid * 4 + 0], a1 = P[tid * 4 + 1], a2 = P[tid * 4 + 2], a3 = P[tid * 4 + 3];
            f32x2 o; o.x = (a0.x + a1.x) + (a2.x + a3.x); o.y = (a0.y + a1.y) + (a2.y + a3.y);
            *(f32x2*)(st_next + (size_t)(u.pm * 256 + hoff + tid) * 16 + u.pn * 2) = o;
        }
        __syncthreads();
    }
};

struct TrCtx { const float* W; bf16_t* WT; const float* gk; const float* bk; float* p1; float* p2; int K, N, drow0, n0, k0, f8; };
__device__ __forceinline__ void tr_load(const TrCtx& c, int lane, float (&wv)[32], float (&gv)[8], float (&bv)[8]) {
    const int cc = lane & 7;
#pragma unroll
    for (int e = 0; e < 8; ++e) { gv[e] = 1.f; bv[e] = 0.f; }
    if (c.gk) {
        const f32x4 g0 = *(const f32x4*)(c.gk + c.k0 + 8 * cc), g1 = *(const f32x4*)(c.gk + c.k0 + 8 * cc + 4), b0 = *(const f32x4*)(c.bk + c.k0 + 8 * cc), b1 = *(const f32x4*)(c.bk + c.k0 + 8 * cc + 4);
#pragma unroll
        for (int e = 0; e < 4; ++e) { gv[e] = g0[e]; gv[4 + e] = g1[e]; bv[e] = b0[e]; bv[4 + e] = b1[e]; }
    }
    const float* wp = c.W + (size_t)(c.k0 + (lane >> 5)) * c.N + c.n0 + (lane & 31);
#pragma unroll
    for (int i = 0; i < 32; ++i) wv[i] = __builtin_nontemporal_load(wp + (size_t)(2 * i) * c.N);
}
__device__ __forceinline__ void tr_proc(const TrCtx& c, PG8_LAS float* scr, int lane, const float (&wv)[32], const float (&gv)[8], const float (&bv)[8]) {
    const int cc = lane & 7;
#pragma unroll
    for (int i = 0; i < 32; ++i) scr[(2 * i + (lane >> 5)) * 33 + (lane & 31)] = wv[i];
    asm volatile("s_waitcnt lgkmcnt(0)" ::: "memory");
#pragma unroll
    for (int j = 0; j < 4; ++j) {
        const int n = (lane >> 3) + 8 * j; const PG8_LAS float* s = scr + (8 * cc) * 33 + n;
        float w[8];
#pragma unroll
        for (int e = 0; e < 8; ++e) w[e] = s[e * 33];
        float r1 = 0.f;
        if (c.f8) {
            float ws8[8];
#pragma unroll
            for (int e = 0; e < 8; ++e) ws8[e] = __builtin_amdgcn_fmed3f(w[e] * gv[e] * W8S, -448.f, 448.f);
            u32x2 o; o.x = pk8u(ws8[0], ws8[1], ws8[2], ws8[3]); o.y = pk8u(ws8[4], ws8[5], ws8[6], ws8[7]);
            __builtin_nontemporal_store(o, (u32x2*)((unsigned char*)c.WT + (size_t)(c.drow0 + n) * c.K + c.k0 + 8 * cc));
            if (c.gk) r1 = (((up8(o.x, 0) + up8(o.x, 1)) + (up8(o.x, 2) + up8(o.x, 3))) + ((up8(o.y, 0) + up8(o.y, 1)) + (up8(o.y, 2) + up8(o.y, 3)))) * (1.f / W8S);
        } else {
            u32x4 o; o.x = pk(w[0] * gv[0], w[1] * gv[1]); o.y = pk(w[2] * gv[2], w[3] * gv[3]); o.z = pk(w[4] * gv[4], w[5] * gv[5]); o.w = pk(w[6] * gv[6], w[7] * gv[7]);
            __builtin_nontemporal_store(o, (u32x4*)(c.WT + (size_t)(c.drow0 + n) * c.K + c.k0 + 8 * cc));
            if (c.gk) r1 = ((bflo(o.x) + bfhi(o.x)) + (bflo(o.y) + bfhi(o.y))) + ((bflo(o.z) + bfhi(o.z)) + (bflo(o.w) + bfhi(o.w)));
        }
        if (c.gk) {
            float r2 = 0.f;
#pragma unroll
            for (int e = 0; e < 8; ++e) r2 = fmaf(bv[e], w[e], r2);
            r1 += shx(r1, 1, lane); r1 += shx(r1, 2, lane); r1 += shx(r1, 4, lane);
            r2 += shx(r2, 1, lane); r2 += shx(r2, 2, lane); r2 += shx(r2, 4, lane);
            if (cc == 0) { c.p1[c.drow0 + n] = r1; c.p2[c.drow0 + n] = r2; }
        }
    }
    asm volatile("s_waitcnt lgkmcnt(0)" ::: "memory");
}
}

namespace mk {
typedef short bf16x8 __attribute__((ext_vector_type(8)));
#define MK_LAS __attribute__((address_space(3)))
#define MK_OPQF(name, val) float name = (val); asm volatile("" : "+v"(name))
__device__ __forceinline__ f32x4 mfma16(bf16x8 a, bf16x8 b, f32x4 c) { return __builtin_amdgcn_mfma_f32_16x16x32_bf16(a, b, c, 0, 0, 0); }
__device__ __forceinline__ s16x4 tr_rd(MK_LAS unsigned char* p) { return __builtin_bit_cast(s16x4, __builtin_amdgcn_ds_read_tr16_b64_v4i16((MK_LAS s16x4*)p)); }
__device__ __forceinline__ bf16x8 cat8(s16x4 a, s16x4 b) { return (bf16x8){a[0], a[1], a[2], a[3], b[0], b[1], b[2], b[3]}; }
__device__ __forceinline__ unsigned offb(unsigned row, unsigned ch) { return 256u * row + 16u * (ch ^ (((row & 3u) << 2) | ((row >> 2) & 3u))); }
__device__ __forceinline__ void glds16(const void* g, MK_LAS unsigned char* l) { __builtin_amdgcn_global_load_lds((const unsigned*)g, (MK_LAS unsigned*)l, 16, 0, 0); }
__device__ __forceinline__ void st_bf16(bf16_t* p, float v) { *p = (bf16_t)(pk(v, 0.f) & 0xffffu); }

struct AttnP { int b, h, gsel, r, nbk, kbeg, dsh; };
__device__ __forceinline__ AttnP attn_decode(int unit) {
    AttnP p; const int bh = unit / 48, rest = unit % 48, x = rest & 15; p.gsel = rest >> 4; p.b = bh >> 3; p.h = bh & 7; p.dsh = 2 * p.gsel;
    p.r = (p.gsel == 0) ? 0 : (p.gsel == 1 ? (x & 3) : x); p.nbk = (p.gsel == 0) ? x : (p.gsel == 1 ? (x >> 2) : 0); p.kbeg = (p.nbk == 0) ? 128 : 0; return p;
}
__device__ __forceinline__ void attn_stage(MK_LAS unsigned char* img, const bf16_t* Z, const AttnP& p, int coff, int wave, int lane) {
    const __amdgpu_buffer_rsrc_t rz = __builtin_amdgcn_make_buffer_rsrc((void*)Z, (short)0, 0x7fffffff, 0x00020000);
#pragma unroll
    for (int it = 0; it < 8; ++it) {
        const int inst = wave * 8 + it;
        if (inst * 4 >= p.kbeg) {
            const int row = 4 * inst + (lane >> 4), pc = lane & 15, ch = pc ^ (((row & 3) << 2) | ((row >> 2) & 3));
            const int t = ((128 * (p.nbk - 1) + row) << p.dsh) + p.r;
            const unsigned off = (unsigned)(((p.b * T + t) * INW + coff + p.h * 128 + ch * 8) * 2);
            __builtin_amdgcn_raw_ptr_buffer_load_lds(rz, (MK_LAS void*)(img + inst * 1024), 16, (int)off, 0, 0, 0);
        }
    }
}
__device__ __forceinline__ void attn_loadq(bf16x8 (&qf)[4], const bf16_t* Z, const AttnP& p, int wave, int lane) {
    const int qi = 16 * wave + (lane & 15);
    const bf16_t* qp = Z + ((size_t)p.b * T + (((128 * p.nbk + qi) << p.dsh) + p.r)) * INW + p.h * 128 + 8 * (lane >> 4);
#pragma unroll
    for (int ks = 0; ks < 4; ++ks) qf[ks] = *(const bf16x8*)(qp + 32 * ks);
}
#define MK_WAITBAR() do { asm volatile("s_waitcnt vmcnt(0) lgkmcnt(0)" ::: "memory"); __builtin_amdgcn_s_barrier(); asm volatile("" ::: "memory"); } while (0)
__device__ __forceinline__ void attn_phase(MK_LAS unsigned char* lds, const bf16_t* Z, bf16_t* OG, float* LSE, int first, int stride, int nunits, int wave, int lane) {
    asm volatile("" : "+v"(lane));
    MK_LAS unsigned char* KI = lds; MK_LAS unsigned char* VI = lds + 65536;
    const int fr = lane & 15, fq = lane >> 4, q4 = (lane & 15) >> 2, p4 = lane & 3;
    if (first >= nunits) return;
    AttnP p = attn_decode(first);
    bf16x8 qf[4];
    attn_stage(KI, Z, p, 1024, wave, lane);
    attn_loadq(qf, Z, p, wave, lane);
    const int s_lo = wave >> 1, s_hi = (wave >> 1) + 4;
    u32x4 dw[4]; float dl = 0.f; unsigned dofs = 0u, dlofs = 0u; bool dhave = false;
#define MK_ATTN_FLUSH() do { if (dhave) { _Pragma("unroll") for (int cp = 0; cp < 4; ++cp) *(u32x4*)(OG + dofs + 32 * cp) = dw[cp]; if (fq == 0) LSE[dlofs] = dl; } } while (0)
    for (int unit = first; unit < nunits; unit += stride) {
        const int qi = 16 * wave + fr;
        const size_t rowb = (size_t)p.b * T;
        MK_WAITBAR();
        asm volatile("" : "+v"(qf[0]), "+v"(qf[1]), "+v"(qf[2]), "+v"(qf[3]));
        attn_stage(VI, Z, p, 2048, wave, lane);
        MK_ATTN_FLUSH();
        f32x4 S[8][2];
        {
            unsigned kb[2][4];
#pragma unroll
            for (int u = 0; u < 2; ++u)
#pragma unroll
                for (int ks = 0; ks < 4; ++ks) kb[u][ks] = offb(8 * (fr >> 2) + 4 * u + (fr & 3), 4 * ks + fq);
#pragma unroll
            for (int s = 0; s < 8; ++s)
#pragma unroll
                for (int u = 0; u < 2; ++u) {
                    S[s][u] = (f32x4){0.f, 0.f, 0.f, 0.f};
                    if (32 * s >= p.kbeg && s >= s_lo && s <= s_hi) {
#pragma unroll
                        for (int ks = 0; ks < 4; ++ks) { const bf16x8 kf = *(const MK_LAS bf16x8*)(KI + kb[u][ks] + 8192 * s); S[s][u] = mfma16(kf, qf[ks], S[s][u]); }
                    }
                    asm volatile("" ::: "memory");
                }
        }
        MK_OPQF(sc2, 0.08838834764831845f * LOG2E); MK_OPQF(kneg, -1e30f); MK_OPQF(k128, 128.f);
        const float slope2 = __builtin_amdgcn_exp2f(-(float)(p.h + 1)) * LOG2E * (float)(1 << p.dsh);
        float mx = kneg;
        int qo = qi + 128 - 8 * fq; asm volatile("" : "+v"(qo));
        const float qof = (float)qo;
#pragma unroll
        for (int s = 0; s < 8; ++s) {
            const bool son = (32 * s >= p.kbeg) && s >= s_lo && s <= s_hi;
            if (!son) continue;
#pragma unroll
            for (int u = 0; u < 2; ++u)
#pragma unroll
                for (int i = 0; i < 4; ++i) {
                    const float dist = qof - (float)(32 * s + 4 * u + i);
                    const bool valid = son && (dist >= 0.f) && (dist <= k128);
                    const float v = valid ? (S[s][u][i] * sc2 - slope2 * dist) : kneg;
                    S[s][u][i] = v; mx = fmaxf(mx, v);
                }
        }
        mx = fmaxf(mx, shx(mx, 16, lane)); mx = fmaxf(mx, shx(mx, 32, lane));
        float l = 0.f;
        bf16x8 pf[8];
#pragma unroll
        for (int s = 0; s < 8; ++s) {
            if (!(32 * s >= p.kbeg && s >= s_lo && s <= s_hi)) { pf[s] = (bf16x8){0, 0, 0, 0, 0, 0, 0, 0}; continue; }
            float pp[8];
#pragma unroll
            for (int j = 0; j < 8; ++j) { pp[j] = __builtin_amdgcn_exp2f(S[s][j >> 2][j & 3] - mx); l += pp[j]; }
            u32x4 w; w.x = pk(pp[0], pp[1]); w.y = pk(pp[2], pp[3]); w.z = pk(pp[4], pp[5]); w.w = pk(pp[6], pp[7]);
            pf[s] = __builtin_bit_cast(bf16x8, w);
        }
        l += shx(l, 16, lane); l += shx(l, 32, lane);
        MK_WAITBAR();
        const AttnP pc = p;
        const int nu = unit + stride;
        if (nu < nunits) { p = attn_decode(nu); attn_stage(KI, Z, p, 1024, wave, lane); attn_loadq(qf, Z, p, wave, lane); }
        f32x4 O[8];
#pragma unroll
        for (int c = 0; c < 8; ++c) O[c] = (f32x4){0.f, 0.f, 0.f, 0.f};
        {
            unsigned vb[8][2];
            const unsigned vbase = (unsigned)(unsigned long long)VI;
#pragma unroll
            for (int c = 0; c < 8; ++c)
#pragma unroll
                for (int t2 = 0; t2 < 2; ++t2) vb[c][t2] = vbase + offb(8 * fq + q4 + 4 * t2, 4 * (c >> 1) + p4) + 8 * (c & 1);
#pragma unroll
            for (int s = 0; s < 8; ++s) {
                if (32 * s >= pc.kbeg && s >= s_lo && s <= s_hi) {
#pragma unroll
                    for (int ch = 0; ch < 2; ++ch) {
                        s16x4 va[4][2];
#pragma unroll
                        for (int c = 0; c < 4; ++c)
#pragma unroll
                            for (int t2 = 0; t2 < 2; ++t2) asm volatile("ds_read_b64_tr_b16 %0, %1 offset:%2" : "=v"(va[c][t2]) : "v"(vb[4 * ch + c][t2]), "n"(8192 * s));
                        asm volatile("s_waitcnt lgkmcnt(0)" : "+v"(va[0][0]), "+v"(va[0][1]), "+v"(va[1][0]), "+v"(va[1][1]), "+v"(va[2][0]), "+v"(va[2][1]), "+v"(va[3][0]), "+v"(va[3][1]));
#pragma unroll
                        for (int c = 0; c < 4; ++c) O[4 * ch + c] = mfma16(cat8(va[c][0], va[c][1]), pf[s], O[4 * ch + c]);
                    }
                }
                asm volatile("" ::: "memory");
            }
        }
        const float linv = 1.0f / l;
        {
            const int tq = ((128 * pc.nbk + qi) << pc.dsh) + pc.r;
            dofs = (unsigned)((size_t)pc.gsel * M * 1024 + (rowb + tq) * 1024 + pc.h * 128 + 8 * fq);
#pragma unroll
            for (int cp = 0; cp < 4; ++cp) { u32x4 w; w.x = pk(O[2 * cp][0] * linv, O[2 * cp][1] * linv); w.y = pk(O[2 * cp][2] * linv, O[2 * cp][3] * linv); w.z = pk(O[2 * cp + 1][0] * linv, O[2 * cp + 1][1] * linv); w.w = pk(O[2 * cp + 1][2] * linv, O[2 * cp + 1][3] * linv); dw[cp] = w; }
        }
        dlofs = (unsigned)((size_t)pc.gsel * M * 8 + (rowb + (((128 * pc.nbk + qi) << pc.dsh) + pc.r)) * 8 + pc.h);
        dl = (mx + __builtin_amdgcn_logf(l)) * (1.0f / LOG2E);
        dhave = true;
    }
    MK_ATTN_FLUSH();
#undef MK_ATTN_FLUSH
    asm volatile("s_waitcnt lgkmcnt(0)" ::: "memory"); __builtin_amdgcn_s_barrier(); asm volatile("" ::: "memory");
}

constexpr int KP = 144, VP = 320;
__device__ __forceinline__ void stage_rows64(MK_LAS unsigned char* img, const bf16_t* src0  , int tid, bool decay, float l2g) {
#pragma unroll
    for (int i = 0; i < 2; ++i) {
        const int idx = tid + 512 * i, row = idx >> 3, ch = idx & 7;
        u32x4 v = *(const u32x4*)(src0 + (size_t)row * INW + ch * 8);
        if (decay) {
            const float dc = __builtin_amdgcn_exp2f((float)(127 - row) * l2g);
            v.x = pk(bflo(v.x) * dc, bfhi(v.x) * dc); v.y = pk(bflo(v.y) * dc, bfhi(v.y) * dc); v.z = pk(bflo(v.z) * dc, bfhi(v.z) * dc); v.w = pk(bflo(v.w) * dc, bfhi(v.w) * dc);
        }
        *(MK_LAS u32x4*)(img + row * KP + ch * 16) = v;
    }
}
__device__ __forceinline__ void stage_rows128(MK_LAS unsigned char* img, const bf16_t* src0, int tid) {
#pragma unroll
    for (int i = 0; i < 4; ++i) {
        const int idx = tid + 512 * i, row = idx >> 4, ch = idx & 15;
        *(MK_LAS u32x4*)(img + row * VP + ch * 16) = *(const u32x4*)(src0 + (size_t)row * INW + ch * 8);
    }
}
__device__ __forceinline__ void retu_pair(MK_LAS unsigned char* lds, const bf16_t* Z, float* U, int u0, int u1, int tid, int wave, int lane) {
    asm volatile("" : "+v"(lane), "+v"(tid));
    const int half = wave >> 2, unit = half ? u1 : u0, ht = tid & 255, hw = wave & 3;
    MK_LAS unsigned char* KI = lds + half * 65536; MK_LAS unsigned char* VI = KI + 20480;
    const int bh = unit >> 4, c = unit & 15, b = bh >> 3, h = bh & 7;
    const float l2g = log2f(1.f - exp2f(-5.f - (float)h));
    const bf16_t* zr = Z + ((size_t)b * T + 128 * c) * INW;
    if (unit >= 0) {
        u32x4 kv[4], vv[8];
#pragma unroll
        for (int i = 0; i < 4; ++i) { const int idx = ht + 256 * i, row = idx >> 3, ch = idx & 7; kv[i] = *(const u32x4*)(zr + 3584 + h * 64 + (size_t)row * INW + ch * 8); }
#pragma unroll
        for (int i = 0; i < 8; ++i) { const int idx = ht + 256 * i, row = idx >> 4, ch = idx & 15; vv[i] = *(const u32x4*)(zr + 4096 + h * 128 + (size_t)row * INW + ch * 8); }
#pragma unroll
        for (int i = 0; i < 4; ++i) {
            const int idx = ht + 256 * i, row = idx >> 3, ch = idx & 7;
            const float dc = __builtin_amdgcn_exp2f((float)(127 - row) * l2g);
            u32x4 v = kv[i];
            v.x = pk(bflo(v.x) * dc, bfhi(v.x) * dc); v.y = pk(bflo(v.y) * dc, bfhi(v.y) * dc); v.z = pk(bflo(v.z) * dc, bfhi(v.z) * dc); v.w = pk(bflo(v.w) * dc, bfhi(v.w) * dc);
            *(MK_LAS u32x4*)(KI + row * KP + ch * 16) = v;
        }
#pragma unroll
        for (int i = 0; i < 8; ++i) { const int idx = ht + 256 * i, row = idx >> 4, ch = idx & 15; *(MK_LAS u32x4*)(VI + row * VP + ch * 16) = vv[i]; }
    }
    __syncthreads();
    if (unit >= 0) {
        const int fr = lane & 15, fq = lane >> 4, q4 = fr >> 2, p4 = lane & 3, rb = hw;
        f32x4 acc[8];
#pragma unroll
        for (int j = 0; j < 8; ++j) acc[j] = (f32x4){0.f, 0.f, 0.f, 0.f};
#pragma unroll
        for (int ks = 0; ks < 4; ++ks) {
            const int row0 = 32 * ks + 8 * fq + q4;
            const bf16x8 af = cat8(tr_rd(KI + row0 * KP + (16 * rb + 4 * p4) * 2), tr_rd(KI + (row0 + 4) * KP + (16 * rb + 4 * p4) * 2));
#pragma unroll
            for (int j = 0; j < 8; ++j) {
                const bf16x8 bf = cat8(tr_rd(VI + row0 * VP + (16 * j + 4 * p4) * 2), tr_rd(VI + (row0 + 4) * VP + (16 * j + 4 * p4) * 2));
                acc[j] = mfma16(af, bf, acc[j]);
            }
        }
        float* up = U + (size_t)unit * 8192;
#pragma unroll
        for (int j = 0; j < 8; ++j)
#pragma unroll
            for (int i = 0; i < 4; ++i) up[(16 * rb + 4 * fq + i) * 128 + 16 * j + fr] = acc[j][i];
    }
    __syncthreads();
}
__device__ __forceinline__ void retu_units(MK_LAS unsigned char* lds, const bf16_t* Z, float* U, int first, int stride, int nunits, int tid, int wave, int lane) {
    asm volatile("" : "+v"(lane), "+v"(tid));
    if (first >= nunits) return;
    MK_LAS unsigned char* KI = lds; MK_LAS unsigned char* VI = lds + 32768;
    u32x4 kv[2], vv[4];
#define MK_RETU_LOAD(unit_) do { const int bh_ = (unit_) >> 4, c_ = (unit_) & 15, b_ = bh_ >> 3, h_ = bh_ & 7; const bf16_t* zr_ = Z + ((size_t)b_ * T + 128 * c_) * INW; \
        _Pragma("unroll") for (int i = 0; i < 2; ++i) { const int idx = tid + 512 * i, row = idx >> 3, ch = idx & 7; kv[i] = *(const u32x4*)(zr_ + 3584 + h_ * 64 + (size_t)row * INW + ch * 8); } \
        _Pragma("unroll") for (int i = 0; i < 4; ++i) { const int idx = tid + 512 * i, row = idx >> 4, ch = idx & 15; vv[i] = *(const u32x4*)(zr_ + 4096 + h_ * 128 + (size_t)row * INW + ch * 8); } } while (0)
    MK_RETU_LOAD(first);
    for (int unit = first; unit < nunits; unit += stride) {
        const int h = (unit >> 4) & 7;
        const float l2g = log2f(1.f - exp2f(-5.f - (float)h));
#pragma unroll
        for (int i = 0; i < 2; ++i) {
            const int idx = tid + 512 * i, row = idx >> 3, ch = idx & 7;
            const float dc = __builtin_amdgcn_exp2f((float)(127 - row) * l2g);
            u32x4 v = kv[i];
            v.x = pk(bflo(v.x) * dc, bfhi(v.x) * dc); v.y = pk(bflo(v.y) * dc, bfhi(v.y) * dc); v.z = pk(bflo(v.z) * dc, bfhi(v.z) * dc); v.w = pk(bflo(v.w) * dc, bfhi(v.w) * dc);
            *(MK_LAS u32x4*)(KI + row * KP + ch * 16) = v;
        }
#pragma unroll
        for (int i = 0; i < 4; ++i) { const int idx = tid + 512 * i, row = idx >> 4, ch = idx & 15; *(MK_LAS u32x4*)(VI + row * VP + ch * 16) = vv[i]; }
        asm volatile("" ::: "memory");
        if (unit + stride < nunits) MK_RETU_LOAD(unit + stride);
        __syncthreads();
        const int fr = lane & 15, fq = lane >> 4, q4 = fr >> 2, p4 = lane & 3, rb = wave & 3, cb0 = 4 * (wave >> 2);
        f32x4 acc[4];
#pragma unroll
        for (int j = 0; j < 4; ++j) acc[j] = (f32x4){0.f, 0.f, 0.f, 0.f};
#pragma unroll
        for (int ks = 0; ks < 4; ++ks) {
            const int row0 = 32 * ks + 8 * fq + q4;
            const bf16x8 af = cat8(tr_rd(KI + row0 * KP + (16 * rb + 4 * p4) * 2), tr_rd(KI + (row0 + 4) * KP + (16 * rb + 4 * p4) * 2));
#pragma unroll
            for (int j = 0; j < 4; ++j) {
                const bf16x8 bf = cat8(tr_rd(VI + row0 * VP + (16 * (cb0 + j) + 4 * p4) * 2), tr_rd(VI + (row0 + 4) * VP + (16 * (cb0 + j) + 4 * p4) * 2));
                acc[j] = mfma16(af, bf, acc[j]);
            }
        }
        float* up = U + (size_t)unit * 8192;
#pragma unroll
        for (int j = 0; j < 4; ++j)
#pragma unroll
            for (int i = 0; i < 4; ++i) up[(16 * rb + 4 * fq + i) * 128 + 16 * (cb0 + j) + fr] = acc[j][i];
        __syncthreads();
    }
#undef MK_RETU_LOAD
}
struct NoJob { __device__ __forceinline__ void operator()() const {} };
template <class JPre = NoJob, class JPost = NoJob> __device__ __forceinline__ void reto_unit(MK_LAS unsigned char* lds, const bf16_t* Z, const float* U, bf16_t* MIX, const float* gng, const float* gnb, float* sfin  ,
                                          int unit, int tid, int wave, int lane, const JPre& jpre = JPre(), const JPost& jpost = JPost()) {
    asm volatile("" : "+v"(lane), "+v"(tid));
    const int pass = unit >> 8, idx = unit & 255, bh = (idx >> 3) , c = pass ? (idx & 7) : 15 - (idx & 7), b = bh >> 3, h = bh & 7;
    const float l2g = log2f(1.f - exp2f(-5.f - (float)h));
    const float G = __builtin_amdgcn_exp2f(128.f * l2g);
    const size_t row0g = (size_t)b * T + 128 * c;
    const bf16_t* zr = Z + row0g * INW;
    MK_LAS unsigned char* QI = lds; MK_LAS unsigned char* KI = lds + 18432; MK_LAS unsigned char* VI = lds + 36864; MK_LAS unsigned char* SI = lds + 77824;
    const float* ub = U + (size_t)bh * 16 * 8192;
    u32x4 qv[2], kv[2], vv[4];
#pragma unroll
    for (int i = 0; i < 2; ++i) { const int idx = tid + 512 * i, row = idx >> 3, ch = idx & 7; qv[i] = *(const u32x4*)(zr + 3072 + h * 64 + (size_t)row * INW + ch * 8); kv[i] = *(const u32x4*)(zr + 3584 + h * 64 + (size_t)row * INW + ch * 8); }
#pragma unroll
    for (int i = 0; i < 4; ++i) { const int idx = tid + 512 * i, row = idx >> 4, ch = idx & 15; vv[i] = *(const u32x4*)(zr + 4096 + h * 128 + (size_t)row * INW + ch * 8); }
    jpre();
    asm volatile("" ::: "memory");
    {
        f32x4 S[4];
#pragma unroll
        for (int k = 0; k < 4; ++k) S[k] = (f32x4){0.f, 0.f, 0.f, 0.f};
#pragma unroll 4
        for (int cc = 0; cc < c; ++cc) {
            f32x4 v[4];
#pragma unroll
            for (int k = 0; k < 4; ++k) v[k] = *(const f32x4*)(ub + (size_t)cc * 8192 + tid * 4 + 2048 * k);
#pragma unroll
            for (int k = 0; k < 4; ++k) S[k] = S[k] * G + v[k];
        }
#pragma unroll
        for (int k = 0; k < 4; ++k) {
            const int e = tid * 4 + 2048 * k;
            u32x2 w; w.x = pk(S[k][0], S[k][1]); w.y = pk(S[k][2], S[k][3]);
            *(MK_LAS u32x2*)(SI + (e >> 7) * VP + (e & 127) * 2) = w;
            if (c == 15) *(f32x4*)(sfin + (size_t)bh * 8192 + e) = S[k] * G + *(const f32x4*)(ub + (size_t)15 * 8192 + e);
        }
    }
    jpost();
#pragma unroll
    for (int i = 0; i < 2; ++i) { const int idx = tid + 512 * i, row = idx >> 3, ch = idx & 7; *(MK_LAS u32x4*)(QI + row * KP + ch * 16) = qv[i]; *(MK_LAS u32x4*)(KI + row * KP + ch * 16) = kv[i]; }
#pragma unroll
    for (int i = 0; i < 4; ++i) { const int idx = tid + 512 * i, row = idx >> 4, ch = idx & 15; *(MK_LAS u32x4*)(VI + row * VP + ch * 16) = vv[i]; }
    __syncthreads();
    const int fr = lane & 15, fq = lane >> 4, q4 = fr >> 2, p4 = lane & 3, i0 = 16 * wave, smax = wave >> 1;
    bf16x8 qf[2];
#pragma unroll
    for (int ks = 0; ks < 2; ++ks) qf[ks] = *(const MK_LAS bf16x8*)(QI + (i0 + fr) * KP + (32 * ks + 8 * fq) * 2);
    f32x4 O1[8], O2[8];
#pragma unroll
    for (int cb = 0; cb < 8; ++cb) { O1[cb] = (f32x4){0.f, 0.f, 0.f, 0.f}; O2[cb] = O1[cb]; }
    const int iq = i0 + fr;
#pragma unroll
    for (int s = 0; s < 4; ++s) {
        if (s <= smax) {
            float p[8];
#pragma unroll
            for (int u = 0; u < 2; ++u) {
                const int krow = 32 * s + 8 * (fr >> 2) + 4 * u + (fr & 3);
                f32x4 P = (f32x4){0.f, 0.f, 0.f, 0.f};
#pragma unroll
                for (int ks = 0; ks < 2; ++ks) { const bf16x8 kf = *(const MK_LAS bf16x8*)(KI + krow * KP + (32 * ks + 8 * fq) * 2); P = mfma16(kf, qf[ks], P); }
#pragma unroll
                for (int i = 0; i < 4; ++i) { const int kap = 32 * s + 8 * fq + 4 * u + i; p[4 * u + i] = (iq >= kap) ? P[i] * __builtin_amdgcn_exp2f((float)(iq - kap) * l2g) : 0.f; }
            }
            u32x4 w; w.x = pk(p[0], p[1]); w.y = pk(p[2], p[3]); w.z = pk(p[4], p[5]); w.w = pk(p[6], p[7]);
            const bf16x8 pfr = __builtin_bit_cast(bf16x8, w);
            const int row0 = 32 * s + 8 * fq + q4;
#pragma unroll
            for (int cb = 0; cb < 8; ++cb) {
                const int dch = (32 * (cb >> 1) + 8 * p4 + 4 * (cb & 1)) * 2;
                const bf16x8 vf = cat8(tr_rd(VI + row0 * VP + dch), tr_rd(VI + (row0 + 4) * VP + dch));
                O1[cb] = mfma16(vf, pfr, O1[cb]);
            }
        }
    }
#pragma unroll
    for (int ks = 0; ks < 2; ++ks) {
        const int row0 = 32 * ks + 8 * fq + q4;
#pragma unroll
        for (int cb = 0; cb < 8; ++cb) {
            const int dch = (32 * (cb >> 1) + 8 * p4 + 4 * (cb & 1)) * 2;
            const bf16x8 sf = cat8(tr_rd(SI + row0 * VP + dch), tr_rd(SI + (row0 + 4) * VP + dch));
            O2[cb] = mfma16(sf, qf[ks], O2[cb]);
        }
    }
    {
        const int il = i0 + fr;
        const float qd = __builtin_amdgcn_exp2f((float)(il + 1) * l2g);
        float s = 0.f;
#pragma unroll
        for (int cb = 0; cb < 8; ++cb) { O1[cb] = O1[cb] + qd * O2[cb]; s += (O1[cb][0] + O1[cb][1]) + (O1[cb][2] + O1[cb][3]); }
        s += shx(s, 16, lane); s += shx(s, 32, lane);
        const float mu = s * (1.f / 128.f);
        float q = 0.f;
#pragma unroll
        for (int cb = 0; cb < 8; ++cb)
#pragma unroll
            for (int i = 0; i < 4; ++i) { const float dd = O1[cb][i] - mu; q += dd * dd; }
        q += shx(q, 16, lane); q += shx(q, 32, lane);
        const float rstd = 1.0f / sqrtf(q * (1.f / 128.f) + GN_EPS);
        const size_t trow = row0g + il;
        u32x4 gzv[4]; f32x4 g0v[4], g1v[4], b0v[4], b1v[4];
#pragma unroll
        for (int cp = 0; cp < 4; ++cp) {
            const int dv = h * 128 + 32 * cp + 8 * fq;
            gzv[cp] = *(const u32x4*)(Z + trow * INW + 5120 + dv);
            g0v[cp] = *(const f32x4*)(gng + dv); g1v[cp] = *(const f32x4*)(gng + dv + 4); b0v[cp] = *(const f32x4*)(gnb + dv); b1v[cp] = *(const f32x4*)(gnb + dv + 4);
        }
        asm volatile("" ::: "memory");
#pragma unroll
        for (int cp = 0; cp < 4; ++cp) {
            const int dv = h * 128 + 32 * cp + 8 * fq;
            const u32x4 gz = gzv[cp];
            const f32x4 g0 = g0v[cp], g1 = g1v[cp], b0 = b0v[cp], b1 = b1v[cp];
            float r[8];
#pragma unroll
            for (int j = 0; j < 8; ++j) {
                const unsigned gw_ = gz[j >> 1];
                const float gbv = (j & 1) ? bfhi(gw_) : bflo(gw_);
                const float ov = O1[2 * cp + (j >> 2)][j & 3], gg = (j < 4) ? g0[j & 3] : g1[j & 3], bb = (j < 4) ? b0[j & 3] : b1[j & 3];
                r[j] = ((ov - mu) * rstd * gg + bb) * gbv * sigmoid_f(gbv);
            }
            u32x4 w; w.x = pk(r[0], r[1]); w.y = pk(r[2], r[3]); w.z = pk(r[4], r[5]); w.w = pk(r[6], r[7]);
            *(u32x4*)(MIX + trow * D + 1024 + dv) = w;
        }
    }
    __syncthreads();
}
struct CombRegs2 { u32x4 a[2][2], b[2][2], c[2][2]; float l0[2][2], l1[2][2], l2[2][2]; };
__device__ __forceinline__ void combine_load2(const bf16_t* __restrict__ OG, const float* __restrict__ LSE, int t0, int tstride, int lane, CombRegs2& R) {
#pragma unroll
    for (int r = 0; r < 2; ++r)
#pragma unroll
        for (int j = 0; j < 2; ++j) {
            const int t = t0 + r * tstride, c8 = lane + 64 * j, h = c8 >> 4;
            R.l0[r][j] = LSE[(size_t)t * 8 + h]; R.l1[r][j] = LSE[(size_t)M * 8 + (size_t)t * 8 + h]; R.l2[r][j] = LSE[(size_t)2 * M * 8 + (size_t)t * 8 + h];
            R.a[r][j] = *(const u32x4*)(OG + (size_t)t * 1024 + 8 * c8); R.b[r][j] = *(const u32x4*)(OG + (size_t)M * 1024 + (size_t)t * 1024 + 8 * c8); R.c[r][j] = *(const u32x4*)(OG + (size_t)2 * M * 1024 + (size_t)t * 1024 + 8 * c8);
        }
}
__device__ __forceinline__ void combine_finish2(bf16_t* __restrict__ MIX, int t0, int tstride, int lane, const CombRegs2& R) {
#pragma unroll
    for (int r = 0; r < 2; ++r)
#pragma unroll
        for (int j = 0; j < 2; ++j) {
            const int t = t0 + r * tstride, c8 = lane + 64 * j;
            const float mx = fmaxf(R.l0[r][j], fmaxf(R.l1[r][j], R.l2[r][j]));
            float w0 = __builtin_amdgcn_exp2f((R.l0[r][j] - mx) * LOG2E), w1 = __builtin_amdgcn_exp2f((R.l1[r][j] - mx) * LOG2E), w2 = __builtin_amdgcn_exp2f((R.l2[r][j] - mx) * LOG2E);
            const float inv = 1.0f / (w0 + w1 + w2); w0 *= inv; w1 *= inv; w2 *= inv;
            u32x4 o;
#pragma unroll
            for (int e = 0; e < 4; ++e) o[e] = pk(w0 * bflo(R.a[r][j][e]) + w1 * bflo(R.b[r][j][e]) + w2 * bflo(R.c[r][j][e]), w0 * bfhi(R.a[r][j][e]) + w1 * bfhi(R.b[r][j][e]) + w2 * bfhi(R.c[r][j][e]));
            *(u32x4*)(MIX + (size_t)t * D + 8 * c8) = o;
        }
}
template <int NR> __device__ __forceinline__ void combine_rows(const bf16_t* __restrict__ OG, const float* __restrict__ LSE, bf16_t* __restrict__ MIX, int t0, int tstride, int lane) {
    asm volatile("" : "+v"(lane));
    u32x4 a[NR][2], b[NR][2], c[NR][2]; float l0[NR][2], l1[NR][2], l2[NR][2];
#pragma unroll
    for (int r = 0; r < NR; ++r)
#pragma unroll
        for (int j = 0; j < 2; ++j) {
            const int t = t0 + r * tstride, c8 = lane + 64 * j, h = c8 >> 4;
            l0[r][j] = LSE[(size_t)t * 8 + h]; l1[r][j] = LSE[(size_t)M * 8 + (size_t)t * 8 + h]; l2[r][j] = LSE[(size_t)2 * M * 8 + (size_t)t * 8 + h];
            a[r][j] = *(const u32x4*)(OG + (size_t)t * 1024 + 8 * c8); b[r][j] = *(const u32x4*)(OG + (size_t)M * 1024 + (size_t)t * 1024 + 8 * c8); c[r][j] = *(const u32x4*)(OG + (size_t)2 * M * 1024 + (size_t)t * 1024 + 8 * c8);
        }
#pragma unroll
    for (int r = 0; r < NR; ++r)
#pragma unroll
        for (int j = 0; j < 2; ++j) {
            const int t = t0 + r * tstride, c8 = lane + 64 * j;
            const float mx = fmaxf(l0[r][j], fmaxf(l1[r][j], l2[r][j]));
            float w0 = __builtin_amdgcn_exp2f((l0[r][j] - mx) * LOG2E), w1 = __builtin_amdgcn_exp2f((l1[r][j] - mx) * LOG2E), w2 = __builtin_amdgcn_exp2f((l2[r][j] - mx) * LOG2E);
            const float inv = 1.0f / (w0 + w1 + w2); w0 *= inv; w1 *= inv; w2 *= inv;
            u32x4 o;
#pragma unroll
            for (int e = 0; e < 4; ++e) o[e] = pk(w0 * bflo(a[r][j][e]) + w1 * bflo(b[r][j][e]) + w2 * bflo(c[r][j][e]), w0 * bfhi(a[r][j][e]) + w1 * bfhi(b[r][j][e]) + w2 * bfhi(c[r][j][e]));
            *(u32x4*)(MIX + (size_t)t * D + 8 * c8) = o;
        }
}

__device__ __forceinline__ void ld8(const float* p, float (&v)[8]) { const f32x4 a = *(const f32x4*)p, b = *(const f32x4*)(p + 4); v[0] = a[0]; v[1] = a[1]; v[2] = a[2]; v[3] = a[3]; v[4] = b[0]; v[5] = b[1]; v[6] = b[2]; v[7] = b[3]; }
struct ABDirect { const float* src; int ld; __device__ __forceinline__ void val8(int row, int k0, float (&v)[8]) const { ld8(src + row * ld + k0, v); } };
struct ABResid {
    const float* ys; const float* sst; int ident; const float* g; const float* b; const float* rawp; float scale; int mode; const float* pws; const float* c1; const float* c2;
    __device__ __forceinline__ void val8(int row, int k0, float (&v)[8]) const {
        float y[8], rp[8]; ld8(ys + row * D + k0, y); ld8(rawp + row * D + k0, rp);
        float mu = 0.f, rs = 1.f;
        if (!ident) { mu = sst[2 * row]; rs = sst[2 * row + 1]; float gg[8], bb[8]; ld8(g + k0, gg); ld8(b + k0, bb);
#pragma unroll
            for (int e = 0; e < 8; ++e) y[e] = (y[e] - mu) * rs * gg[e] + bb[e]; }
        if (mode == 0) {
#pragma unroll
            for (int e = 0; e < 8; ++e) v[e] = __builtin_fmaf(ALPHA, y[e], scale * rp[e]);
        } else {
            float pp[8], a1[8], a2[8]; ld8(pws + row * D + k0, pp); ld8(c1 + k0, a1); ld8(c2 + k0, a2);
#pragma unroll
            for (int e = 0; e < 8; ++e) v[e] = __builtin_fmaf(ALPHA, y[e], pp[e] * sigmoid_f(__builtin_fmaf(rp[e] - mu * a1[e], rs, a2[e])));
        }
    }
};
struct ABSwi {
    const float* raw; const float* sst; int ident; const float* c1; const float* c2;
    __device__ __forceinline__ void val8(int row, int k0, float (&v)[8]) const {
        const int gi = 256 * (k0 >> 7) + (k0 & 127);
        float gg[8], uu[8]; ld8(raw + row * NUP + gi, gg); ld8(raw + row * NUP + gi + 128, uu);
        if (!ident) { const float mu = sst[2 * row], rs = sst[2 * row + 1]; float a1[8], a2[8], b1[8], b2[8]; ld8(c1 + gi, a1); ld8(c2 + gi, a2); ld8(c1 + gi + 128, b1); ld8(c2 + gi + 128, b2);
#pragma unroll
            for (int e = 0; e < 8; ++e) { gg[e] = (gg[e] - mu * a1[e]) * rs + a2[e]; uu[e] = (uu[e] - mu * b1[e]) * rs + b2[e]; } }
#pragma unroll
        for (int e = 0; e < 8; ++e) v[e] = gg[e] * uu[e] * sigmoid_f(gg[e]);
    }
};
template <int KS32, class AB, int NG = 1> __device__ __forceinline__ void skinny(const bf16_t* Wt, int N, float* raw, const AB& ab, MK_LAS float* red, int tid, int wave, int lane, int gfirst, int gstride) {
    asm volatile("" : "+v"(lane), "+v"(tid));
    constexpr int K = KS32 * 32 * 8;
    const int fr = lane & 15, fq = lane >> 4, k0 = wave * (KS32 * 32), ng = N >> 4;
    if (gfirst < 0 || gfirst >= ng) return;
    bf16x8 bfr[NG][KS32];
#pragma unroll
    for (int gi = 0; gi < NG; ++gi) {
        const int g = gfirst + gi * gstride;
        if (g < ng) {
            const bf16_t* wp0 = Wt + (size_t)(16 * g + fr) * K + k0 + 8 * fq;
#pragma unroll
            for (int s = 0; s < KS32; ++s) bfr[gi][s] = *(const bf16x8*)(wp0 + 32 * s);
        }
    }
    bf16x8 afr[KS32];
#pragma unroll
    for (int s = 0; s < KS32; ++s) {
        u32x4 w = (u32x4){0u, 0u, 0u, 0u};
        if (fr < 8) { float v[8]; ab.val8(fr, k0 + 32 * s + 8 * fq, v); w.x = pk(v[0], v[1]); w.y = pk(v[2], v[3]); w.z = pk(v[4], v[5]); w.w = pk(v[6], v[7]); }
        afr[s] = __builtin_bit_cast(bf16x8, w);
    }
    for (int g0 = gfirst; g0 < ng; g0 += NG * gstride) {
        if (g0 != gfirst) {
#pragma unroll
            for (int gi = 0; gi < NG; ++gi) {
                const int g = g0 + gi * gstride;
                if (g < ng) {
                    const bf16_t* wp = Wt + (size_t)(16 * g + fr) * K + k0 + 8 * fq;
#pragma unroll
                    for (int s = 0; s < KS32; ++s) bfr[gi][s] = *(const bf16x8*)(wp + 32 * s);
                }
            }
        }
#pragma unroll
        for (int gi = 0; gi < NG; ++gi) {
            if (g0 + gi * gstride < ng) {
                f32x4 acc = (f32x4){0.f, 0.f, 0.f, 0.f};
#pragma unroll
                for (int s = 0; s < KS32; ++s) acc = mfma16(afr[s], bfr[gi][s], acc);
                if (fq < 2) {
#pragma unroll
                    for (int i = 0; i < 4; ++i) red[(gi * 8 + wave) * 128 + (4 * fq + i) * 16 + fr] = acc[i];
                }
            }
        }
        __syncthreads();
        if (tid < NG * 128) {
            const int gi = tid >> 7, idx = tid & 127, g = g0 + gi * gstride;
            if (g < ng) {
                float s = 0.f;
#pragma unroll
                for (int w8 = 0; w8 < 8; ++w8) s += red[(gi * 8 + w8) * 128 + idx];
                raw[(size_t)(idx >> 4) * N + 16 * g + (idx & 15)] = s;
            }
        }
        if (g0 + NG * gstride < ng) __syncthreads();
    }
}
struct ABRaw8 { const unsigned char* src; };
template <int NS, class AB, int NG = 1, int UNR = 2, bool RAW8 = false> __device__ __forceinline__ void skinny8(const unsigned char* W8, int N, int K, float* raw, const AB& ab, float ascale, float oscale, MK_LAS unsigned char* lds, int tid, int wave, int lane, int gfirst, int gstride) {
    asm volatile("" : "+v"(lane), "+v"(tid));
    typedef int v8i __attribute__((ext_vector_type(8)));
    MK_LAS unsigned char* ai = lds;
    MK_LAS float* red = (MK_LAS float*)(lds + 49152);
    const int fr = lane & 15, fq = lane >> 4, ng = N >> 4, nst = K >> 7, base = nst >> 3, rem = nst & 7, k8n = K >> 3;
    const int cnt = base + (wave < rem ? 1 : 0), s0 = wave * base + (wave < rem ? wave : rem);
    if (gfirst < 0 || gfirst >= ng) return;
    v8i bfr[NG][NS];
#pragma unroll
    for (int gi = 0; gi < NG; ++gi) {
        const int g = gfirst + gi * gstride;
        const unsigned char* wp = W8 + (size_t)(16 * g + fr) * K + 128 * s0 + 32 * fq;
#pragma unroll
        for (int s = 0; s < NS; ++s) {
            if (g < ng && s < cnt) { const u32x4 b0 = *(const u32x4*)(wp + 128 * s), b1 = *(const u32x4*)(wp + 128 * s + 16); bfr[gi][s] = (v8i){(int)b0.x, (int)b0.y, (int)b0.z, (int)b0.w, (int)b1.x, (int)b1.y, (int)b1.z, (int)b1.w}; }
            else bfr[gi][s] = (v8i){0, 0, 0, 0, 0, 0, 0, 0};
        }
    }
    if constexpr (RAW8) {
        u32x4 cp[6];
#pragma unroll
        for (int j = 0; j < 6; ++j) { const int it = tid + j * NTHR; if (16 * it < 8 * K) cp[j] = *(const u32x4*)(ab.src + 16 * it); }
#pragma unroll
        for (int j = 0; j < 6; ++j) { const int it = tid + j * NTHR; if (16 * it < 8 * K) *(MK_LAS u32x4*)(ai + 16 * it) = cp[j]; }
    } else
    for (int it0 = tid; it0 < K; it0 += UNR * NTHR) {
        float v[UNR][8];
#pragma unroll
        for (int j = 0; j < UNR; ++j) { const int it = it0 + j * NTHR; if (it < K) { const int row = it / k8n, k8 = it - row * k8n; if constexpr (!RAW8) ab.val8(row, 8 * k8, v[j]); } }
#pragma unroll
        for (int j = 0; j < UNR; ++j) {
            const int it = it0 + j * NTHR;
            if (it < K) { const int row = it / k8n, k8 = it - row * k8n;
                u32x2 w; w.x = pk8(v[j][0] * ascale, v[j][1] * ascale, v[j][2] * ascale, v[j][3] * ascale); w.y = pk8(v[j][4] * ascale, v[j][5] * ascale, v[j][6] * ascale, v[j][7] * ascale);
                *(MK_LAS u32x2*)(ai + row * K + 8 * k8) = w; }
        }
    }
    __syncthreads();
    v8i afr[NS];
#pragma unroll
    for (int s = 0; s < NS; ++s) {
        afr[s] = (v8i){0, 0, 0, 0, 0, 0, 0, 0};
        if (fr < 8 && s < cnt) { const MK_LAS unsigned char* ap = ai + fr * K + 128 * (s0 + s) + 32 * fq; const u32x4 a0 = *(const MK_LAS u32x4*)ap, a1 = *(const MK_LAS u32x4*)(ap + 16);
            afr[s] = (v8i){(int)a0.x, (int)a0.y, (int)a0.z, (int)a0.w, (int)a1.x, (int)a1.y, (int)a1.z, (int)a1.w}; }
    }
    for (int g0 = gfirst; g0 < ng; g0 += NG * gstride) {
        if (g0 != gfirst) {
#pragma unroll
            for (int gi = 0; gi < NG; ++gi) {
                const int g = g0 + gi * gstride;
                const unsigned char* wp = W8 + (size_t)(16 * g + fr) * K + 128 * s0 + 32 * fq;
#pragma unroll
                for (int s = 0; s < NS; ++s) {
                    if (g < ng && s < cnt) { const u32x4 b0 = *(const u32x4*)(wp + 128 * s), b1 = *(const u32x4*)(wp + 128 * s + 16); bfr[gi][s] = (v8i){(int)b0.x, (int)b0.y, (int)b0.z, (int)b0.w, (int)b1.x, (int)b1.y, (int)b1.z, (int)b1.w}; }
                    else bfr[gi][s] = (v8i){0, 0, 0, 0, 0, 0, 0, 0};
                }
            }
        }
#pragma unroll
        for (int gi = 0; gi < NG; ++gi) {
            if (g0 + gi * gstride < ng) {
                f32x4 acc = (f32x4){0.f, 0.f, 0.f, 0.f};
#pragma unroll
                for (int s = 0; s < NS; ++s) acc = __builtin_amdgcn_mfma_scale_f32_16x16x128_f8f6f4(afr[s], bfr[gi][s], acc, 0, 0, 0, 0x7F7F7F7F, 0, 0x7F7F7F7F);
                if (fq < 2) {
#pragma unroll
                    for (int i = 0; i < 4; ++i) red[(gi * 8 + wave) * 128 + (4 * fq + i) * 16 + fr] = acc[i];
                }
            }
        }
        __syncthreads();
        if (tid < NG * 128) {
            const int gi = tid >> 7, idx = tid & 127, g = g0 + gi * gstride;
            if (g < ng) {
                float s = 0.f;
#pragma unroll
                for (int w8 = 0; w8 < 8; ++w8) s += red[(gi * 8 + w8) * 128 + idx];
                raw[(size_t)(idx >> 4) * N + 16 * g + (idx & 15)] = s * oscale;
            }
        }
        if (g0 + NG * gstride < ng) __syncthreads();
    }
}
template <class AB> __device__ __forceinline__ void skinny8_swi(const unsigned char* W8, const AB& ab, int ident, const float* c1, const float* c2, unsigned char* HS, MK_LAS unsigned char* lds, int tid, int wave, int lane, int bx) {
    asm volatile("" : "+v"(lane), "+v"(tid));
    typedef int v8i __attribute__((ext_vector_type(8)));
    constexpr int K = D, NS = 2, NG = 4, NP = NUP / 32;
    MK_LAS unsigned char* ai = lds;
    MK_LAS float* stp = (MK_LAS float*)(lds + 16384);
    MK_LAS float* stt = (MK_LAS float*)(lds + 16384 + 512);
    MK_LAS float* zt = (MK_LAS float*)(lds + 20480);
    MK_LAS float* red = (MK_LAS float*)(lds + 49152);
    const int fr = lane & 15, fq = lane >> 4, s0 = wave * 2;
    v8i bfr[NG][NS];
#pragma unroll
    for (int gi = 0; gi < NG; ++gi) {
        const int p = bx + 256 * (gi >> 1), g = 16 * (p >> 3) + (p & 7) + 8 * (gi & 1);
        const unsigned char* wp = W8 + (size_t)(16 * g + fr) * K + 128 * s0 + 32 * fq;
#pragma unroll
        for (int s = 0; s < NS; ++s) {
            if (p < NP) { const u32x4 b0 = *(const u32x4*)(wp + 128 * s), b1 = *(const u32x4*)(wp + 128 * s + 16); bfr[gi][s] = (v8i){(int)b0.x, (int)b0.y, (int)b0.z, (int)b0.w, (int)b1.x, (int)b1.y, (int)b1.z, (int)b1.w}; }
            else bfr[gi][s] = (v8i){0, 0, 0, 0, 0, 0, 0, 0};
        }
    }
    {
        float v[4][8];
#pragma unroll
        for (int j = 0; j < 4; ++j) ab.val8((tid >> 8) + 2 * j, 8 * (tid & 255), v[j]);
#pragma unroll
        for (int j = 0; j < 4; ++j) {
            float sm = 0.f, sq = 0.f;
#pragma unroll
            for (int e = 0; e < 8; ++e) { sm += v[j][e]; sq += v[j][e] * v[j][e]; }
#pragma unroll
            for (int o = 32; o > 0; o >>= 1) { sm += shx(sm, o, lane); sq += shx(sq, o, lane); }
            if (lane == 0) { stp[(wave * 4 + j) * 2] = sm; stp[(wave * 4 + j) * 2 + 1] = sq; }
            u32x2 w; w.x = pk8(v[j][0], v[j][1], v[j][2], v[j][3]); w.y = pk8(v[j][4], v[j][5], v[j][6], v[j][7]);
            *(MK_LAS u32x2*)(ai + ((tid >> 8) + 2 * j) * K + 8 * (tid & 255)) = w;
        }
    }
    __syncthreads();
    if (tid < 8) {
        float sm = 0.f, sq = 0.f;
#pragma unroll
        for (int w4 = 0; w4 < 4; ++w4) { sm += stp[((4 * (tid & 1) + w4) * 4 + (tid >> 1)) * 2]; sq += stp[((4 * (tid & 1) + w4) * 4 + (tid >> 1)) * 2 + 1]; }
        const float mu = sm * (1.f / 2048.f), var = fmaxf(sq * (1.f / 2048.f) - mu * mu, 0.f);
        stt[2 * tid] = mu; stt[2 * tid + 1] = 1.0f / sqrtf(var + LN_EPS);
    }
    v8i afr[NS];
#pragma unroll
    for (int s = 0; s < NS; ++s) {
        afr[s] = (v8i){0, 0, 0, 0, 0, 0, 0, 0};
        if (fr < 8) { const MK_LAS unsigned char* ap = ai + fr * K + 128 * (s0 + s) + 32 * fq; const u32x4 a0 = *(const MK_LAS u32x4*)ap, a1 = *(const MK_LAS u32x4*)(ap + 16);
            afr[s] = (v8i){(int)a0.x, (int)a0.y, (int)a0.z, (int)a0.w, (int)a1.x, (int)a1.y, (int)a1.z, (int)a1.w}; }
    }
#pragma unroll
    for (int gi = 0; gi < NG; ++gi) {
        if (bx + 256 * (gi >> 1) < NP) {
            f32x4 acc = (f32x4){0.f, 0.f, 0.f, 0.f};
#pragma unroll
            for (int s = 0; s < NS; ++s) acc = __builtin_amdgcn_mfma_scale_f32_16x16x128_f8f6f4(afr[s], bfr[gi][s], acc, 0, 0, 0, 0x7F7F7F7F, 0, 0x7F7F7F7F);
            if (fq < 2) {
#pragma unroll
                for (int i = 0; i < 4; ++i) red[(gi * 8 + wave) * 128 + (4 * fq + i) * 16 + fr] = acc[i];
            }
        }
    }
    __syncthreads();
    if (tid < 256) {
        const int ps = tid >> 7, idx = tid & 127, p = bx + 256 * ps, r = idx >> 4;
        if (p < NP) {
            float sg = 0.f, su = 0.f;
#pragma unroll
            for (int w8 = 0; w8 < 8; ++w8) { sg += red[((2 * ps) * 8 + w8) * 128 + idx]; su += red[((2 * ps + 1) * 8 + w8) * 128 + idx]; }
            MK_OPQF(kinv, 1.f / W8S);
            float gg = sg * kinv, uu = su * kinv;
            const int colg = 16 * (16 * (p >> 3) + (p & 7)) + (idx & 15), colu = colg + 128;
            if (!ident) { const float mu = stt[2 * r], rs = stt[2 * r + 1]; gg = (gg - mu * c1[colg]) * rs + c2[colg]; uu = (uu - mu * c1[colu]) * rs + c2[colu]; }
            const float h = gg * uu * sigmoid_f(gg) * H8S;
            HS[(size_t)r * FF + (p >> 3) * 128 + 16 * (p & 7) + (idx & 15)] = (unsigned char)(pk8(h, 0.f, 0.f, 0.f) & 0xffu);
        }
    }
}
template <class AB> __device__ __forceinline__ void smp_update(const AB& ab, float* ysn, float* sstn, int wave, int lane) {
    float s = 0.f, q = 0.f;
    float vall[4][8];
#pragma unroll
    for (int j = 0; j < 4; ++j) ab.val8(wave, lane * 8 + 512 * j, vall[j]);
    asm volatile("" ::: "memory");
#pragma unroll
    for (int j = 0; j < 4; ++j) {
        const int kb = lane * 8 + 512 * j;
        float (&v)[8] = vall[j];
        *(f32x4*)(ysn + wave * D + kb) = (f32x4){v[0], v[1], v[2], v[3]}; *(f32x4*)(ysn + wave * D + kb + 4) = (f32x4){v[4], v[5], v[6], v[7]};
#pragma unroll
        for (int e = 0; e < 8; ++e) { s += v[e]; q += v[e] * v[e]; }
    }
#pragma unroll
    for (int o = 32; o > 0; o >>= 1) { s += shx(s, o, lane); q += shx(q, o, lane); }
    if (lane == 0) { const float mu = s * (1.f / 2048.f); const float var = fmaxf(q * (1.f / 2048.f) - mu * mu, 0.f); sstn[2 * wave] = mu; sstn[2 * wave + 1] = 1.0f / sqrtf(var + LN_EPS); }
}
struct ZsFold { const float* raw; const float* sst; const float* c1; const float* c2;
    __device__ __forceinline__ float operator()(int b, int col) const { return (raw[b * INW + col] - sst[2 * b] * c1[col]) * sst[2 * b + 1] + c2[col]; } };
__device__ __forceinline__ void smp_attn(MK_LAS float* ls, const ZsFold& zf, const float* ck, const float* cv, float* ap, float* kout, float* vout, int task, int tid, int wave, int lane) {
    asm volatile("" : "+v"(lane), "+v"(tid));
    const int b = task / 24, h = (task % 24) / 3, g = task % 3, dd = 1 << (2 * g);
    MK_LAS float* qs = ls; MK_LAS float* sc = ls + 128; MK_LAS float* kn = ls + 384; MK_LAS float* vn = ls + 512; MK_LAS float* po = ls + 640;
    const int d = tid & 127, part = tid >> 7;
    f32x2 kk[17]; float vv[33];
#pragma unroll
    for (int i = 0; i < 17; ++i) { const int j = wave + 8 * i; kk[i] = (j >= 1 && j < 129) ? *(const f32x2*)(ck + (((size_t)b * 2048 + (2048 - j * dd)) * 8 + h) * 128 + 2 * lane) : (f32x2){0.f, 0.f}; }
#pragma unroll
    for (int i = 0; i < 33; ++i) { const int j = part + 4 * i; vv[i] = (j >= 1 && j < 129) ? cv[(((size_t)b * 2048 + (2048 - j * dd)) * 8 + h) * 128 + d] : 0.f; }
    if (tid < 128) { qs[tid] = zf(b, h * 128 + tid); const float kv = zf(b, 1024 + h * 128 + tid), vv = zf(b, 2048 + h * 128 + tid); kn[tid] = kv; vn[tid] = vv;
        if (g == 0) { kout[b * 1024 + h * 128 + tid] = kv; vout[b * 1024 + h * 128 + tid] = vv; } }
    __syncthreads();
    const float slope = __builtin_amdgcn_exp2f(-(float)(h + 1));
    {
        if (wave == 0) kk[0] = (f32x2){kn[2 * lane], kn[2 * lane + 1]};
        const float q0 = qs[2 * lane], q1 = qs[2 * lane + 1];
        MK_OPQF(kscale, 0.08838834764831845f);
#pragma unroll
        for (int i = 0; i < 17; ++i) {
            const int j = wave + 8 * i;
            float dot = q0 * kk[i].x + q1 * kk[i].y;
#pragma unroll
            for (int o = 32; o > 0; o >>= 1) dot += shx(dot, o, lane);
            if (lane == 0 && j < 129) sc[j] = __builtin_fmaf(dot, kscale, -slope * (float)(j * dd));
        }
    }
    __syncthreads();
    float mx = -1e30f;
    for (int j = 0; j < 129; ++j) mx = fmaxf(mx, sc[j]);
    float l = 0.f;
    for (int j = 0; j < 129; ++j) l += __expf(sc[j] - mx);
    float o = 0.f;
    {
        if (part == 0) vv[0] = vn[d];
#pragma unroll
        for (int i = 0; i < 33; ++i) { const int j = part + 4 * i; if (j < 129) o = fmaf(__expf(sc[j] - mx), vv[i], o); }
    }
    po[part * 128 + d] = o;
    __syncthreads();
    if (tid < 128) { ap[task * 136 + 8 + tid] = (po[tid] + po[128 + tid]) + (po[256 + tid] + po[384 + tid]); if (tid == 0) { ap[task * 136] = mx; ap[task * 136 + 1] = l; } }
    __syncthreads();
}
__device__ __forceinline__ void smp_ret(MK_LAS float* ls, const ZsFold& zf, const float* s0, float* sout, const float* gng, const float* gnb, float* mixs, int task, int tid) {
    asm volatile("" : "+v"(tid));
    const int b = task >> 3, h = task & 7;
    MK_LAS float* qs = ls; MK_LAS float* ks = ls + 64; MK_LAS float* po = ls + 128; MK_LAS float* os = ls + 640;
    const int e = tid & 127, part = tid >> 7;
    float s0v[16];
#pragma unroll
    for (int i = 0; i < 16; ++i) s0v[i] = s0[(((size_t)b * 8 + h) * 64 + 16 * part + i) * 128 + e];
    if (tid < 64) qs[tid] = zf(b, 3072 + h * 64 + tid);
    else if (tid < 128) ks[tid - 64] = zf(b, 3584 + h * 64 + (tid - 64)) * 0.125f;
    __syncthreads();
    const float gam = 1.f - __builtin_amdgcn_exp2f(-5.f - (float)h);
    const float v = zf(b, 4096 + h * 128 + e);
    float o = 0.f;
#pragma unroll
    for (int i = 0; i < 16; ++i) {
        const int dk = 16 * part + i; const size_t idx = (((size_t)b * 8 + h) * 64 + dk) * 128 + e;
        const float sn = fmaf(gam, s0v[i], ks[dk] * v);
        sout[idx] = sn; o = fmaf(qs[dk], sn, o);
    }
    po[part * 128 + e] = o;
    __syncthreads();
    if (tid < 128) os[tid] = (po[tid] + po[128 + tid]) + (po[256 + tid] + po[384 + tid]);
    __syncthreads();
    if (tid < 128) {
        float s = 0.f;
        for (int i = 0; i < 128; ++i) s += os[i];
        const float mu = s * (1.f / 128.f); float q = 0.f;
        for (int i = 0; i < 128; ++i) { const float dd = os[i] - mu; q += dd * dd; }
        const float rstd = 1.0f / sqrtf(q * (1.f / 128.f) + GN_EPS);
        const int c = h * 128 + tid; const float gbv = zf(b, 5120 + c);
        mixs[b * D + 1024 + c] = ((os[tid] - mu) * rstd * gng[c] + gnb[c]) * gbv * sigmoid_f(gbv);
    }
    __syncthreads();
}
}

namespace mk {
struct Args { const float* in[21]; float* out; unsigned char* ws; int nl; int stop; int rep; int pad; };
static_assert(sizeof(Args) == 21 * 8 + 8 + 8 + 16, "Args has no padding");

__global__ void __launch_bounds__(NTHR, 2) mega(Args a) {
    extern __shared__ __attribute__((aligned(16))) unsigned char lds_raw[];
    MK_LAS unsigned char* lds = (MK_LAS unsigned char*)lds_raw;
    int wave = __builtin_amdgcn_readfirstlane((int)threadIdx.x >> 6);
    int lane = (int)__builtin_amdgcn_mbcnt_hi(~0u, __builtin_amdgcn_mbcnt_lo(~0u, 0u)), tid = wave * 64 + lane;
    int G = gridDim.x, bx = blockIdx.x;
#define OPAQUE_IDS() do { unsigned z_ = 0u; asm volatile("" : "+s"(z_)); lane = (int)__builtin_amdgcn_mbcnt_hi(~0u, __builtin_amdgcn_mbcnt_lo(~0u, z_)); tid = wave * 64 + lane; asm volatile("" : "+v"(tid), "+v"(lane), "+s"(wave), "+s"(G), "+s"(bx), "+s"(KP)); } while (0)
    for (int u = tid; u < (LDS_BYTES - RING_BYTES) / 4; u += NTHR) ((MK_LAS unsigned*)(lds + RING_BYTES))[u] = 0u;
    __syncthreads();
    typedef const __attribute__((address_space(4))) Args* KArgs;
    KArgs KP = (KArgs)__builtin_amdgcn_kernarg_segment_ptr();
#define ws (KP->ws)
#define out (KP->out)
#define x_prompt (KP->in[0])
#define x_sample (KP->in[1])
#define cache_k (KP->in[2])
#define cache_v (KP->in[3])
#define state_ret (KP->in[4])
#define p_prompt (KP->in[5])
#define p_sample (KP->in[6])
#define w_in (KP->in[7])
#define w_out (KP->in[8])
#define gn_g (KP->in[9])
#define gn_b (KP->in[10])
#define f1w1 (KP->in[11])
#define f1w3 (KP->in[12])
#define f1w2 (KP->in[13])
#define f2w1 (KP->in[14])
#define f2w3 (KP->in[15])
#define f2w2 (KP->in[16])
#define w_ple (KP->in[17])
#define w_gate (KP->in[18])
#define ln_g (KP->in[19])
#define ln_b (KP->in[20])
#define STATS ((float*)(ws + WS_STATS))
#define CV ((float*)(ws + WS_CV))
#define SMP ((float*)(ws + WS_SMP))
#define PART ((float*)(ws + WS_PART))
#define WB ((bf16_t*)(ws + WS_W))
#define YB ((bf16_t*)(ws + WS_YB))
#define Y8 ((unsigned char*)(ws + WS_Y))
#define H ((unsigned char*)(ws + WS_H))
#define Z ((bf16_t*)(ws + WS_Z))
#define MIX ((bf16_t*)(ws + WS_MIX))
#define OG ((bf16_t*)(ws + WS_OG))
#define LSE ((float*)(ws + WS_LSE))
#define U ((float*)(ws + WS_U))
#define PB ((bf16_t*)(ws + WS_PB))
#define PW ((bf16_t*)(ws + WS_PW))
#define YS (SMP + SM_YS)
#define SST (SMP + SM_ST)
#define RUP (SMP + SM_RUP)
#define RDA (SMP + SM_RD)
#define RIN (SMP + SM_RIN)
#define MIXS (SMP + SM_MIX)
#define AP (SMP + SM_AP)
#define PWS (SMP + SM_PWS)
#define RDB (SMP + SM_RDB)
#define HSS ((unsigned char*)(SMP + SM_HS))
#define YBDUM ((bf16_t*)(ws + WS_END + (size_t)M * D * 4))
#define STDUM ((float*)(ws + WS_END + (size_t)M * D * 6))
    XcdBarrier bar = xcd_barrier_post((unsigned*)(ws + WS_CTL) + 4096, (volatile LAS unsigned*)(lds + MISC_OFF) + 8);
    MK_LAS float* red = (MK_LAS float*)lds;
#if defined(MK_STAMP)
    int nstamp = 1; if (bx == 0 && tid == 0) ((unsigned long long*)(ws + WS_CTL + 524288))[0] = __builtin_amdgcn_s_memrealtime();
#endif
#define gw (bx * NWAVES + wave)
#define NGW (G * NWAVES)
#define gt (bx * NTHR + tid)
#define GT (G * NTHR)
#define LNG(l, i) (ln_g + ((size_t)(l) * 4 + (i)) * D)
#define LNB(l, i) (ln_b + ((size_t)(l) * 4 + (i)) * D)
#define CV1(l, off) (CV + ((size_t)(l) * 2 + 0) * NCV + (off))
#define CV2(l, off) (CV + ((size_t)(l) * 2 + 1) * NCV + (off))
#define WL(l, off) (WB + (size_t)(l) * LW + (off))
#if defined(MK_STAMP)
#define GRID_BAR() do { xcd_barrier(bar); if (bx == 0 && tid == 0) { ((unsigned long long*)(ws + WS_CTL + 524288))[nstamp] = __builtin_amdgcn_s_memrealtime(); } ++nstamp; } while (0)
#else
#if defined(MK_PROBE)
#define GRID_BAR() do { xcd_barrier(bar); if ((KP->rep >> 15) & 1) xcd_barrier(bar); } while (0)
#else
#define GRID_BAR() xcd_barrier(bar)
#endif
#endif
#define RUNP(id) (KP->stop == 0 || (id) < KP->stop)
#if defined(MK_PROBE)
#if defined(MK_PROBE_KIND)
#define REPS(kind) for (int rep_ = 0, nrep_ = ((kind) == MK_PROBE_KIND && ((KP->rep >> (kind)) & 1)) ? 2 : 1; rep_ < nrep_; ++rep_)
#else
#define REPS(kind) for (int rep_ = 0, nrep_ = ((KP->rep >> (kind)) & 1) ? 2 : 1; rep_ < nrep_; ++rep_)
#endif
#define REPBAR() do { OPAQUE_IDS(); if (rep_) GRID_BAR(); } while (0)
#define DUMSEL (nrep_ == 2 && rep_ == 0)
#else
#define REPS(kind)
#define REPBAR() do { } while (0)
#define DUMSEL false
#endif

    REPS(10) {
        REPBAR();
        MK_LAS float* scr = (MK_LAS float*)(lds + wave * 16384);
        constexpr int IPL = 44288, NIT = DEPTH * IPL;
#define TR_DECODE(it_, c_) do { \
            const int l = (it_) / IPL; int r = (it_) % IPL; \
            const float* W; int K = D, N; size_t woff; int kind = 0, lnl = -1, lni = 0, cvoff = 0, f8 = 0;     \
            if (r < 5632) { W = f1w1 + (size_t)l * D * FF; N = FF; woff = W_UP1; kind = 1; lnl = l - 1; lni = 3; cvoff = CV_UP1; f8 = 1; } \
            else if ((r -= 5632) < 5632) { W = f1w3 + (size_t)l * D * FF; N = FF; woff = W_UP1; kind = 2; lnl = l - 1; lni = 3; cvoff = CV_UP1; f8 = 1; } \
            else if ((r -= 5632) < 5632) { W = f1w2 + (size_t)l * FF * D; K = FF; N = D; woff = W_DN1; f8 = 1; } \
            else if ((r -= 5632) < 6144) { W = w_in + (size_t)l * D * INW; N = INW; woff = W_IN; lnl = l; lni = 0; cvoff = CV_IN; } \
            else if ((r -= 6144) < 2048) { W = w_out + (size_t)l * D * D; N = D; woff = W_OUT; } \
            else if ((r -= 2048) < 5632) { W = f2w1 + (size_t)l * D * FF; N = FF; woff = W_UP2; kind = 1; lnl = l; lni = 1; cvoff = CV_UP2; f8 = 1; } \
            else if ((r -= 5632) < 5632) { W = f2w3 + (size_t)l * D * FF; N = FF; woff = W_UP2; kind = 2; lnl = l; lni = 1; cvoff = CV_UP2; f8 = 1; } \
            else if ((r -= 5632) < 5632) { W = f2w2 + (size_t)l * FF * D; K = FF; N = D; woff = W_DN2; f8 = 1; } \
            else if ((r -= 5632) < 2048) { W = w_gate + (size_t)l * D * D; N = D; woff = W_GATE; lnl = l; lni = 2; cvoff = CV_GATE; } \
            else { r -= 2048; W = w_ple + (size_t)l * PLE * D; K = PLE; N = D; woff = W_PLE; } \
            const int nblk = N >> 5, kb = r / nblk, nb = r % nblk, n0 = nb * 32; \
            (c_).W = W; (c_).WT = WL(l, woff); (c_).K = K; (c_).N = N; (c_).n0 = n0; (c_).k0 = kb * 64; (c_).f8 = f8; \
            (c_).drow0 = (kind == 0) ? n0 : (256 * (n0 >> 7) + (n0 & 127) + (kind == 2 ? 128 : 0)); \
            (c_).gk = nullptr; (c_).bk = nullptr; if (lnl >= 0) { (c_).gk = LNG(lnl, lni); (c_).bk = LNB(lnl, lni); } \
            (c_).p1 = PART + (((size_t)l * 2 + 0) * 32 + kb) * NCV + cvoff; (c_).p2 = PART + (((size_t)l * 2 + 1) * 32 + kb) * NCV + cvoff; } while (0)
        {
            TrCtx cA, cB; float wA[32], gA[8], bA[8], wB[32], gB[8], bB[8];
            int it = gw; bool vA = it < NIT;
            if (vA) { TR_DECODE(it, cA); tr_load(cA, lane, wA, gA, bA); }
            while (vA) {
                const int itB = it + NGW; const bool vB = itB < NIT;
                if (vB) { TR_DECODE(itB, cB); tr_load(cB, lane, wB, gB, bB); }
                tr_proc(cA, scr, lane, wA, gA, bA);
                if (!vB) break;
                it = itB + NGW; vA = it < NIT;
                if (vA) { TR_DECODE(it, cA); tr_load(cA, lane, wA, gA, bA); }
                tr_proc(cB, scr, lane, wB, gB, bB);
            }
        }
#undef TR_DECODE
        for (int i0 = gt; i0 < M * D / 4; i0 += 8 * GT) {
            f32x4 v[8];
#pragma unroll
            for (int j = 0; j < 8; ++j) { const int i = i0 + j * GT; v[j] = (i < M * D / 4) ? __builtin_nontemporal_load((const f32x4*)x_prompt + i) : (f32x4){0.f, 0.f, 0.f, 0.f}; }
#pragma unroll
            for (int j = 0; j < 8; ++j) { const int i = i0 + j * GT; if (i < M * D / 4) ((unsigned*)Y8)[i] = pk8(v[j][0], v[j][1], v[j][2], v[j][3]); }
        }
        for (int i0 = gt; i0 < DEPTH * M * PLE / 4; i0 += 8 * GT) {
            f32x4 v[8];
#pragma unroll
            for (int j = 0; j < 8; ++j) { const int i = i0 + j * GT; v[j] = (i < DEPTH * M * PLE / 4) ? __builtin_nontemporal_load((const f32x4*)p_prompt + i) : (f32x4){0.f, 0.f, 0.f, 0.f}; }
#pragma unroll
            for (int j = 0; j < 8; ++j) { const int i = i0 + j * GT; if (i < DEPTH * M * PLE / 4) { u32x2 w; w.x = pk(v[j][0], v[j][1]); w.y = pk(v[j][2], v[j][3]); ((u32x2*)PB)[i] = w; } }
        }
    }
    GRID_BAR();
    REPS(11) {
        REPBAR();
        for (int i = gt; i < DEPTH * NCV; i += GT) {
            const int l = i / NCV, col = i % NCV;
            if (l == 0 && col < CV_IN) continue;
            float s1 = 0.f, s2 = 0.f;
            for (int kb = 0; kb < 32; ++kb) { s1 += PART[(((size_t)l * 2 + 0) * 32 + kb) * NCV + col]; s2 += PART[(((size_t)l * 2 + 1) * 32 + kb) * NCV + col]; }
            CV[((size_t)l * 2 + 0) * NCV + col] = s1; CV[((size_t)l * 2 + 1) * NCV + col] = s2;
        }
        {
            OPAQUE_IDS();
            pg8::Gemm g{PB, WL(0, W_PLE), DEPTH * M, D, PLE}; PleOrder S; S.base.init(M, D, G, bx);
            EpiPle E{PW};
            pg8::gemm_phase<EpiPle, PleOrder, false, true>(lds, g, S, E, wave);
        }
        {
            OPAQUE_IDS();
            const int l = bx >> 6, gf = bx & 63;
            if (G == 256 && l < DEPTH) skinny<1, ABDirect, 2>(WL(l, W_PLE), D, PWS + (size_t)l * 8 * D, ABDirect{p_sample + (size_t)l * 8 * PLE, PLE}, red, tid, wave, lane, gf, 64);
            else if (G != 256) for (int l2 = 0; l2 < DEPTH; ++l2) { skinny<1>(WL(l2, W_PLE), D, PWS + (size_t)l2 * 8 * D, ABDirect{p_sample + (size_t)l2 * 8 * PLE, PLE}, red, tid, wave, lane, bx, G); __syncthreads(); }
        }
    }
    GRID_BAR();

#if defined(MK_DUP)
#define MK_DUPLOOP(k) for (int rr_ = 0, nr_ = (MK_DUP == (k)) ? 1 + KP->pad : 1; rr_ < nr_; ++rr_)
#else
#define MK_DUPLOOP(k)
#endif
    int cur = 0;
    const float* ysp = x_sample; const float* sstp = SST; int sid = 1; const float* sg = ln_g; const float* sb = ln_b; int ss = 0;
    for (int l = 0; l < KP->nl; ++l) {
        OPAQUE_IDS();
        float* k_out = out + O_KP + (size_t)l * M * 1024; float* v_out = out + O_VP + (size_t)l * M * 1024;
        for (int sub = 0; sub < 2; ++sub) {
            OPAQUE_IDS();
            if (sub == 1) {
                if (RUNP(l * 16 + 3)) REPS(3) {
                    REPBAR();
                    pg8::Gemm g{YB + (size_t)cur * M * D, WL(l, W_IN), M, INW, D}; pg8::StaticOrder S; S.init(M, INW, G, bx);
                    EpiIn E{Z, k_out, v_out, STATS + (size_t)cur * M * 16, CV1(l, CV_IN), CV2(l, CV_IN)};
                    const PreTab<pg8::StaticOrder> PT{lds, S, STATS + (size_t)cur * M * 16, tid, 1};
                    pg8::gemm_phase<EpiIn, pg8::StaticOrder, true, true, false, false, PreTab<pg8::StaticOrder>>(lds, g, S, E, wave, PT);
                    ABResid ab{ysp, sstp, sid, sg, sb, RDB, 0.5f, 0, nullptr, nullptr, nullptr};
                    if (bx == 0) smp_update(ab, YS + ss * 8 * D, SST + ss * 16, wave, lane);
                    MK_DUPLOOP(6) skinny<8, ABResid, 2>(WL(l, W_IN), INW, RIN, ab, red, tid, wave, lane, bx, G);
                }
                ysp = YS + ss * 8 * D; sstp = SST + ss * 16; sid = 0; sg = LNG(l, 0); sb = LNB(l, 0); ss ^= 1;
                GRID_BAR();
                if (RUNP(l * 16 + 4)) REPS(4) {
                    REPBAR();
                    const int xa_ = (G == 256) ? ((4 * (bx & 7) + (bx >> 6)) * 48 + ((bx >> 3) & 7)) : bx, xs_ = (G == 256) ? 8 : G, xn_ = (G == 256) ? ((4 * (bx & 7) + (bx >> 6)) * 48 + 48) : 1536;
                    const int ra_ = (G == 256) ? ((4 * (bx & 7) + (bx >> 6)) * 16 + ((bx >> 3) & 7)) : bx, rn_ = (G == 256) ? ((4 * (bx & 7) + (bx >> 6)) * 16 + 16) : 512;
                    MK_DUPLOOP(1) { OPAQUE_IDS(); attn_phase(lds, Z, OG, LSE, xa_, xs_, xn_, wave, lane); }
                    MK_DUPLOOP(2) { OPAQUE_IDS(); if (G == 256) retu_pair(lds, Z, U, ra_, ra_ + 8, tid, wave, lane); else retu_units(lds, Z, U, ra_, xs_, rn_, tid, wave, lane); }
                    const ZsFold zf{RIN, sstp, CV1(l, CV_IN), CV2(l, CV_IN)};
                    MK_DUPLOOP(3) for (int t = bx; t < 256; t += G) {
                        if (t < 192) smp_attn((MK_LAS float*)lds, zf, cache_k + (size_t)l * SB * 2048 * 1024, cache_v + (size_t)l * SB * 2048 * 1024, AP, out + O_KS + (size_t)l * SB * 1024, out + O_VS + (size_t)l * SB * 1024, t, tid, wave, lane);
                        else smp_ret((MK_LAS float*)lds, zf, state_ret + (size_t)l * SB * 8 * 8192, out + O_RS + (size_t)l * SB * 8 * 8192, gn_g + (size_t)l * 1024, gn_b + (size_t)l * 1024, MIXS, t - 192, tid);
                    }
                }
                GRID_BAR();
                if (RUNP(l * 16 + 5)) REPS(5) {
                    REPBAR();
                    {
                        const int ub_ = (G == 256) ? ((4 * (bx & 7) + (bx >> 6)) * 8 + ((bx >> 3) & 7)) : bx;
                        if (G == 256 && NGW * 4 == M) {
                            int ui_ = 0;
                            for (int u = ub_; u < 512; u += 256) {
                                CombRegs2 cr; const int t0_ = gw + 2 * ui_ * NGW;
                                const auto jpre = [&]() { combine_load2(OG, LSE, t0_, NGW, lane, cr); };
                                const auto jpost = [&]() { combine_finish2(MIX, t0_, NGW, lane, cr); };
                                reto_unit(lds, Z, U, MIX, gn_g + (size_t)l * 1024, gn_b + (size_t)l * 1024, out + O_RP + (size_t)l * NB * 8 * 8192, u, tid, wave, lane, jpre, jpost);
                                ++ui_;
                            }
                        } else {
                            for (int u = ub_; u < 512; u += G) reto_unit(lds, Z, U, MIX, gn_g + (size_t)l * 1024, gn_b + (size_t)l * 1024, out + O_RP + (size_t)l * NB * 8 * 8192, u, tid, wave, lane);
                            for (int t = gw; t < M; t += NGW) combine_rows<1>(OG, LSE, MIX, t, 0, lane);
                        }
                    }
                    for (int t = bx; t < 64; t += G) {
                        if (tid < 128) {
                            const float* p0 = AP + (t * 3 + 0) * 136; const float* p1 = AP + (t * 3 + 1) * 136; const float* p2 = AP + (t * 3 + 2) * 136;
                            const float mx = fmaxf(p0[0], fmaxf(p1[0], p2[0]));
                            const float e0 = __expf(p0[0] - mx), e1 = __expf(p1[0] - mx), e2 = __expf(p2[0] - mx);
                            const float L = p0[1] * e0 + p1[1] * e1 + p2[1] * e2;
                            MIXS[(t >> 3) * D + (t & 7) * 128 + tid] = (p0[8 + tid] * e0 + p1[8 + tid] * e1 + p2[8 + tid] * e2) / L;
                        }
                    }
                }
                GRID_BAR();
                if (RUNP(l * 16 + 6)) REPS(6) {
                    REPBAR(); const bool dum = DUMSEL;
                    pg8::Gemm g{MIX, WL(l, W_OUT), M, D, D}; pg8::StaticOrder S; S.init(M, D, G, bx);
                    EpiRes<0> E{nullptr, YB + (size_t)cur * M * D, dum ? YBDUM : YB + (size_t)(cur ^ 1) * M * D, STATS + (size_t)cur * M * 16, dum ? STDUM : STATS + (size_t)(cur ^ 1) * M * 16, LNG(l, 0), LNB(l, 0), 0, 1.0f, nullptr, nullptr, nullptr, dum ? nullptr : Y8};
                    const PreTab<pg8::StaticOrder> PT{lds, S, STATS + (size_t)cur * M * 16, tid, 1};
                    pg8::gemm_phase<EpiRes<0>, pg8::StaticOrder, false, true, false, false, PreTab<pg8::StaticOrder>>(lds, g, S, E, wave, PT);
                    MK_DUPLOOP(6) skinny<8>(WL(l, W_OUT), D, RDA, ABDirect{MIXS, D}, red, tid, wave, lane, bx, G);
                }
                cur ^= 1;
                GRID_BAR();
            }
            const size_t wup = sub ? W_UP2 : W_UP1, wdn = sub ? W_DN2 : W_DN1; const int cvu = sub ? CV_UP2 : CV_UP1;
            const int idn = (l == 0 && sub == 0) ? 1 : 0;
            if (RUNP(l * 16 + (sub ? 7 : 1))) REPS(1) {
                REPBAR();
                pg8::Gemm g{(const bf16_t*)Y8, WL(l, wup), M, NUP, D / 2}; pg8::StaticOrder S; S.init(M, NUP, G, bx);
                const bool tail = (G == 256);
                if (tail) S.lim = 1280;
#if defined(MK_PROBE)
                const int nost_ = DUMSEL ? (int)((KP->rep >> 16) & 3) : 0;
                EpiSwiGLU<false> E{H, STATS + (size_t)cur * M * 16, CV1(l, cvu), CV2(l, cvu), idn, nost_};
#else
                EpiSwiGLU<false> E{H, STATS + (size_t)cur * M * 16, CV1(l, cvu), CV2(l, cvu), idn};
#endif
                TailOrder ST{S, 1280, G / 2, bx, S.nwg};
                const PreTab<pg8::StaticOrder> PT{lds, S, STATS + (size_t)cur * M * 16, tid, !idn};
                {
                    const ChainOrder SC{S, 1280, G / 2};
                    pg8::gemm_phase<EpiSwiGLU<false>, ChainOrder, true, true, false, true, PreTab<pg8::StaticOrder>>(lds, g, SC, E, wave, PT);
                }
                OPAQUE_IDS();
                if (tail) {
#if defined(MK_PROBE)
                    EpiSwiGLU<true> ET{H, STATS + (size_t)cur * M * 16, CV1(l, cvu), CV2(l, cvu), idn, nost_};
#else
                    EpiSwiGLU<true> ET{H, STATS + (size_t)cur * M * 16, CV1(l, cvu), CV2(l, cvu), idn};
#endif
                    const PreTabHalf PTH{lds, ST, STATS + (size_t)cur * M * 16, tid, !idn}; pg8::gemm_phase<EpiSwiGLU<true>, TailOrder, false, true, true, true, PreTabHalf, true>(lds, g, ST, ET, wave, PTH); }
                OPAQUE_IDS();
                const int sgf = bx, sgs = G;
                if (idn) skinny8_swi((const unsigned char*)WL(l, wup), ABDirect{x_sample, D}, 1, nullptr, nullptr, HSS, lds, tid, wave, lane, bx);
                else {
                    const int gm = (sub == 0) ? 1 : 0;
                    ABResid ab{ysp, sstp, 0, sg, sb, RDA, 1.0f, gm, gm ? PWS + (size_t)(l - 1) * 8 * D : nullptr, gm ? CV1(l - 1, CV_GATE) : nullptr, gm ? CV2(l - 1, CV_GATE) : nullptr};
                    if (sgf == 0) smp_update(ab, YS + ss * 8 * D, SST + ss * 16, wave, lane);
                    OPAQUE_IDS();
                    skinny8_swi((const unsigned char*)WL(l, wup), ab, 0, CV1(l, cvu), CV2(l, cvu), HSS, lds, tid, wave, lane, bx);
                }
            }
            if (!idn) { ysp = YS + ss * 8 * D; sstp = SST + ss * 16; sid = 0; if (sub == 0) { sg = LNG(l - 1, 3); sb = LNB(l - 1, 3); } else { sg = LNG(l, 1); sb = LNB(l, 1); } ss ^= 1; }
            GRID_BAR();
            if (RUNP(l * 16 + (sub ? 8 : 2))) REPS(2) {
                REPBAR(); const bool dum = DUMSEL;
                pg8::Gemm g{(const bf16_t*)H, WL(l, wdn), M, D, FF / 2}; pg8::StaticOrder S; S.init(M, D, G, bx);
                const float* pg = idn ? ln_g : (sub ? LNG(l, 1) : LNG(l - 1, 3)); const float* pb = idn ? ln_b : (sub ? LNB(l, 1) : LNB(l - 1, 3));
                EpiRes<0> E{x_prompt, YB + (size_t)cur * M * D, dum ? YBDUM : YB + (size_t)(cur ^ 1) * M * D, STATS + (size_t)cur * M * 16, dum ? STDUM : STATS + (size_t)(cur ^ 1) * M * 16, pg, pb, idn, 0.5f / (W8S * H8S), nullptr, nullptr, nullptr, nullptr};
                const PreTab<pg8::StaticOrder> PT{lds, S, STATS + (size_t)cur * M * 16, tid, !idn};
                pg8::gemm_phase<EpiRes<0>, pg8::StaticOrder, false, true, false, true, PreTab<pg8::StaticOrder>>(lds, g, S, E, wave, PT);
                OPAQUE_IDS();
                skinny8<6, ABRaw8, 1, 3, true>((const unsigned char*)WL(l, wdn), D, FF, RDB, ABRaw8{HSS}, 1.f, 1.f / (W8S * H8S), lds, tid, wave, lane, bx, G);
            }
            cur ^= 1;
            GRID_BAR();
        }
        OPAQUE_IDS();
        if (RUNP(l * 16 + 9)) REPS(9) {
            REPBAR(); const bool dum = DUMSEL;
            pg8::Gemm g{YB + (size_t)cur * M * D, WL(l, W_GATE), M, D, D}; pg8::StaticOrder S; S.init(M, D, G, bx);
            EpiRes<1> E{nullptr, YB + (size_t)cur * M * D, dum ? YBDUM : YB + (size_t)(cur ^ 1) * M * D, STATS + (size_t)cur * M * 16, dum ? STDUM : STATS + (size_t)(cur ^ 1) * M * 16, LNG(l, 2), LNB(l, 2), 0, 1.0f, PW + (size_t)l * M * D, CV1(l, CV_GATE), CV2(l, CV_GATE), dum ? nullptr : Y8};
            const PreTab<pg8::StaticOrder> PT{lds, S, STATS + (size_t)cur * M * 16, tid, 1};
            pg8::gemm_phase<EpiRes<1>, pg8::StaticOrder, false, true, false, false, PreTab<pg8::StaticOrder>>(lds, g, S, E, wave, PT);
            ABResid ab{ysp, sstp, 0, sg, sb, RDB, 0.5f, 0, nullptr, nullptr, nullptr};
            if (bx == 0) smp_update(ab, YS + ss * 8 * D, SST + ss * 16, wave, lane);
            MK_DUPLOOP(6) skinny<8>(WL(l, W_GATE), D, RDA, ab, red, tid, wave, lane, bx, G);
        }
        ysp = YS + ss * 8 * D; sstp = SST + ss * 16; sid = 0; sg = LNG(l, 2); sb = LNB(l, 2); ss ^= 1;
        cur ^= 1;
        GRID_BAR();
    }
    {
        OPAQUE_IDS();
        const int l = KP->nl - 1;
        const float* st = STATS + (size_t)cur * M * 16; const float* g = LNG(l, 3); const float* b = LNB(l, 3);
        for (int t0 = gw; t0 < M; t0 += 4 * NGW) {
            u32x2 pq[4][8]; float mu[4], rs[4];
#pragma unroll
            for (int r = 0; r < 4; ++r) {
                const int t = t0 + r * NGW;
                if (t < M) { row_stats(st, t, mu[r], rs[r]);
#pragma unroll
                    for (int j = 0; j < 8; ++j) pq[r][j] = *(const u32x2*)(YB + (size_t)cur * M * D + (size_t)t * D + 4 * lane + 256 * j); }
            }
#pragma unroll
            for (int j = 0; j < 8; ++j) {
                const int c = 4 * lane + 256 * j; const f32x4 gv = *(const f32x4*)(g + c), bv = *(const f32x4*)(b + c);
#pragma unroll
                for (int r = 0; r < 4; ++r) {
                    const int t = t0 + r * NGW;
                    if (t < M) { const f32x4 v = (f32x4){bflo(pq[r][j].x), bfhi(pq[r][j].x), bflo(pq[r][j].y), bfhi(pq[r][j].y)}; __builtin_nontemporal_store((v - mu[r]) * rs[r] * gv + bv, (f32x4*)(out + O_YP + (size_t)t * D + c)); }
                }
            }
        }
        if (bx == 0) {
            ABResid ab{ysp, sstp, 0, sg, sb, RDA, 1.0f, 1, PWS + (size_t)l * 8 * D, CV1(l, CV_GATE), CV2(l, CV_GATE)};
            float v[32]; float s = 0.f, q = 0.f;
#pragma unroll
            for (int j = 0; j < 4; ++j) { float t8[8]; ab.val8(wave, lane * 8 + 512 * j, t8);
#pragma unroll
                for (int e = 0; e < 8; ++e) { v[8 * j + e] = t8[e]; s += t8[e]; q += t8[e] * t8[e]; } }
#pragma unroll
            for (int o = 32; o > 0; o >>= 1) { s += shx(s, o, lane); q += shx(q, o, lane); }
            const float mu = s * (1.f / 2048.f), rs = 1.0f / sqrtf(fmaxf(q * (1.f / 2048.f) - mu * mu, 0.f) + LN_EPS);
#pragma unroll
            for (int j = 0; j < 4; ++j)
#pragma unroll
                for (int e = 0; e < 8; ++e) { const int k = lane * 8 + 512 * j + e; out[O_YS + (size_t)wave * D + k] = (v[8 * j + e] - mu) * rs * g[k] + b[k]; }
        }
    }
#if defined(MK_STAMP)
    asm volatile("s_waitcnt vmcnt(0)" ::: "memory");
    if (bx == 0 && tid == 0) ((unsigned long long*)(ws + WS_CTL + 524288))[nstamp] = __builtin_amdgcn_s_memrealtime();
#endif
}
#undef ws
#undef out
#undef x_prompt
#undef x_sample
#undef cache_k
#undef cache_v
#undef state_ret
#undef p_prompt
#undef p_sample
#undef w_in
#undef w_out
#undef gn_g
#undef gn_b
#undef f1w1
#undef f1w3
#undef f1w2
#undef f2w1
#undef f2w3
#undef f2w2
#undef w_ple
#undef w_gate
#undef ln_g
#undef ln_b
#undef STATS
#undef CV
#undef SMP
#undef PART
#undef WB
#undef YB
#undef Y8
#undef H
#undef Z
#undef MIX
#undef OG
#undef LSE
#undef U
#undef PB
#undef PW
#undef YS
#undef SST
#undef RUP
#undef RDA
#undef RIN
#undef MIXS
#undef AP
#undef PWS
#undef RDB
#undef YBDUM
#undef STDUM
#undef gw
#undef NGW
#undef gt
#undef GT
#undef OPAQUE_IDS
#undef LNG
#undef LNB
#undef CV1
#undef CV2
#undef WL
#undef GRID_BAR
#undef RUNP
#undef REPS
#undef REPBAR
#undef DUMSEL
}

namespace mk { constexpr size_t WS_NEED = WS_END + (size_t)120 * 1024 * 1024; }
#define NL_RUN 4
#define STOP_RUN 0
#define REP_RUN 0


extern "C" void kernel_launch(void* const* d_in, const int* in_sizes, int n_in, void* d_out, int out_size, void* d_ws, size_t ws_size, hipStream_t stream) {
    using namespace mk;
    static int ok = 0;
    if (ok == 0) {
        ok = 1;
        if (n_in != 21 || (size_t)out_size != O_END || ws_size < WS_NEED) { fprintf(stderr, "kernel_launch: unexpected shapes (n_in %d out %d ws %zu need %zu)\n", n_in, out_size, ws_size, (size_t)WS_NEED); ok = -1; }
        else if (hipFuncSetAttribute((const void*)mega, hipFuncAttributeMaxDynamicSharedMemorySize, LDS_BYTES) != hipSuccess) { fprintf(stderr, "kernel_launch: hipFuncSetAttribute failed\n"); ok = -1; }
        else {
            int dev = 0, ncu = 0, per = 0;
            if (hipGetDevice(&dev) == hipSuccess && hipDeviceGetAttribute(&ncu, hipDeviceAttributeMultiprocessorCount, dev) == hipSuccess &&
                hipOccupancyMaxActiveBlocksPerMultiprocessor(&per, (const void*)mega, NTHR, LDS_BYTES) == hipSuccess && (long)per * ncu < 256)
                fprintf(stderr, "kernel_launch: 256 workgroups are not co-resident here (%d per CU x %d CUs)\n", per, ncu);
        }
    }
    if (ok < 0) return;
    unsigned char* ws = (unsigned char*)d_ws;

    (void)hipMemsetAsync(ws + WS_CTL, 0, CTL_BYTES, stream);
    Args a{};
    for (int i = 0; i < 21; ++i) a.in[i] = (const float*)d_in[i];
    a.out = (float*)d_out; a.ws = ws; a.nl = NL_RUN; a.stop = STOP_RUN; a.rep = REP_RUN;
#if defined(MK_DUP)
    a.pad = 1;
#endif
    hipLaunchKernelGGL(mega, dim3(256), dim3(NTHR), LDS_BYTES, stream, a);

}
```
